# Optimizing an MI355X kernel written in HIP

```python
import math
import jax, jax.numpy as jnp
from jax import lax
import numpy as np

D_MODEL = 1024
BATCH = 16
SEQ = 256
DEPTH = 2
DEC_BATCH = 8
DEC_SEQ = 1024
PAST_LEN = 256

GRID_W = 64
N_EVEN = (DEPTH + 1) // 2
N_ODD = DEPTH // 2
NA_HEADS = 8
NA_HEAD_DIM = 64
NA_WIDTH = NA_HEADS * NA_HEAD_DIM
NA_ROWS_MAX = 8
NA_COLS = 16
RPB_ROWS = 2 * NA_ROWS_MAX - 1
RPB_COLS = 2 * NA_COLS - 1
LRU_WIDTH = 512
LRU_BLOCKS = 8
LRU_BLOCK = LRU_WIDTH // LRU_BLOCKS
LRU_C = 8.0
CONV_WIDTH = 4
CONV_PAD_L = 2
CONV_PAD_R = 1
DIFF_HEADS = 8
DIFF_HEAD_DIM = 64
DIFF_WIDTH = DIFF_HEADS * 2 * DIFF_HEAD_DIM
EVEN_IN = 4 * NA_WIDTH + 2 * LRU_WIDTH
EVEN_OUT = NA_WIDTH + LRU_WIDTH
ODD_IN = 4 * DIFF_WIDTH
ROPE_BASE = 10000.0
Q_BLOCK = 128
EPS = 1e-6
NEG_INF = -1e30

kernel_name = 'hybrid_natten_rglru_diffattn_prefix_step'


def rmsnorm(x, g):
    xf = x.astype(jnp.float32)
    y = xf * lax.rsqrt(jnp.mean(xf * xf, axis=-1, keepdims=True) + EPS)
    return y.astype(x.dtype) * g


def adaln_input(x, cvec, norm_g, ada_w, ada_b):
    m = (jax.nn.silu(cvec) @ ada_w + ada_b)[..., None, :]
    shift, scale, gate = jnp.split(m, 3, axis=-1)
    return rmsnorm(x, norm_g) * (1 + scale) + shift, gate


def _query_blocks(q):
    b, t = q.shape[:2]
    return jnp.moveaxis(q.reshape((b, t // Q_BLOCK, Q_BLOCK) + q.shape[2:]), 1, 0)


def _merge_blocks(o):
    nb, b, qb = o.shape[:3]
    return jnp.moveaxis(o, 0, 1).reshape((b, nb * qb) + o.shape[3:])


def dense_attention(q, k, v):
    scale = q.shape[-1] ** -0.5
    def one(qb):
        s = jnp.einsum('bqhd,bkhd->bhqk', qb, k).astype(jnp.float32) * scale
        p = jax.nn.softmax(s, axis=-1).astype(v.dtype)
        return jnp.einsum('bhqk,bkhd->bqhd', p, v)
    return _merge_blocks(lax.map(one, _query_blocks(q)))


def diff_attention(q, k, v, lam):
    scale = DIFF_HEAD_DIM ** -0.5
    k1, k2 = jnp.split(k, 2, axis=-1)
    def one(qb):
        q1, q2 = jnp.split(qb, 2, axis=-1)
        s1 = jnp.einsum('bqhd,bkhd->bhqk', q1, k1).astype(jnp.float32) * scale
        s2 = jnp.einsum('bqhd,bkhd->bhqk', q2, k2).astype(jnp.float32) * scale
        p = jax.nn.softmax(s1, axis=-1) - lam * jax.nn.softmax(s2, axis=-1)
        return jnp.einsum('bhqk,bkhd->bqhd', p.astype(v.dtype), v)
    return _merge_blocks(lax.map(one, _query_blocks(q)))


def rope_2d(x):
    t_len = x.shape[1]
    half = DIFF_HEAD_DIM // 2
    m = half // 2
    t = jnp.arange(t_len)
    rows = (t // GRID_W).astype(jnp.float32)
    cols = (t % GRID_W).astype(jnp.float32)
    inv = ROPE_BASE ** (-jnp.arange(m, dtype=jnp.float32) / m)
    def rot(xh, pos):
        ang = pos[:, None] * inv[None, :]
        cos = jnp.cos(ang)[None, :, None, None, :].astype(x.dtype)
        sin = jnp.sin(ang)[None, :, None, None, :].astype(x.dtype)
        x1, x2 = jnp.split(xh, 2, axis=-1)
        return jnp.concatenate([x1 * cos - x2 * sin, x2 * cos + x1 * sin], axis=-1)
    return jnp.concatenate([rot(x[..., :half], rows), rot(x[..., half:], cols)], axis=-1)


def neighbourhood_attention(q, k, v, ck, cv, rpb):
    b, t, h, d = q.shape
    n_rows = t // GRID_W
    kr = min(NA_ROWS_MAX, n_rows)
    kc = NA_COLS
    scale = d ** -0.5
    rows = jnp.arange(n_rows)
    cols = jnp.arange(GRID_W)
    row_start = jnp.clip(rows - kr // 2, 0, n_rows - kr)
    row_idx = row_start[:, None] + jnp.arange(kr)[None, :]
    col_start = jnp.clip(cols - kc // 2, 0, GRID_W - kc)
    col_in = (cols[None, :] >= col_start[:, None]) & (cols[None, :] < col_start[:, None] + kc)
    dr = row_idx - rows[:, None] + (NA_ROWS_MAX - 1)
    dc = jnp.clip(cols[None, :] - cols[:, None] + (kc - 1), 0, 2 * kc - 2)
    bias = rpb[:, dr[:, None, :, None], dc[None, :, None, :]]
    qg = q.reshape(b, n_rows, GRID_W, h, d)
    kg = jnp.take(k.reshape(b, n_rows, GRID_W, h, d), row_idx, axis=1)
    vg = jnp.take(v.reshape(b, n_rows, GRID_W, h, d), row_idx, axis=1)
    s_win = jnp.einsum('brqhd,brkwhd->bhrqkw', qg, kg).astype(jnp.float32) * scale + bias[None].astype(jnp.float32)
    s_win = jnp.where(col_in[:, None, :], s_win, NEG_INF)
    s_ctx = jnp.einsum('brqhd,bkhd->bhrqk', qg, ck).astype(jnp.float32) * scale
    n_win = kr * GRID_W
    s = jnp.concatenate([s_win.reshape(b, h, n_rows, GRID_W, n_win), s_ctx], axis=-1)
    p = jax.nn.softmax(s, axis=-1).astype(v.dtype)
    p_win = p[..., :n_win].reshape(b, h, n_rows, GRID_W, kr, GRID_W)
    p_ctx = p[..., n_win:]
    o = jnp.einsum('bhrqkw,brkwhd->brqhd', p_win, vg) + jnp.einsum('bhrqk,bkhd->brqhd', p_ctx, cv)
    return o.reshape(b, t, h, d)


def dwconv(x, w, bias):
    y = lax.conv_general_dilated(x, w[:, None, :], window_strides=(1,), padding=[(CONV_PAD_L, CONV_PAD_R)],
                                 dimension_numbers=('NWC', 'WIO', 'NWC'), feature_group_count=x.shape[-1])
    return y + bias


def rglru(x, w_a, b_a, w_x, b_x, lam, h0, reverse):
    b, t, wd = x.shape
    xb = x.reshape(b, t, LRU_BLOCKS, LRU_BLOCK)
    r = jax.nn.sigmoid(jnp.einsum('btnc,ncd->btnd', xb, w_a).reshape(b, t, wd) + b_a)
    i = jax.nn.sigmoid(jnp.einsum('btnc,ncd->btnd', xb, w_x).reshape(b, t, wd) + b_x)
    log_a = -LRU_C * r * jax.nn.softplus(-lam)
    a = jnp.exp(log_a)
    u = jnp.sqrt(-jnp.expm1(2 * log_a)) * (i * x)
    def combine(e1, e2):
        a1, b1 = e1
        a2, b2 = e2
        return a1 * a2, a2 * b1 + b2
    a_acc, u_acc = lax.associative_scan(combine, (a, u), reverse=reverse, axis=1)
    hs = u_acc + a_acc * h0[:, None, :]
    final = hs[:, 0] if reverse else hs[:, -1]
    return hs, final


def lru_branch(xb, conv_w, conv_b, wa, ba, wx, bx, lam, h0f, h0b):
    xc = dwconv(xb, conv_w, conv_b)
    hf, ff = rglru(xc, wa[0], ba[0], wx[0], bx[0], lam[0], h0f, False)
    hb, fb = rglru(xc, wa[1], ba[1], wx[1], bx[1], lam[1], h0b, True)
    return hf + hb, ff, fb


def even_split(h, w_in):
    return jnp.split(h @ w_in, [NA_WIDTH, 2 * NA_WIDTH, 3 * NA_WIDTH, 4 * NA_WIDTH, 4 * NA_WIDTH + LRU_WIDTH], axis=-1)


def even_layer_ctx(x, cvec, norm_g, ada_w, ada_b, w_in, conv_w, conv_b, wa, ba, wx, bx, lam, w_out):
    b, t, _ = x.shape
    h, gate = adaln_input(x, cvec, norm_g, ada_w, ada_b)
    q, k, v, ga, xb, gb = even_split(h, w_in)
    q = q.reshape(b, t, NA_HEADS, NA_HEAD_DIM)
    k = k.reshape(b, t, NA_HEADS, NA_HEAD_DIM)
    v = v.reshape(b, t, NA_HEADS, NA_HEAD_DIM)
    o_a = dense_attention(q, k, v).reshape(b, t, NA_WIDTH)
    zeros = jnp.zeros((b, LRU_WIDTH), x.dtype)
    o_b, ff, fb = lru_branch(xb, conv_w, conv_b, wa, ba, wx, bx, lam, zeros, zeros)
    o = jnp.concatenate([o_a * jax.nn.silu(ga), o_b * jax.nn.silu(gb)], axis=-1) @ w_out
    return x + gate * o, k, v, jnp.stack([ff, fb], axis=1)


def even_layer_lat(x, cvec, ck, cv, lru_state, rpb, norm_g, ada_w, ada_b, w_in, conv_w, conv_b, wa, ba, wx, bx, lam, w_out):
    b, t, _ = x.shape
    h, gate = adaln_input(x, cvec, norm_g, ada_w, ada_b)
    q, k, v, ga, xb, gb = even_split(h, w_in)
    q = q.reshape(b, t, NA_HEADS, NA_HEAD_DIM)
    k = k.reshape(b, t, NA_HEADS, NA_HEAD_DIM)
    v = v.reshape(b, t, NA_HEADS, NA_HEAD_DIM)
    o_a = neighbourhood_attention(q, k, v, ck, cv, rpb).reshape(b, t, NA_WIDTH)
    o_b, _, _ = lru_branch(xb, conv_w, conv_b, wa, ba, wx, bx, lam, lru_state[:, 0], lru_state[:, 1])
    o = jnp.concatenate([o_a * jax.nn.silu(ga), o_b * jax.nn.silu(gb)], axis=-1) @ w_out
    return x + gate * o


def diff_lambda(lq1, lk1, lq2, lk2, lam_init):
    return jnp.exp(jnp.sum(lq1 * lk1)) - jnp.exp(jnp.sum(lq2 * lk2)) + lam_init


def diff_output(o, g, sub_g, w_out, lam_init):
    b, t = o.shape[:2]
    o = rmsnorm(o, sub_g) * (1 - lam_init)
    return (o.reshape(b, t, DIFF_WIDTH) * jax.nn.silu(g)) @ w_out


def odd_layer_ctx(x, cvec, lam_init, norm_g, ada_w, ada_b, w_in, lq1, lk1, lq2, lk2, sub_g, w_out):
    b, t, _ = x.shape
    h, gate = adaln_input(x, cvec, norm_g, ada_w, ada_b)
    q, k, v, g = jnp.split(h @ w_in, 4, axis=-1)
    q = q.reshape(b, t, DIFF_HEADS, 2 * DIFF_HEAD_DIM)
    k = k.reshape(b, t, DIFF_HEADS, 2 * DIFF_HEAD_DIM)
    v = v.reshape(b, t, DIFF_HEADS, 2 * DIFF_HEAD_DIM)
    lam = diff_lambda(lq1, lk1, lq2, lk2, lam_init)
    o = diff_attention(q, k, v, lam)
    return x + gate * diff_output(o, g, sub_g, w_out, lam_init), k, v


def odd_layer_lat(x, cvec, ck, cv, lam_init, norm_g, ada_w, ada_b, w_in, lq1, lk1, lq2, lk2, sub_g, w_out):
    b, t, _ = x.shape
    h, gate = adaln_input(x, cvec, norm_g, ada_w, ada_b)
    q, k, v, g = jnp.split(h @ w_in, 4, axis=-1)
    q = rope_2d(q.reshape(b, t, DIFF_HEADS, 2, DIFF_HEAD_DIM)).reshape(b, t, DIFF_HEADS, 2 * DIFF_HEAD_DIM)
    k = rope_2d(k.reshape(b, t, DIFF_HEADS, 2, DIFF_HEAD_DIM)).reshape(b, t, DIFF_HEADS, 2 * DIFF_HEAD_DIM)
    v = v.reshape(b, t, DIFF_HEADS, 2 * DIFF_HEAD_DIM)
    k_all = jnp.concatenate([ck, k], axis=1)
    v_all = jnp.concatenate([cv, v], axis=1)
    lam = diff_lambda(lq1, lk1, lq2, lk2, lam_init)
    o = diff_attention(q, k_all, v_all, lam)
    return x + gate * diff_output(o, g, sub_g, w_out, lam_init)


def setup_inputs(seed: int = 0) -> dict:
    key = jax.random.key(seed)
    kit = iter(jax.random.split(key, 40))
    def nrm(shape, s):
        return jax.random.normal(next(kit), shape, jnp.float32) * s
    def gain(shape):
        return 1.0 + nrm(shape, 0.02)
    a0 = jax.random.uniform(next(kit), (N_EVEN, 2, LRU_WIDTH), jnp.float32, minval=0.9, maxval=0.999)
    a_base = a0 ** (1.0 / LRU_C)
    lru_lam = jnp.log(a_base) - jnp.log1p(-a_base)
    return {
        'x_prompt': nrm((BATCH, SEQ, D_MODEL), 1.0),
        'x_sample': nrm((DEC_BATCH, DEC_SEQ, D_MODEL), 1.0),
        'c': nrm((DEC_BATCH, D_MODEL), 1.0),
        'cache_na_k': nrm((DEC_BATCH, N_EVEN, PAST_LEN, NA_HEADS, NA_HEAD_DIM), 1.0),
        'cache_na_v': nrm((DEC_BATCH, N_EVEN, PAST_LEN, NA_HEADS, NA_HEAD_DIM), 1.0),
        'state_lru': nrm((DEC_BATCH, N_EVEN, 2, LRU_WIDTH), 0.3),
        'cache_diff_k': nrm((DEC_BATCH, N_ODD, PAST_LEN, DIFF_HEADS, 2 * DIFF_HEAD_DIM), 1.0),
        'cache_diff_v': nrm((DEC_BATCH, N_ODD, PAST_LEN, DIFF_HEADS, 2 * DIFF_HEAD_DIM), 1.0),
        'c_ctx': nrm((D_MODEL,), 1.0),
        'e_norm': gain((N_EVEN, D_MODEL)),
        'e_ada_w': nrm((N_EVEN, D_MODEL, 3 * D_MODEL), D_MODEL ** -0.5),
        'e_ada_b': nrm((N_EVEN, 3 * D_MODEL), 0.02),
        'e_w_in': nrm((N_EVEN, D_MODEL, EVEN_IN), D_MODEL ** -0.5),
        'e_rpb': nrm((N_EVEN, NA_HEADS, RPB_ROWS, RPB_COLS), 0.2),
        'e_conv_w': nrm((N_EVEN, CONV_WIDTH, LRU_WIDTH), 0.5),
        'e_conv_b': nrm((N_EVEN, LRU_WIDTH), 0.02),
        'e_lru_wa': nrm((N_EVEN, 2, LRU_BLOCKS, LRU_BLOCK, LRU_BLOCK), LRU_BLOCK ** -0.5),
        'e_lru_ba': nrm((N_EVEN, 2, LRU_WIDTH), 0.02),
        'e_lru_wx': nrm((N_EVEN, 2, LRU_BLOCKS, LRU_BLOCK, LRU_BLOCK), LRU_BLOCK ** -0.5),
        'e_lru_bx': nrm((N_EVEN, 2, LRU_WIDTH), 0.02),
        'e_lru_lam': lru_lam,
        'e_w_out': nrm((N_EVEN, EVEN_OUT, D_MODEL), EVEN_OUT ** -0.5),
        'o_norm': gain((N_ODD, D_MODEL)),
        'o_ada_w': nrm((N_ODD, D_MODEL, 3 * D_MODEL), D_MODEL ** -0.5),
        'o_ada_b': nrm((N_ODD, 3 * D_MODEL), 0.02),
        'o_w_in': nrm((N_ODD, D_MODEL, ODD_IN), D_MODEL ** -0.5),
        'o_lq1': nrm((N_ODD, DIFF_HEAD_DIM), 0.1),
        'o_lk1': nrm((N_ODD, DIFF_HEAD_DIM), 0.1),
        'o_lq2': nrm((N_ODD, DIFF_HEAD_DIM), 0.1),
        'o_lk2': nrm((N_ODD, DIFF_HEAD_DIM), 0.1),
        'o_sub_g': gain((N_ODD, 2 * DIFF_HEAD_DIM)),
        'o_w_out': nrm((N_ODD, DIFF_WIDTH, D_MODEL), DIFF_WIDTH ** -0.5),
        'final_norm': gain((D_MODEL,)),
    }


def reference(x_prompt, x_sample, c, cache_na_k, cache_na_v, state_lru, cache_diff_k, cache_diff_v, c_ctx,
              e_norm, e_ada_w, e_ada_b, e_w_in, e_rpb, e_conv_w, e_conv_b, e_lru_wa, e_lru_ba, e_lru_wx, e_lru_bx,
              e_lru_lam, e_w_out, o_norm, o_ada_w, o_ada_b, o_w_in, o_lq1, o_lk1, o_lq2, o_lk2, o_sub_g, o_w_out,
              final_norm):
    xp = x_prompt
    xs = x_sample
    na_k, na_v, lru_s, df_k, df_v = [], [], [], [], []
    for i in range(DEPTH):
        j = i // 2
        if i % 2 == 0:
            ep = (e_norm[j], e_ada_w[j], e_ada_b[j], e_w_in[j], e_conv_w[j], e_conv_b[j], e_lru_wa[j], e_lru_ba[j],
                  e_lru_wx[j], e_lru_bx[j], e_lru_lam[j], e_w_out[j])
            xp, k, v, s = even_layer_ctx(xp, c_ctx, *ep)
            xs = even_layer_lat(xs, c, cache_na_k[:, j], cache_na_v[:, j], state_lru[:, j], e_rpb[j], *ep)
            na_k.append(k)
            na_v.append(v)
            lru_s.append(s)
        else:
            lam_init = 0.8 - 0.6 * math.exp(-0.3 * i)
            op = (o_norm[j], o_ada_w[j], o_ada_b[j], o_w_in[j], o_lq1[j], o_lk1[j], o_lq2[j], o_lk2[j], o_sub_g[j], o_w_out[j])
            xp, k, v = odd_layer_ctx(xp, c_ctx, lam_init, *op)
            xs = odd_layer_lat(xs, c, cache_diff_k[:, j], cache_diff_v[:, j], lam_init, *op)
            df_k.append(k)
            df_v.append(v)
    y_prompt = rmsnorm(xp, final_norm)
    y_sample = rmsnorm(xs, final_norm)
    new_na_k = jnp.stack(na_k, axis=1)
    new_na_v = jnp.stack(na_v, axis=1)
    new_lru = jnp.stack(lru_s, axis=1)
    new_diff_k = jnp.stack(df_k, axis=1)
    new_diff_v = jnp.stack(df_v, axis=1)
    return (y_prompt, y_sample, new_na_k, new_na_v, new_lru, new_diff_k, new_diff_v)
```

```cpp
#include <hip/hip_runtime.h>
#include <hip/hip_cooperative_groups.h>
#include <cstdio>
#include <cstdint>
namespace cg = cooperative_groups;
namespace pg8 {
#define PG8_LAS __attribute__((address_space(3)))
typedef unsigned short bf16_t;
typedef short bf16x8 __attribute__((ext_vector_type(8)));
typedef float f32x4 __attribute__((ext_vector_type(4)));
typedef unsigned u32x4 __attribute__((ext_vector_type(4)));
constexpr int BM = 256, BK = 64, HALF = 128, HTB = HALF * BK * 2  , STAGE_BYTES = 8 * HTB, NXCD = 8, WGM = 8;

__host__ __device__ __forceinline__ int lds_byte(int r, int c) { const int st = (r >> 4) * 2 + (c >> 5), rr = r & 15, cc = c & 31, ob = rr * 64 + cc * 2; return st * 1024 + (ob ^ (((ob >> 9) & 1) << 5)); }
__host__ __device__ __forceinline__ void stage_rc(int b, int& R, int& C) { const int st = b / 1024, sb = b % 1024, swz = sb ^ (((sb >> 9) & 1) << 5); R = (st >> 1) * 16 + swz / 64; C = (st & 1) * 32 + (swz % 64) / 2; }
__host__ __device__ __forceinline__ int perm32(int rho) { const int n = rho >> 4, i = rho & 15; return 8 * (i >> 2) + 4 * n + (i & 3); }

struct Unit { int pm, pn; };
struct Gemm { const bf16_t* A; const bf16_t* Bt; int M, N, K; };

struct StaticOrder {
    int nM, nN, nwg, G, c;
    __host__ __device__ void init(int M, int N, int G_, int c_) { nM = M / BM; nN = N / BM; nwg = nM * nN; G = G_; c = c_; }
    __host__ __device__ bool next(int i, Unit& u) const {
        const long L = (long)i * G + c; if (L >= nwg) return false;
        int wgid = (int)L; { const int q = nwg / NXCD, r = nwg % NXCD, xcd = wgid % NXCD, off = wgid / NXCD; wgid = (xcd < r ? xcd * (q + 1) : r * (q + 1) + (xcd - r) * q) + off; }
        const int nig = WGM * nN, gid = wgid / nig, fm = gid * WGM, gsz = (nM - fm) < WGM ? (nM - fm) : WGM;
        u.pm = fm + ((wgid % nig) % gsz); u.pn = (wgid % nig) / gsz; return true;
    }
    __device__ __forceinline__ void a_ready(const Unit&) const {}
    __device__ __forceinline__ void done(const Unit&) const {}
};

__device__ __forceinline__ unsigned cvt_pk_bf16(float lo, float hi) { unsigned r; asm volatile("v_cvt_pk_bf16_f32 %0, %1, %2" : "=v"(r) : "v"(lo), "v"(hi)); return r; }
template <int ACT  > struct EpiBf16 {
    static constexpr bool PERM = true, AFTER_DRAIN = false;
    bf16_t* O; int ldc; const float* bias; int split_cols; size_t split_stride;
    __device__ __forceinline__ void operator()(const f32x4 (&acc)[2][2][4][2], const Unit& u, int wr, int wc, int fr, int fq) const {
        const int row0 = u.pm * BM + wr * 64 + fr; int colt = u.pn * BM; bf16_t* base = O;
        if (split_cols) { const int t = colt / split_cols; base += (size_t)t * split_stride; colt -= t * split_cols; }
        const int col0 = colt + wc * 32 + 8 * fq, bcol0 = u.pn * BM + wc * 32 + 8 * fq;
        f32x4 bv[2][2];
#pragma unroll
        for (int bj = 0; bj < 2; ++bj)
#pragma unroll
            for (int n = 0; n < 2; ++n) bv[bj][n] = bias ? *(const f32x4*)(bias + bcol0 + bj * HALF + 4 * n) : (f32x4){0.f, 0.f, 0.f, 0.f};
#pragma unroll
        for (int ai = 0; ai < 2; ++ai)
#pragma unroll
            for (int m = 0; m < 4; ++m) { bf16_t* rowp = base + (size_t)(row0 + ai * HALF + m * 16) * ldc + col0;
#pragma unroll
                for (int bj = 0; bj < 2; ++bj) { f32x4 v0 = acc[ai][bj][m][0] + bv[bj][0], v1 = acc[ai][bj][m][1] + bv[bj][1];
                    u32x4 w; w.x = cvt_pk_bf16(v0[0], v0[1]); w.y = cvt_pk_bf16(v0[2], v0[3]); w.z = cvt_pk_bf16(v1[0], v1[1]); w.w = cvt_pk_bf16(v1[2], v1[3]);
                    *(u32x4*)(rowp + bj * HALF) = w; } }
    }
};

template <class Epi, class Sched, bool STAMP = false>
__device__ __forceinline__ void gemm_phase(PG8_LAS unsigned char* lds, const Gemm g, const Sched& S, const Epi& E, unsigned long long* stamps) {
    const int tid = threadIdx.x, wid = __builtin_amdgcn_readfirstlane(tid >> 6), lane = tid & 63, wr = wid >> 2, wc = wid & 3, fr = lane & 15, fq = lane >> 4;
    const int K = g.K, nt = K / BK;
    int ts_lo = 0, ts_hi = 0, nts = 0; const unsigned long long rt_entry = STAMP ? (unsigned long long)wall_clock64() : 0ull;
#define PG8_STAMP() do { if (STAMP && wid == 0 && nts < 64) { const unsigned long long _c = (unsigned long long)clock64(); \
        ts_lo = (lane == nts) ? (int)(unsigned)_c : ts_lo; ts_hi = (lane == nts) ? (int)(unsigned)(_c >> 32) : ts_hi; ++nts; } } while (0)
    PG8_STAMP();
    unsigned voffA[2], voffB[2];
#pragma unroll
    for (int i = 0; i < 2; ++i) { int R, C; stage_rc(tid * 16 + i * 8192, R, C); const int Rb = Epi::PERM ? ((R & ~31) + perm32(R & 31)) : R;
        voffA[i] = (unsigned)(R * K + C) * 2u; voffB[i] = (unsigned)(Rb * K + C) * 2u; }
    const size_t kstep = (size_t)(BK * 2);
    const size_t hstep = (size_t)HALF * K * 2;
    const size_t tstep = 2 * hstep;
    const unsigned ldsw = (unsigned)wid * 1024u;
    const int aoff = lds_byte(wr * 64 + fr, fq * 8), boff = lds_byte(wc * 32 + fr, fq * 8);
#define PG8_SA(b, h) (((b) * 2 + (h)) * HTB)
#define PG8_SB(b, h) ((4 + (b) * 2 + (h)) * HTB)
#define PG8_STAGE(bufoff, gbase, voff) do { _Pragma("unroll") for (int _i = 0; _i < 2; ++_i) \
        __builtin_amdgcn_global_load_lds((const unsigned*)((const char*)(gbase) + (voff)[_i]), (PG8_LAS unsigned*)(lds + (bufoff) + ldsw + _i * 8192), 16, 0, 0); } while (0)
#define PG8_LDA(dst, b, h) do { _Pragma("unroll") for (int m = 0; m < 4; ++m) _Pragma("unroll") for (int k = 0; k < 2; ++k) dst[m][k] = *(const PG8_LAS bf16x8*)(lds + PG8_SA(b, h) + aoff + m * 2048 + k * 1024); } while (0)
#define PG8_LDB(dst, b, h) do { _Pragma("unroll") for (int n = 0; n < 2; ++n) _Pragma("unroll") for (int k = 0; k < 2; ++k) dst[n][k] = *(const PG8_LAS bf16x8*)(lds + PG8_SB(b, h) + boff + n * 2048 + k * 1024); } while (0)
#define PG8_MMA(ai, bj, At, Bt) do { __builtin_amdgcn_s_setprio(1); _Pragma("unroll") for (int m = 0; m < 4; ++m) _Pragma("unroll") for (int n = 0; n < 2; ++n) _Pragma("unroll") for (int k = 0; k < 2; ++k) \
        acc[ai][bj][m][n] = __builtin_amdgcn_mfma_f32_16x16x32_bf16(Bt[n][k], At[m][k], acc[ai][bj][m][n], 0, 0, 0); __builtin_amdgcn_s_setprio(0); } while (0)
#define PG8_WAIT_V(n) asm volatile("s_waitcnt vmcnt(" #n ")" ::: "memory")
#define PG8_WAIT_L(n) asm volatile("s_waitcnt lgkmcnt(" #n ")" ::: "memory")
#define PG8_BAR __builtin_amdgcn_s_barrier()
#define PG8_SCHED __builtin_amdgcn_sched_barrier(0)
    Unit cur, nxt; int ui = 0;
    if (!S.next(0, cur)) return;
    f32x4 acc[2][2][4][2];
#pragma unroll
    for (int a = 0; a < 2; ++a)
#pragma unroll
        for (int b = 0; b < 2; ++b)
#pragma unroll
            for (int m = 0; m < 4; ++m)
#pragma unroll
                for (int n = 0; n < 2; ++n) acc[a][b][m][n] = (f32x4){0.f, 0.f, 0.f, 0.f};
    bf16x8 At[4][2], B0[2][2], B1[2][2];
    const char* cA = (const char*)g.A + (size_t)cur.pm * tstep; const char* cB = (const char*)g.Bt + (size_t)cur.pn * tstep;
    S.a_ready(cur);
    PG8_STAGE(PG8_SB(0, 0), cB, voffB); PG8_STAGE(PG8_SA(0, 0), cA, voffA); PG8_STAGE(PG8_SB(0, 1), cB + hstep, voffB); PG8_STAGE(PG8_SA(0, 1), cA + hstep, voffA);
    if (wr == 1) PG8_BAR;
    PG8_WAIT_V(4); PG8_BAR;
    PG8_STAGE(PG8_SB(1, 0), cB + kstep, voffB); PG8_STAGE(PG8_SA(1, 0), cA + kstep, voffA); PG8_STAGE(PG8_SB(1, 1), cB + hstep + kstep, voffB);
    PG8_WAIT_V(6); PG8_BAR;
    PG8_STAMP();
    for (;;) {
        const bool has_next = S.next(ui + 1, nxt);
        const char* nA = has_next ? (const char*)g.A + (size_t)nxt.pm * tstep : cA; const char* nB = has_next ? (const char*)g.Bt + (size_t)nxt.pn * tstep : cB;
        for (int t = 0; t < nt; t += 2) {
            const bool last = (t == nt - 2);
            const char* a1 = cA + (size_t)(t + 1) * kstep;
            const char* a2 = last ? nA : cA + (size_t)(t + 2) * kstep; const char* b2 = last ? nB : cB + (size_t)(t + 2) * kstep;
            const char* a3 = a2 + kstep; const char* b3 = b2 + kstep;
            if (last && has_next) S.a_ready(nxt);
            PG8_LDB(B0, 0, 0); PG8_SCHED; PG8_LDA(At, 0, 0); PG8_STAGE(PG8_SA(1, 1), a1 + hstep, voffA);
            PG8_WAIT_L(8); PG8_BAR; PG8_WAIT_L(0); PG8_MMA(0, 0, At, B0); PG8_BAR; PG8_SCHED;
            PG8_LDB(B1, 0, 1); PG8_STAGE(PG8_SB(0, 0), b2, voffB);
            PG8_BAR; PG8_WAIT_L(0); PG8_MMA(0, 1, At, B1); PG8_BAR;
            PG8_LDA(At, 0, 1); PG8_STAGE(PG8_SA(0, 0), a2, voffA);
            PG8_BAR; PG8_WAIT_L(0); PG8_MMA(1, 0, At, B0); PG8_BAR; PG8_SCHED;
            PG8_STAGE(PG8_SB(0, 1), b2 + hstep, voffB);
            PG8_WAIT_V(6); PG8_BAR; PG8_MMA(1, 1, At, B1); PG8_BAR;
            PG8_LDB(B0, 1, 0); PG8_SCHED; PG8_LDA(At, 1, 0); PG8_STAGE(PG8_SA(0, 1), a2 + hstep, voffA);
            PG8_WAIT_L(8); PG8_BAR; PG8_WAIT_L(0); PG8_MMA(0, 0, At, B0); PG8_BAR; PG8_SCHED;
            PG8_LDB(B1, 1, 1); PG8_STAGE(PG8_SB(1, 0), b3, voffB);
            PG8_BAR; PG8_WAIT_L(0); PG8_MMA(0, 1, At, B1); PG8_BAR;
            PG8_LDA(At, 1, 1); PG8_STAGE(PG8_SA(1, 0), a3, voffA);
            PG8_BAR; PG8_WAIT_L(0); PG8_MMA(1, 0, At, B0); PG8_BAR; PG8_SCHED;
            PG8_STAGE(PG8_SB(1, 1), b3 + hstep, voffB);
            PG8_WAIT_V(6); PG8_BAR; PG8_MMA(1, 1, At, B1); PG8_BAR;
        }
        PG8_STAMP();
        if constexpr (!Epi::AFTER_DRAIN) { E(acc, cur, wr, wc, fr, fq); S.done(cur); }
        PG8_STAMP();
        if (!has_next) break;
#pragma unroll
        for (int a = 0; a < 2; ++a)
#pragma unroll
            for (int b = 0; b < 2; ++b)
#pragma unroll
                for (int m = 0; m < 4; ++m)
#pragma unroll
                    for (int n = 0; n < 2; ++n) acc[a][b][m][n] = (f32x4){0.f, 0.f, 0.f, 0.f};
        cur = nxt; cA = nA; cB = nB; ++ui;
    }
    PG8_WAIT_V(0);
    if (wr == 0) PG8_BAR;
    PG8_BAR;
    if constexpr (Epi::AFTER_DRAIN) { E.fused(acc, cur, wr, wc, fr, fq, lds, wid, lane); S.done(cur); }
    PG8_STAMP();
    if (STAMP && wid == 0) { stamps[lane] = lane < nts ? (((unsigned long long)(unsigned)ts_hi << 32) | (unsigned)ts_lo) : 0ull;
        if (lane == 62) stamps[62] = rt_entry; if (lane == 63) stamps[63] = (unsigned long long)wall_clock64(); }
#undef PG8_STAMP
#undef PG8_SA
#undef PG8_SB
#undef PG8_STAGE
#undef PG8_LDA
#undef PG8_LDB
#undef PG8_MMA
#undef PG8_WAIT_V
#undef PG8_WAIT_L
#undef PG8_BAR
#undef PG8_SCHED
}
}
using pg8::bf16_t; using pg8::bf16x8; using pg8::f32x4; using pg8::u32x4;
#define LAS __attribute__((address_space(3)))
typedef unsigned u32x2 __attribute__((ext_vector_type(2)));

constexpr int NTOK = 12288, NCTX = 4096;
constexpr int LDS_BYTES = 131072;
constexpr float LAM_INIT = 0.35550906759f;
constexpr size_t O_YP = 0, O_YS = 4194304, O_NAK = 12582912, O_NAV = 14680064, O_LRU = 16777216, O_DK = 16793600, O_DV = 20987904;

struct Params { const float* in[33]; float* out; unsigned char* ws; };

__device__ __forceinline__ float bf2f(bf16_t v) { return __uint_as_float(((unsigned)v) << 16); }
__device__ __forceinline__ bf16_t f2bf(float f) { unsigned u = __float_as_uint(f); u += 0x7FFFu + ((u >> 16) & 1u); return (bf16_t)(u >> 16); }
__device__ __forceinline__ unsigned pk2(float lo, float hi) { return (unsigned)f2bf(lo) | ((unsigned)f2bf(hi) << 16); }
__device__ __forceinline__ float silu_f(float x) { return x / (1.0f + __expf(-x)); }
__device__ __forceinline__ float sigmoid_f(float x) { return 1.0f / (1.0f + __expf(-x)); }
__device__ __forceinline__ float wave_sum(float v) {
#pragma unroll
    for (int o = 32; o >= 1; o >>= 1) v += __shfl_xor(v, o);
    return v;
}
constexpr size_t WS_MOD = 0;
constexpr size_t WS_ROPE = 229376;
constexpr size_t WS_W1T = 262144;
constexpr size_t WS_W2T = WS_W1T + 6291456;
constexpr size_t WS_W3T = WS_W2T + 2097152;
constexpr size_t WS_W4T = WS_W3T + 8388608;
constexpr size_t WS_H = WS_W4T + 2097152;
constexpr size_t WS_P = WS_H + 25165824;
constexpr size_t WS_Y = WS_P + 100663296;
constexpr size_t WS_HF = WS_Y + 25165824;
constexpr size_t WS_END = WS_HF + 25165824;

__device__ __forceinline__ void transpose_tile(const float* __restrict__ src, int lds_, bf16_t* __restrict__ dst, int ldd, int r0, int c0, float* sm) {
    const int tid = threadIdx.x;
    __syncthreads();
#pragma unroll
    for (int i = 0; i < 2; ++i) {
        const int r = (tid >> 4) + i * 32, c4 = (tid & 15) * 4;
        const float4 v = *(const float4*)(src + (size_t)(r0 + r) * lds_ + c0 + c4);
        sm[r * 65 + c4 + 0] = v.x; sm[r * 65 + c4 + 1] = v.y; sm[r * 65 + c4 + 2] = v.z; sm[r * 65 + c4 + 3] = v.w;
    }
    __syncthreads();
    const int c = tid >> 3, r8 = (tid & 7) * 8;
    u32x4 w;
    w.x = pk2(sm[(r8 + 0) * 65 + c], sm[(r8 + 1) * 65 + c]); w.y = pk2(sm[(r8 + 2) * 65 + c], sm[(r8 + 3) * 65 + c]);
    w.z = pk2(sm[(r8 + 4) * 65 + c], sm[(r8 + 5) * 65 + c]); w.w = pk2(sm[(r8 + 6) * 65 + c], sm[(r8 + 7) * 65 + c]);
    *(u32x4*)(dst + (size_t)(c0 + c) * ldd + r0 + r8) = w;
}

__device__ __forceinline__ void phaseA(const Params& p, float* sm) {
    const int tid = threadIdx.x;
    float* mod = (float*)(p.ws + WS_MOD);
    for (int it = blockIdx.x; it < 193 + 2304; it += gridDim.x) {
        if (it < 192) {
            const int layer = it / 96, col0 = (it % 96) * 32;
            const float* W = p.in[layer ? 23 : 10]; const float* Bv = p.in[layer ? 24 : 11];
            const int col = tid & 31, kp = tid >> 5;
            float acc[9];
#pragma unroll
            for (int v = 0; v < 9; ++v) acc[v] = 0.f;
            for (int kk = 0; kk < 64; ++kk) {
                const int k = kp * 64 + kk; const float w = W[(size_t)k * 3072 + col0 + col];
                acc[0] += silu_f(p.in[8][k]) * w;
#pragma unroll
                for (int v = 1; v < 9; ++v) acc[v] += silu_f(p.in[2][(v - 1) * 1024 + k]) * w;
            }
            __syncthreads();
#pragma unroll
            for (int v = 0; v < 9; ++v) sm[(kp * 9 + v) * 32 + col] = acc[v];
            __syncthreads();
            if (tid < 288) { const int v = tid >> 5, c = tid & 31; float s = Bv[col0 + c];
                for (int k2 = 0; k2 < 16; ++k2) s += sm[(k2 * 9 + v) * 32 + c];
                mod[(layer * 9 + v) * 3072 + col0 + c] = s; }
        } else if (it == 192) {
            float* rc = (float*)(p.ws + WS_ROPE);
            for (int e = tid; e < 1024; e += 512) { const int pos = e >> 4, i = e & 15; const float inv = powf(10000.0f, -(float)i / 16.0f); const float ang = (float)pos * inv;
                rc[e] = cosf(ang); rc[1024 + e] = sinf(ang); }
        } else {
            int t = it - 193; const float* src; bf16_t* dst; int N;
            if (t < 768) { src = p.in[12]; dst = (bf16_t*)(p.ws + WS_W1T); N = 3072; }
            else if (t < 1024) { t -= 768; src = p.in[21]; dst = (bf16_t*)(p.ws + WS_W2T); N = 1024; }
            else if (t < 2048) { t -= 1024; src = p.in[25]; dst = (bf16_t*)(p.ws + WS_W3T); N = 4096; }
            else { t -= 2048; src = p.in[31]; dst = (bf16_t*)(p.ws + WS_W4T); N = 1024; }
            const int nb = N / 64; const int r0 = (t / nb) * 64, c0 = (t % nb) * 64;
            transpose_tile(src, N, dst, 1024, r0, c0, sm);
        }
    }
}

__device__ __forceinline__ void phase_norm(const Params& p, int layer, const float* xa, const float* xb_) {
    const int lane = threadIdx.x & 63, wave = threadIdx.x >> 6;
    const float* g = p.in[layer ? 22 : 9];
    const float* mod = (const float*)(p.ws + WS_MOD) + layer * 9 * 3072;
    bf16_t* H = (bf16_t*)(p.ws + WS_H);
    for (int row = blockIdx.x * 8 + wave; row < NTOK; row += gridDim.x * 8) {
        const float* xr = row < NCTX ? xa + (size_t)row * 1024 : xb_ + (size_t)(row - NCTX) * 1024;
        const int mi = row < NCTX ? 0 : 1 + ((row - NCTX) >> 10);
        const float* mv = mod + mi * 3072;
        float4 v[4]; float ss = 0.f;
#pragma unroll
        for (int i = 0; i < 4; ++i) { v[i] = *(const float4*)(xr + i * 256 + lane * 4); ss += v[i].x * v[i].x + v[i].y * v[i].y + v[i].z * v[i].z + v[i].w * v[i].w; }
        ss = wave_sum(ss);
        const float rstd = rsqrtf(ss * (1.0f / 1024.0f) + 1e-6f);
#pragma unroll
        for (int i = 0; i < 4; ++i) { const int c = i * 256 + lane * 4;
            const float4 gg = *(const float4*)(g + c), sh = *(const float4*)(mv + c), sc = *(const float4*)(mv + 1024 + c);
            u32x2 w;
            w.x = pk2(v[i].x * rstd * gg.x * (1.f + sc.x) + sh.x, v[i].y * rstd * gg.y * (1.f + sc.y) + sh.y);
            w.y = pk2(v[i].z * rstd * gg.z * (1.f + sc.z) + sh.z, v[i].w * rstd * gg.w * (1.f + sc.w) + sh.w);
            *(u32x2*)(H + (size_t)row * 1024 + c) = w; }
    }
}

__device__ __forceinline__ void phase_final(const Params& p) {
    const int lane = threadIdx.x & 63, wave = threadIdx.x >> 6;
    const float* g = p.in[32];
    for (int row = blockIdx.x * 8 + wave; row < NTOK; row += gridDim.x * 8) {
        float* xr = p.out + (size_t)row * 1024;
        float4 v[4]; float ss = 0.f;
#pragma unroll
        for (int i = 0; i < 4; ++i) { v[i] = *(const float4*)(xr + i * 256 + lane * 4); ss += v[i].x * v[i].x + v[i].y * v[i].y + v[i].z * v[i].z + v[i].w * v[i].w; }
        ss = wave_sum(ss);
        const float rstd = rsqrtf(ss * (1.0f / 1024.0f) + 1e-6f);
#pragma unroll
        for (int i = 0; i < 4; ++i) { const int c = i * 256 + lane * 4; const float4 gg = *(const float4*)(g + c);
            float4 o; o.x = v[i].x * rstd * gg.x; o.y = v[i].y * rstd * gg.y; o.z = v[i].z * rstd * gg.z; o.w = v[i].w * rstd * gg.w;
            *(float4*)(xr + c) = o; }
    }
}

struct EpiRes {
    static constexpr bool PERM = false, AFTER_DRAIN = false;
    const float* xa; const float* xb; float* xo; const float* gate;
    __device__ __forceinline__ void operator()(const f32x4 (&acc)[2][2][4][2], const pg8::Unit& u, int wr, int wc, int fr, int fq) const {
        const int row0 = u.pm * 256 + wr * 64 + fr, col0 = u.pn * 256 + wc * 32 + 4 * fq;
        const int mi = u.pm < 16 ? 0 : 1 + ((u.pm - 16) >> 2);
        f32x4 gv[2][2];
#pragma unroll
        for (int bj = 0; bj < 2; ++bj)
#pragma unroll
            for (int n = 0; n < 2; ++n) gv[bj][n] = *(const f32x4*)(gate + mi * 3072 + col0 + bj * 128 + n * 16);
#pragma unroll
        for (int ai = 0; ai < 2; ++ai)
#pragma unroll
            for (int m = 0; m < 4; ++m) { const int row = row0 + ai * 128 + m * 16;
                const float* xin = (row < NCTX ? xa + (size_t)row * 1024 : xb + (size_t)(row - NCTX) * 1024) + col0;
                float* xout = xo + (size_t)row * 1024 + col0;
#pragma unroll
                for (int bj = 0; bj < 2; ++bj)
#pragma unroll
                    for (int n = 0; n < 2; ++n) { const f32x4 xv = *(const f32x4*)(xin + bj * 128 + n * 16);
                        *(f32x4*)(xout + bj * 128 + n * 16) = xv + gv[bj][n] * acc[ai][bj][m][n]; } }
    }
};

__device__ __forceinline__ void sm_step(float s, float v, float& o, float& m, float& l) {
    const float mn = fmaxf(m, s), al = __expf(m - mn), pp = __expf(s - mn);
    l = l * al + pp; o = o * al + pp * v; m = mn;
}

__device__ __forceinline__ void naive_mix0(const Params& p) {
    const int lane = threadIdx.x & 63, wave = threadIdx.x >> 6;
    const bf16_t* P = (const bf16_t*)(p.ws + WS_P);
    bf16_t* Y = (bf16_t*)(p.ws + WS_Y);
    float* Hf = (float*)(p.ws + WS_HF);
    for (size_t e = (size_t)blockIdx.x * 512 + threadIdx.x; e < (size_t)NCTX * 512; e += (size_t)gridDim.x * 512) {
        const size_t row = e >> 9; const int c = (int)(e & 511);
        p.out[O_NAK + e] = bf2f(P[row * 3072 + 512 + c]); p.out[O_NAV + e] = bf2f(P[row * 3072 + 1024 + c]);
    }
    const float* rpb = p.in[13];
    for (int wi = blockIdx.x * 8 + wave; wi < 98304; wi += gridDim.x * 8) {
        const bool lat = wi >= 32768; int b, h, t, tok;
        if (!lat) { b = wi >> 11; h = (wi >> 8) & 7; t = wi & 255; tok = b * 256 + t; }
        else { const int j = wi - 32768; b = j >> 13; h = (j >> 10) & 7; t = j & 1023; tok = NCTX + b * 1024 + t; }
        const float qd = bf2f(P[(size_t)tok * 3072 + h * 64 + lane]) * 0.125f;
        float m = -1e30f, l = 0.f, o = 0.f;
        if (!lat) {
            for (int j = 0; j < 256; ++j) { const size_t kr = (size_t)(b * 256 + j) * 3072 + h * 64 + lane;
                const float s = wave_sum(qd * bf2f(P[kr + 512])); sm_step(s, bf2f(P[kr + 1024]), o, m, l); }
        } else {
            const int r = t >> 6, qc = t & 63;
            const int rs = min(max(r - 4, 0), 8), cs = min(max(qc - 8, 0), 48);
            for (int wr_ = 0; wr_ < 8; ++wr_) for (int kc = cs; kc < cs + 16; ++kc) {
                const int krow = rs + wr_;
                const size_t kr = (size_t)(NCTX + b * 1024 + krow * 64 + kc) * 3072 + h * 64 + lane;
                const float bias = rpb[(h * 15 + (krow - r + 7)) * 31 + (kc - qc + 15)];
                const float s = wave_sum(qd * bf2f(P[kr + 512])) + bias; sm_step(s, bf2f(P[kr + 1024]), o, m, l); }
            const float* ck = p.in[3]; const float* cv = p.in[4];
            for (int j = 0; j < 256; ++j) { const size_t kr = ((size_t)(b * 256 + j) * 8 + h) * 64 + lane;
                const float s = wave_sum(qd * ck[kr]); sm_step(s, cv[kr], o, m, l); }
        }
        const float ga = bf2f(P[(size_t)tok * 3072 + 1536 + h * 64 + lane]);
        Y[(size_t)tok * 1024 + h * 64 + lane] = f2bf(o / l * silu_f(ga));
    }
    for (int wi = blockIdx.x * 8 + wave; wi < 192; wi += gridDim.x * 8) {
        const int s = wi >> 3, n = wi & 7; const bool lat = s >= 16;
        const int T = lat ? 1024 : 256, tok0 = lat ? NCTX + (s - 16) * 1024 : s * 256, ch = n * 64 + lane;
        float cw[4];
#pragma unroll
        for (int j = 0; j < 4; ++j) cw[j] = p.in[14][j * 512 + ch];
        const float cb = p.in[15][ch];
        for (int dir = 0; dir < 2; ++dir) {
            float wa[64], wx[64];
#pragma unroll
            for (int c = 0; c < 64; ++c) { wa[c] = p.in[16][((dir * 8 + n) * 64 + c) * 64 + lane]; wx[c] = p.in[18][((dir * 8 + n) * 64 + c) * 64 + lane]; }
            const float ba = p.in[17][dir * 512 + ch], bx = p.in[19][dir * 512 + ch], lamv = p.in[20][dir * 512 + ch];
            const float nl = -8.0f * log1pf(__expf(-lamv));
            float hst = lat ? p.in[5][((s - 16) * 2 + dir) * 512 + ch] : 0.f;
            for (int pp = 0; pp < T; ++pp) {
                const int t = dir ? T - 1 - pp : pp;
                float xc = cb;
#pragma unroll
                for (int j = 0; j < 4; ++j) { const int tt = t - 2 + j; if (tt >= 0 && tt < T) xc += cw[j] * bf2f(P[(size_t)(tok0 + tt) * 3072 + 2048 + ch]); }
                float pa = ba, px = bx;
#pragma unroll
                for (int c = 0; c < 64; ++c) { const float xv = __shfl(xc, c); pa += xv * wa[c]; px += xv * wx[c]; }
                const float rr = sigmoid_f(pa), ii = sigmoid_f(px), la = rr * nl;
                const float a = __expf(la), uu = sqrtf(-expm1f(2.0f * la)) * (ii * xc);
                hst = a * hst + uu;
                if (dir == 0) Hf[(size_t)(tok0 + t) * 512 + ch] = hst;
                else { const float gb = bf2f(P[(size_t)(tok0 + t) * 3072 + 2560 + ch]);
                    Y[(size_t)(tok0 + t) * 1024 + 512 + ch] = f2bf((Hf[(size_t)(tok0 + t) * 512 + ch] + hst) * silu_f(gb)); }
            }
            if (!lat) p.out[O_LRU + (s * 2 + dir) * 512 + ch] = hst;
        }
    }
}

__device__ __forceinline__ float rope_lane(float x, int lane, int t, const float* rc) {
    const int pos = (lane & 32) ? (t & 63) : (t >> 6), i = lane & 15;
    const float c = rc[pos * 16 + i], s = rc[1024 + pos * 16 + i];
    const float other = __shfl_xor(x, 16);
    return (lane & 16) ? (x * c + other * s) : (x * c - other * s);
}

__device__ __forceinline__ void naive_mix1(const Params& p) {
    const int lane = threadIdx.x & 63, wave = threadIdx.x >> 6;
    const bf16_t* P = (const bf16_t*)(p.ws + WS_P);
    bf16_t* Y = (bf16_t*)(p.ws + WS_Y);
    const float* rc = (const float*)(p.ws + WS_ROPE);
    for (size_t e = (size_t)blockIdx.x * 512 + threadIdx.x; e < (size_t)NCTX * 1024; e += (size_t)gridDim.x * 512) {
        const size_t row = e >> 10; const int c = (int)(e & 1023);
        p.out[O_DK + e] = bf2f(P[row * 4096 + 1024 + c]); p.out[O_DV + e] = bf2f(P[row * 4096 + 2048 + c]);
    }
    const float lam = __expf(wave_sum(p.in[26][lane] * p.in[27][lane])) - __expf(wave_sum(p.in[28][lane] * p.in[29][lane])) + LAM_INIT;
    for (int wi = blockIdx.x * 8 + wave; wi < 98304; wi += gridDim.x * 8) {
        const bool lat = wi >= 32768; int b, h, t, tok;
        if (!lat) { b = wi >> 11; h = (wi >> 8) & 7; t = wi & 255; tok = b * 256 + t; }
        else { const int j = wi - 32768; b = j >> 13; h = (j >> 10) & 7; t = j & 1023; tok = NCTX + b * 1024 + t; }
        float q1 = bf2f(P[(size_t)tok * 4096 + h * 128 + lane]), q2 = bf2f(P[(size_t)tok * 4096 + h * 128 + 64 + lane]);
        if (lat) { q1 = rope_lane(q1, lane, t, rc); q2 = rope_lane(q2, lane, t, rc); }
        q1 *= 0.125f; q2 *= 0.125f;
        float m1 = -1e30f, l1 = 0.f, m2 = -1e30f, l2 = 0.f, o1a = 0.f, o1b = 0.f, o2a = 0.f, o2b = 0.f;
        if (lat) {
            const float* ck = p.in[6]; const float* cv = p.in[7];
            for (int j = 0; j < 256; ++j) { const size_t kr = ((size_t)(b * 256 + j) * 8 + h) * 128 + lane;
                const float s1 = wave_sum(q1 * ck[kr]), s2 = wave_sum(q2 * ck[kr + 64]);
                const float va = cv[kr], vb = cv[kr + 64];
                { const float mn = fmaxf(m1, s1), al = __expf(m1 - mn), pp = __expf(s1 - mn); l1 = l1 * al + pp; o1a = o1a * al + pp * va; o1b = o1b * al + pp * vb; m1 = mn; }
                { const float mn = fmaxf(m2, s2), al = __expf(m2 - mn), pp = __expf(s2 - mn); l2 = l2 * al + pp; o2a = o2a * al + pp * va; o2b = o2b * al + pp * vb; m2 = mn; } }
        }
        const int nk = lat ? 1024 : 256, ktok0 = lat ? NCTX + b * 1024 : b * 256;
        for (int j = 0; j < nk; ++j) { const size_t kr = (size_t)(ktok0 + j) * 4096 + h * 128 + lane;
            float k1 = bf2f(P[kr + 1024]), k2 = bf2f(P[kr + 1024 + 64]);
            if (lat) { k1 = rope_lane(k1, lane, j, rc); k2 = rope_lane(k2, lane, j, rc); }
            const float s1 = wave_sum(q1 * k1), s2 = wave_sum(q2 * k2);
            const float va = bf2f(P[kr + 2048]), vb = bf2f(P[kr + 2048 + 64]);
            { const float mn = fmaxf(m1, s1), al = __expf(m1 - mn), pp = __expf(s1 - mn); l1 = l1 * al + pp; o1a = o1a * al + pp * va; o1b = o1b * al + pp * vb; m1 = mn; }
            { const float mn = fmaxf(m2, s2), al = __expf(m2 - mn), pp = __expf(s2 - mn); l2 = l2 * al + pp; o2a = o2a * al + pp * va; o2b = o2b * al + pp * vb; m2 = mn; } }
        const float oa = o1a / l1 - lam * o2a / l2, ob = o1b / l1 - lam * o2b / l2;
        const float ss = wave_sum(oa * oa + ob * ob);
        const float rstd = rsqrtf(ss * (1.0f / 128.0f) + 1e-6f) * (1.0f - LAM_INIT);
        const float ga = bf2f(P[(size_t)tok * 4096 + 3072 + h * 128 + lane]), gb = bf2f(P[(size_t)tok * 4096 + 3072 + h * 128 + 64 + lane]);
        Y[(size_t)tok * 1024 + h * 128 + lane] = f2bf(oa * rstd * p.in[30][lane] * silu_f(ga));
        Y[(size_t)tok * 1024 + h * 128 + 64 + lane] = f2bf(ob * rstd * p.in[30][64 + lane] * silu_f(gb));
    }
}

__global__ void __launch_bounds__(512) mega(Params p) {
    extern __shared__ __attribute__((aligned(16))) unsigned char smem[];
    cg::grid_group grid = cg::this_grid();
    PG8_LAS unsigned char* lds = (PG8_LAS unsigned char*)smem;
    const float* mod = (const float*)(p.ws + WS_MOD);
    pg8::StaticOrder S;
    phaseA(p, (float*)smem);
    grid.sync();
    phase_norm(p, 0, p.in[0], p.in[1]);
    grid.sync();
    { pg8::Gemm g{(const bf16_t*)(p.ws + WS_H), (const bf16_t*)(p.ws + WS_W1T), NTOK, 3072, 1024}; S.init(NTOK, 3072, (int)gridDim.x, (int)blockIdx.x);
      pg8::EpiBf16<0> E{(bf16_t*)(p.ws + WS_P), 3072, nullptr, 0, 0};
      pg8::gemm_phase<pg8::EpiBf16<0>, pg8::StaticOrder, false>(lds, g, S, E, nullptr); }
    grid.sync();
    naive_mix0(p);
    grid.sync();
    { pg8::Gemm g{(const bf16_t*)(p.ws + WS_Y), (const bf16_t*)(p.ws + WS_W2T), NTOK, 1024, 1024}; S.init(NTOK, 1024, (int)gridDim.x, (int)blockIdx.x);
      EpiRes E{p.in[0], p.in[1], p.out, mod + 2048};
      pg8::gemm_phase<EpiRes, pg8::StaticOrder, false>(lds, g, S, E, nullptr); }
    grid.sync();
    phase_norm(p, 1, p.out, p.out + (size_t)NCTX * 1024);
    grid.sync();
    { pg8::Gemm g{(const bf16_t*)(p.ws + WS_H), (const bf16_t*)(p.ws + WS_W3T), NTOK, 4096, 1024}; S.init(NTOK, 4096, (int)gridDim.x, (int)blockIdx.x);
      pg8::EpiBf16<0> E{(bf16_t*)(p.ws + WS_P), 4096, nullptr, 0, 0};
      pg8::gemm_phase<pg8::EpiBf16<0>, pg8::StaticOrder, false>(lds, g, S, E, nullptr); }
    grid.sync();
    naive_mix1(p);
    grid.sync();
    { pg8::Gemm g{(const bf16_t*)(p.ws + WS_Y), (const bf16_t*)(p.ws + WS_W4T), NTOK, 1024, 1024}; S.init(NTOK, 1024, (int)gridDim.x, (int)blockIdx.x);
      EpiRes E{p.out, p.out + (size_t)NCTX * 1024, p.out, mod + 9 * 3072 + 2048};
      pg8::gemm_phase<EpiRes, pg8::StaticOrder, false>(lds, g, S, E, nullptr); }
    grid.sync();
    phase_final(p);
}

extern "C" void kernel_launch(void* const* d_in, const int* in_sizes, int n_in, void* d_out, int out_size, void* d_ws, size_t ws_size, hipStream_t stream) {
    static int grid_blocks = 0;
    if (!grid_blocks) {
        int dev = 0, cus = 0, per_cu = 0;
        (void)hipGetDevice(&dev);
        (void)hipDeviceGetAttribute(&cus, hipDeviceAttributeMultiprocessorCount, dev);
        (void)hipFuncSetAttribute((const void*)mega, hipFuncAttributeMaxDynamicSharedMemorySize, LDS_BYTES);
        (void)hipOccupancyMaxActiveBlocksPerMultiprocessor(&per_cu, (const void*)mega, 512, LDS_BYTES);
        if (per_cu < 1) { fprintf(stderr, "occupancy query says %d\n", per_cu); per_cu = 1; }
        grid_blocks = cus;
        if (ws_size < WS_END) fprintf(stderr, "workspace too small: %zu < %zu\n", ws_size, (size_t)WS_END);
    }
    Params p{};
    for (int i = 0; i < 33; ++i) p.in[i] = (const float*)d_in[i];
    p.out = (float*)d_out; p.ws = (unsigned char*)d_ws;
    void* args[] = {&p};
    hipError_t e = hipLaunchCooperativeKernel((void*)mega, dim3(grid_blocks), dim3(512), args, LDS_BYTES, stream);
    if (e != hipSuccess) fprintf(stderr, "cooperative launch failed: %s (grid %d)\n", hipGetErrorString(e), grid_blocks);
}
```

```cpp
#include <hip/hip_runtime.h>
#include <hip/hip_cooperative_groups.h>
#include <cstdio>
#include <cstdint>
namespace cg = cooperative_groups;
__device__ __forceinline__ int tidx() { int t = threadIdx.x; asm volatile("" : "+v"(t)); return t; }
namespace pg8 {
#define PG8_LAS __attribute__((address_space(3)))
typedef unsigned short bf16_t;
typedef short bf16x8 __attribute__((ext_vector_type(8)));
typedef float f32x4 __attribute__((ext_vector_type(4)));
typedef unsigned u32x4 __attribute__((ext_vector_type(4)));
constexpr int BM = 256, BK = 64, HALF = 128, HTB = HALF * BK * 2  , STAGE_BYTES = 8 * HTB, NXCD = 8, WGM = 8;

__host__ __device__ __forceinline__ int lds_byte(int r, int c) { const int st = (r >> 4) * 2 + (c >> 5), rr = r & 15, cc = c & 31, ob = rr * 64 + cc * 2; return st * 1024 + (ob ^ (((ob >> 9) & 1) << 5)); }
__host__ __device__ __forceinline__ void stage_rc(int b, int& R, int& C) { const int st = b / 1024, sb = b % 1024, swz = sb ^ (((sb >> 9) & 1) << 5); R = (st >> 1) * 16 + swz / 64; C = (st & 1) * 32 + (swz % 64) / 2; }
__host__ __device__ __forceinline__ int perm32(int rho) { const int n = rho >> 4, i = rho & 15; return 8 * (i >> 2) + 4 * n + (i & 3); }

struct Unit { int pm, pn; };
struct Gemm { const bf16_t* A; const bf16_t* Bt; int M, N, K; };

struct StaticOrder {
    int nM, nN, nwg, G, c;
    __host__ __device__ void init(int M, int N, int G_, int c_) { nM = M / BM; nN = N / BM; nwg = nM * nN; G = G_; c = c_; }
    __host__ __device__ bool next(int i, Unit& u) const {
        const long L = (long)i * G + c; if (L >= nwg) return false;
        int wgid = (int)L; { const int q = nwg / NXCD, r = nwg % NXCD, xcd = wgid % NXCD, off = wgid / NXCD; wgid = (xcd < r ? xcd * (q + 1) : r * (q + 1) + (xcd - r) * q) + off; }
        const int nig = WGM * nN, gid = wgid / nig, fm = gid * WGM, gsz = (nM - fm) < WGM ? (nM - fm) : WGM;
        u.pm = fm + ((wgid % nig) % gsz); u.pn = (wgid % nig) / gsz; return true;
    }
    __device__ __forceinline__ void a_ready(const Unit&) const {}
    __device__ __forceinline__ void done(const Unit&) const {}
};

__device__ __forceinline__ unsigned cvt_pk_bf16(float lo, float hi) { unsigned r; asm volatile("v_cvt_pk_bf16_f32 %0, %1, %2" : "=v"(r) : "v"(lo), "v"(hi)); return r; }
template <int ACT  > struct EpiBf16 {
    static constexpr bool PERM = true, AFTER_DRAIN = false;
    bf16_t* O; int ldc; const float* bias; int split_cols; size_t split_stride;
    __device__ __forceinline__ void operator()(const f32x4 (&acc)[2][2][4][2], const Unit& u, int wr, int wc, int fr, int fq) const {
        const int row0 = u.pm * BM + wr * 64 + fr; int colt = u.pn * BM; bf16_t* base = O;
        if (split_cols) { const int t = colt / split_cols; base += (size_t)t * split_stride; colt -= t * split_cols; }
        const int col0 = colt + wc * 32 + 8 * fq, bcol0 = u.pn * BM + wc * 32 + 8 * fq;
        f32x4 bv[2][2];
#pragma unroll
        for (int bj = 0; bj < 2; ++bj)
#pragma unroll
            for (int n = 0; n < 2; ++n) bv[bj][n] = bias ? *(const f32x4*)(bias + bcol0 + bj * HALF + 4 * n) : (f32x4){0.f, 0.f, 0.f, 0.f};
#pragma unroll
        for (int ai = 0; ai < 2; ++ai)
#pragma unroll
            for (int m = 0; m < 4; ++m) { bf16_t* rowp = base + (size_t)(row0 + ai * HALF + m * 16) * ldc + col0;
#pragma unroll
                for (int bj = 0; bj < 2; ++bj) { f32x4 v0 = acc[ai][bj][m][0] + bv[bj][0], v1 = acc[ai][bj][m][1] + bv[bj][1];
                    u32x4 w; w.x = cvt_pk_bf16(v0[0], v0[1]); w.y = cvt_pk_bf16(v0[2], v0[3]); w.z = cvt_pk_bf16(v1[0], v1[1]); w.w = cvt_pk_bf16(v1[2], v1[3]);
                    *(u32x4*)(rowp + bj * HALF) = w; } }
    }
};

template <class Epi, class Sched, bool STAMP = false>
__device__ __forceinline__ void gemm_phase(PG8_LAS unsigned char* lds, const Gemm g, const Sched& S, const Epi& E, unsigned long long* stamps) {
    const int tid = tidx(), wid = __builtin_amdgcn_readfirstlane(tid >> 6), lane = tid & 63, wr = wid >> 2, wc = wid & 3, fr = lane & 15, fq = lane >> 4;
    const int K = g.K, nt = K / BK;
    int ts_lo = 0, ts_hi = 0, nts = 0; const unsigned long long rt_entry = STAMP ? (unsigned long long)wall_clock64() : 0ull;
#define PG8_STAMP() do { if (STAMP && wid == 0 && nts < 64) { const unsigned long long _c = (unsigned long long)clock64(); \
        ts_lo = (lane == nts) ? (int)(unsigned)_c : ts_lo; ts_hi = (lane == nts) ? (int)(unsigned)(_c >> 32) : ts_hi; ++nts; } } while (0)
    PG8_STAMP();
    unsigned voffA[2], voffB[2];
#pragma unroll
    for (int i = 0; i < 2; ++i) { int R, C; stage_rc(tid * 16 + i * 8192, R, C); const int Rb = Epi::PERM ? ((R & ~31) + perm32(R & 31)) : R;
        voffA[i] = (unsigned)(R * K + C) * 2u; voffB[i] = (unsigned)(Rb * K + C) * 2u; }
    const size_t kstep = (size_t)(BK * 2);
    const size_t hstep = (size_t)HALF * K * 2;
    const size_t tstep = 2 * hstep;
    const unsigned ldsw = (unsigned)wid * 1024u;
    const int aoff = lds_byte(wr * 64 + fr, fq * 8), boff = lds_byte(wc * 32 + fr, fq * 8);
#define PG8_SA(b, h) (((b) * 2 + (h)) * HTB)
#define PG8_SB(b, h) ((4 + (b) * 2 + (h)) * HTB)
#define PG8_STAGE(bufoff, gbase, voff) do { _Pragma("unroll") for (int _i = 0; _i < 2; ++_i) \
        __builtin_amdgcn_global_load_lds((const unsigned*)((const char*)(gbase) + (voff)[_i]), (PG8_LAS unsigned*)(lds + (bufoff) + ldsw + _i * 8192), 16, 0, 0); } while (0)
#define PG8_LDA(dst, b, h) do { _Pragma("unroll") for (int m = 0; m < 4; ++m) _Pragma("unroll") for (int k = 0; k < 2; ++k) dst[m][k] = *(const PG8_LAS bf16x8*)(lds + PG8_SA(b, h) + aoff + m * 2048 + k * 1024); } while (0)
#define PG8_LDB(dst, b, h) do { _Pragma("unroll") for (int n = 0; n < 2; ++n) _Pragma("unroll") for (int k = 0; k < 2; ++k) dst[n][k] = *(const PG8_LAS bf16x8*)(lds + PG8_SB(b, h) + boff + n * 2048 + k * 1024); } while (0)
#define PG8_MMA(ai, bj, At, Bt) do { __builtin_amdgcn_s_setprio(1); _Pragma("unroll") for (int m = 0; m < 4; ++m) _Pragma("unroll") for (int n = 0; n < 2; ++n) _Pragma("unroll") for (int k = 0; k < 2; ++k) \
        acc[ai][bj][m][n] = __builtin_amdgcn_mfma_f32_16x16x32_bf16(Bt[n][k], At[m][k], acc[ai][bj][m][n], 0, 0, 0); __builtin_amdgcn_s_setprio(0); } while (0)
#define PG8_WAIT_V(n) asm volatile("s_waitcnt vmcnt(" #n ")" ::: "memory")
#define PG8_WAIT_L(n) asm volatile("s_waitcnt lgkmcnt(" #n ")" ::: "memory")
#define PG8_BAR __builtin_amdgcn_s_barrier()
#define PG8_SCHED __builtin_amdgcn_sched_barrier(0)
    Unit cur, nxt; int ui = 0;
    if (!S.next(0, cur)) return;
    f32x4 acc[2][2][4][2];
#pragma unroll
    for (int a = 0; a < 2; ++a)
#pragma unroll
        for (int b = 0; b < 2; ++b)
#pragma unroll
            for (int m = 0; m < 4; ++m)
#pragma unroll
                for (int n = 0; n < 2; ++n) acc[a][b][m][n] = (f32x4){0.f, 0.f, 0.f, 0.f};
    bf16x8 At[4][2], B0[2][2], B1[2][2];
    const char* cA = (const char*)g.A + (size_t)cur.pm * tstep; const char* cB = (const char*)g.Bt + (size_t)cur.pn * tstep;
    S.a_ready(cur);
    PG8_STAGE(PG8_SB(0, 0), cB, voffB); PG8_STAGE(PG8_SA(0, 0), cA, voffA); PG8_STAGE(PG8_SB(0, 1), cB + hstep, voffB); PG8_STAGE(PG8_SA(0, 1), cA + hstep, voffA);
    if (wr == 1) PG8_BAR;
    PG8_WAIT_V(4); PG8_BAR;
    PG8_STAGE(PG8_SB(1, 0), cB + kstep, voffB); PG8_STAGE(PG8_SA(1, 0), cA + kstep, voffA); PG8_STAGE(PG8_SB(1, 1), cB + hstep + kstep, voffB);
    PG8_WAIT_V(6); PG8_BAR;
    PG8_STAMP();
    for (;;) {
        const bool has_next = S.next(ui + 1, nxt);
        const char* nA = has_next ? (const char*)g.A + (size_t)nxt.pm * tstep : cA; const char* nB = has_next ? (const char*)g.Bt + (size_t)nxt.pn * tstep : cB;
        for (int t = 0; t < nt; t += 2) {
            const bool last = (t == nt - 2);
            const char* a1 = cA + (size_t)(t + 1) * kstep;
            const char* a2 = last ? nA : cA + (size_t)(t + 2) * kstep; const char* b2 = last ? nB : cB + (size_t)(t + 2) * kstep;
            const char* a3 = a2 + kstep; const char* b3 = b2 + kstep;
            if (last && has_next) S.a_ready(nxt);
            PG8_LDB(B0, 0, 0); PG8_SCHED; PG8_LDA(At, 0, 0); PG8_STAGE(PG8_SA(1, 1), a1 + hstep, voffA);
            PG8_WAIT_L(8); PG8_BAR; PG8_WAIT_L(0); PG8_MMA(0, 0, At, B0); PG8_BAR; PG8_SCHED;
            PG8_LDB(B1, 0, 1); PG8_STAGE(PG8_SB(0, 0), b2, voffB);
            PG8_BAR; PG8_WAIT_L(0); PG8_MMA(0, 1, At, B1); PG8_BAR;
            PG8_LDA(At, 0, 1); PG8_STAGE(PG8_SA(0, 0), a2, voffA);
            PG8_BAR; PG8_WAIT_L(0); PG8_MMA(1, 0, At, B0); PG8_BAR; PG8_SCHED;
            PG8_STAGE(PG8_SB(0, 1), b2 + hstep, voffB);
            PG8_WAIT_V(6); PG8_BAR; PG8_MMA(1, 1, At, B1); PG8_BAR;
            PG8_LDB(B0, 1, 0); PG8_SCHED; PG8_LDA(At, 1, 0); PG8_STAGE(PG8_SA(0, 1), a2 + hstep, voffA);
            PG8_WAIT_L(8); PG8_BAR; PG8_WAIT_L(0); PG8_MMA(0, 0, At, B0); PG8_BAR; PG8_SCHED;
            PG8_LDB(B1, 1, 1); PG8_STAGE(PG8_SB(1, 0), b3, voffB);
            PG8_BAR; PG8_WAIT_L(0); PG8_MMA(0, 1, At, B1); PG8_BAR;
            PG8_LDA(At, 1, 1); PG8_STAGE(PG8_SA(1, 0), a3, voffA);
            PG8_BAR; PG8_WAIT_L(0); PG8_MMA(1, 0, At, B0); PG8_BAR; PG8_SCHED;
            PG8_STAGE(PG8_SB(1, 1), b3 + hstep, voffB);
            PG8_WAIT_V(6); PG8_BAR; PG8_MMA(1, 1, At, B1); PG8_BAR;
        }
        PG8_STAMP();
        if constexpr (!Epi::AFTER_DRAIN) { E(acc, cur, wr, wc, fr, fq); S.done(cur); }
        PG8_STAMP();
        if (!has_next) break;
#pragma unroll
        for (int a = 0; a < 2; ++a)
#pragma unroll
            for (int b = 0; b < 2; ++b)
#pragma unroll
                for (int m = 0; m < 4; ++m)
#pragma unroll
                    for (int n = 0; n < 2; ++n) acc[a][b][m][n] = (f32x4){0.f, 0.f, 0.f, 0.f};
        cur = nxt; cA = nA; cB = nB; ++ui;
    }
    PG8_WAIT_V(0);
    if (wr == 0) PG8_BAR;
    PG8_BAR;
    if constexpr (Epi::AFTER_DRAIN) { E.fused(acc, cur, wr, wc, fr, fq, lds, wid, lane); S.done(cur); }
    PG8_STAMP();
    if (STAMP && wid == 0) { stamps[lane] = lane < nts ? (((unsigned long long)(unsigned)ts_hi << 32) | (unsigned)ts_lo) : 0ull;
        if (lane == 62) stamps[62] = rt_entry; if (lane == 63) stamps[63] = (unsigned long long)wall_clock64(); }
#undef PG8_STAMP
#undef PG8_SA
#undef PG8_SB
#undef PG8_STAGE
#undef PG8_LDA
#undef PG8_LDB
#undef PG8_MMA
#undef PG8_WAIT_V
#undef PG8_WAIT_L
#undef PG8_BAR
#undef PG8_SCHED
}
}
using pg8::bf16_t; using pg8::bf16x8; using pg8::f32x4; using pg8::u32x4;
#define LAS __attribute__((address_space(3)))
typedef unsigned u32x2 __attribute__((ext_vector_type(2)));

constexpr int NTOK = 12288, NCTX = 4096;
constexpr int LDS_BYTES = 131072 + 64;
constexpr float LAM_INIT = 0.35550906759f;
constexpr size_t O_YP = 0, O_YS = 4194304, O_NAK = 12582912, O_NAV = 14680064, O_LRU = 16777216, O_DK = 16793600, O_DV = 20987904;

struct Params { const float* in[33]; float* out; unsigned char* ws; };

__device__ __forceinline__ float bf2f(bf16_t v) { return __uint_as_float(((unsigned)v) << 16); }
__device__ __forceinline__ bf16_t f2bf(float f) { unsigned u = __float_as_uint(f); u += 0x7FFFu + ((u >> 16) & 1u); return (bf16_t)(u >> 16); }
__device__ __forceinline__ unsigned pk2(float lo, float hi) { return (unsigned)f2bf(lo) | ((unsigned)f2bf(hi) << 16); }
__device__ __forceinline__ float silu_f(float x) { return x / (1.0f + __expf(-x)); }
__device__ __forceinline__ float sigmoid_f(float x) { return 1.0f / (1.0f + __expf(-x)); }
__device__ __forceinline__ float wave_sum(float v) {
#pragma unroll
    for (int o = 32; o >= 1; o >>= 1) v += __shfl_xor(v, o);
    return v;
}
#define XB_TMO      128
#define XB_XCNT(j)  (256  + 64 * (j))
#define XB_XSUB(j)  (1280 + 64 * (j))
#define XB_XGEN(j)  (2304 + 64 * (j))
#define XB_TOP      3328
#define XB_TOPGEN   3392
#define XCD_BAR_WORDS 3456
#define XB_SPIN_CAP (1u << 18)
#define LAS __attribute__((address_space(3)))
__device__ __forceinline__ unsigned xb_ld(unsigned* p)              { return __hip_atomic_load(p, __ATOMIC_RELAXED, __HIP_MEMORY_SCOPE_AGENT); }
__device__ __forceinline__ unsigned xb_add(unsigned* p, unsigned v) { return __hip_atomic_fetch_add(p, v, __ATOMIC_RELAXED, __HIP_MEMORY_SCOPE_AGENT); }
__device__ __forceinline__ unsigned xb_xcc_id() { return (unsigned)__builtin_amdgcn_s_getreg((3 << 11) | 20) & 0xFu; }
#define XB_SPIN(cond, bar) do { unsigned _sp = 0; while (cond) { __builtin_amdgcn_s_sleep(1); \
    if ((++_sp & 255u) == 0u) { if (xb_ld(&(bar)[XB_TMO])) break; if (_sp > XB_SPIN_CAP) { atomicAdd(&(bar)[XB_TMO], 1u); break; } } } } while (0)

struct XcdBarrier {
    unsigned* bar; unsigned x;
    volatile LAS unsigned* st;
};

__device__ __forceinline__ XcdBarrier xcd_barrier_post(unsigned* bar, volatile LAS unsigned* st) {
    XcdBarrier b; b.bar = bar; b.x = xb_xcc_id(); b.st = st;
    if (threadIdx.x == 0) (void)xb_add(&bar[XB_XCNT(b.x)], 1u);
    return b;
}
__device__ __forceinline__ void xcd_barrier_complete(unsigned* bar, unsigned x, unsigned& nloc, unsigned& nx) {
    const unsigned G = gridDim.x * gridDim.y * gridDim.z;
    unsigned sum, cnt, mine, sp = 0u;
    for (;;) {
        sum = 0u; cnt = 0u; mine = 0u;
#pragma unroll
        for (unsigned j = 0; j < 16; ++j) { const unsigned c = xb_ld(&bar[XB_XCNT(j)]); sum += c; cnt += (c > 0u) ? 1u : 0u; mine = (j == x) ? c : mine; }
        if (sum == G) break;
        __builtin_amdgcn_s_sleep(1);
        if ((++sp & 255u) == 0u) { if (xb_ld(&bar[XB_TMO])) break; if (sp > XB_SPIN_CAP) { atomicAdd(&bar[XB_TMO], 1u); break; } }
    }
    nloc = mine > 0u ? mine : 1u; nx = cnt > 0u ? cnt : 1u;
}

__device__ __forceinline__ void xcd_barrier(const XcdBarrier& b) {
    asm volatile("s_waitcnt vmcnt(0)" ::: "memory");
    __syncthreads();
    if (threadIdx.x == 0) {
        unsigned* bar = b.bar;
        __builtin_amdgcn_s_waitcnt(0);
        unsigned nloc = b.st[0], nx = b.st[1];
        if (nloc == 0u) { xcd_barrier_complete(bar, b.x, nloc, nx); b.st[0] = nloc; b.st[1] = nx; }
        const unsigned old = xb_add(&bar[XB_XSUB(b.x)], 1u);
        const unsigned gen = old / nloc;
        if (old + 1u == (gen + 1u) * nloc) {
            __builtin_amdgcn_fence(__ATOMIC_RELEASE, "agent");
            asm volatile("s_waitcnt vmcnt(0)" ::: "memory");
            const unsigned og = xb_add(&bar[XB_TOP], 1u);
            const unsigned tg = og / nx;
            if (og + 1u == (tg + 1u) * nx) xb_add(&bar[XB_TOPGEN], 1u);
            else XB_SPIN(xb_ld(&bar[XB_TOPGEN]) == tg, bar);
            __builtin_amdgcn_fence(__ATOMIC_ACQUIRE, "agent");
            xb_add(&bar[XB_XGEN(b.x)], 1u);
            asm volatile("s_waitcnt vmcnt(0)" ::: "memory");
        } else {
            XB_SPIN(xb_ld(&bar[XB_XGEN(b.x)]) == gen, bar);
            __builtin_amdgcn_fence(__ATOMIC_ACQUIRE, "agent");
            asm volatile("s_waitcnt vmcnt(0)" ::: "memory");
        }
    }
    __syncthreads();
}
constexpr size_t WS_MOD = 0;
constexpr size_t WS_ROPE = 229376;
constexpr size_t WS_WG = 262144;
constexpr size_t WS_W1T = WS_WG + 262144;
constexpr size_t WS_W2T = WS_W1T + 6291456;
constexpr size_t WS_W3T = WS_W2T + 2097152;
constexpr size_t WS_W4T = WS_W3T + 8388608;
constexpr size_t WS_H = WS_W4T + 2097152;
constexpr size_t WS_HF = WS_H;
constexpr size_t WS_P = WS_H + 25165824;
constexpr size_t WS_Y = WS_P + 50331648;
constexpr size_t WS_K0L = WS_Y + 25165824;
constexpr size_t WS_V0L = WS_K0L + 10485760;
constexpr size_t WS_K0C = WS_V0L + 10485760;
constexpr size_t WS_V0C = WS_K0C + 4194304;
constexpr size_t WS_K1L = WS_V0C + 4194304;
constexpr size_t WS_V1L = WS_K1L + 20971520;
constexpr size_t WS_K1C = WS_V1L + 20971520;
constexpr size_t WS_V1C = WS_K1C + 8388608;
constexpr size_t WS_X1B = WS_K0L;
constexpr size_t WS_X2B = WS_P;
constexpr size_t WS_BAR = WS_V1C + 8388608;
constexpr size_t WS_END = WS_BAR + 16384;

__device__ __forceinline__ void transpose_tile(const float* __restrict__ src, int lds_, bf16_t* __restrict__ dst, int ldd, int r0, int c0, float* sm) {
    const int tid = tidx();
    __syncthreads();
#pragma unroll
    for (int i = 0; i < 2; ++i) {
        const int r = (tid >> 4) + i * 32, c4 = (tid & 15) * 4;
        const float4 v = *(const float4*)(src + (size_t)(r0 + r) * lds_ + c0 + c4);
        sm[r * 65 + c4 + 0] = v.x; sm[r * 65 + c4 + 1] = v.y; sm[r * 65 + c4 + 2] = v.z; sm[r * 65 + c4 + 3] = v.w;
    }
    __syncthreads();
    const int c = tid >> 3, r8 = (tid & 7) * 8;
    u32x4 w;
    w.x = pk2(sm[(r8 + 0) * 65 + c], sm[(r8 + 1) * 65 + c]); w.y = pk2(sm[(r8 + 2) * 65 + c], sm[(r8 + 3) * 65 + c]);
    w.z = pk2(sm[(r8 + 4) * 65 + c], sm[(r8 + 5) * 65 + c]); w.w = pk2(sm[(r8 + 6) * 65 + c], sm[(r8 + 7) * 65 + c]);
    *(u32x4*)(dst + (size_t)(c0 + c) * ldd + r0 + r8) = w;
}

__device__ __forceinline__ void transpose_4tile(const float* __restrict__ src, int lds_, bf16_t* __restrict__ dst, int ldd, int r0, int c0, float* sm) {
    const int tid = tidx();
    float4 v[8];
#pragma unroll
    for (int i = 0; i < 8; ++i) { const int idx = tid + 512 * i, r = idx >> 6, c4 = (idx & 63) * 4; v[i] = *(const float4*)(src + (size_t)(r0 + r) * lds_ + c0 + c4); }
    __syncthreads();
#pragma unroll
    for (int i = 0; i < 8; ++i) { const int idx = tid + 512 * i, r = idx >> 6, c4 = (idx & 63) * 4;
        sm[r * 257 + c4 + 0] = v[i].x; sm[r * 257 + c4 + 1] = v[i].y; sm[r * 257 + c4 + 2] = v[i].z; sm[r * 257 + c4 + 3] = v[i].w; }
    __syncthreads();
    const int c = tid >> 1, rh = (tid & 1) * 32;
#pragma unroll
    for (int q = 0; q < 4; ++q) { const int rb = rh + q * 8; u32x4 w;
        w.x = pk2(sm[(rb + 0) * 257 + c], sm[(rb + 1) * 257 + c]); w.y = pk2(sm[(rb + 2) * 257 + c], sm[(rb + 3) * 257 + c]);
        w.z = pk2(sm[(rb + 4) * 257 + c], sm[(rb + 5) * 257 + c]); w.w = pk2(sm[(rb + 6) * 257 + c], sm[(rb + 7) * 257 + c]);
        *(u32x4*)(dst + (size_t)(c0 + c) * ldd + r0 + rb) = w; }
}

constexpr int A1_TOTAL = 192 + 32 + 1;
__device__ __forceinline__ void phaseA(const Params& p, float* sm) {
    const int tid = tidx();
    float* mod = (float*)(p.ws + WS_MOD);
    for (int it = blockIdx.x; it < 192; it += gridDim.x) {
        {
            const int layer = it / 96, col0 = (it % 96) * 32;
            const float* W = p.in[layer ? 23 : 10]; const float* Bv = p.in[layer ? 24 : 11];
            const int col = tid & 31, kp = tid >> 5;
            float wv[32];
#pragma unroll
            for (int u = 0; u < 32; ++u) wv[u] = *(const float*)((const char*)W + (unsigned)(((kp * 64 + u) * 3072 + col0 + col) * 4));
            __syncthreads();
            for (int e = tid; e < 9 * 1024; e += 512) { const float cvv = e < 1024 ? p.in[8][e] : p.in[2][e - 1024]; sm[e] = silu_f(cvv); }
            __syncthreads();
            float acc[9];
#pragma unroll
            for (int v = 0; v < 9; ++v) acc[v] = 0.f;
#pragma unroll
            for (int hb = 0; hb < 2; ++hb) {
                float wn[32];
                if (hb == 0) {
#pragma unroll
                    for (int u = 0; u < 32; ++u) wn[u] = *(const float*)((const char*)W + (unsigned)(((kp * 64 + 32 + u) * 3072 + col0 + col) * 4));
                }
#pragma unroll
                for (int u = 0; u < 32; ++u)
#pragma unroll
                    for (int v = 0; v < 9; ++v) acc[v] += sm[v * 1024 + kp * 64 + hb * 32 + u] * wv[u];
                if (hb == 0) {
#pragma unroll
                    for (int u = 0; u < 32; ++u) wv[u] = wn[u];
                }
            }
            __syncthreads();
#pragma unroll
            for (int v = 0; v < 9; ++v) sm[9216 + (kp * 9 + v) * 32 + col] = acc[v];
            __syncthreads();
            if (tid < 288) { const int v = tid >> 5, c = tid & 31; float s = Bv[col0 + c];
                for (int k2 = 0; k2 < 16; ++k2) s += sm[9216 + (k2 * 9 + v) * 32 + c];
                mod[(layer * 9 + v) * 3072 + col0 + c] = s; }
        }
    }
}
__device__ __forceinline__ void phaseA1b(const Params& p, float* sm) {
    const int tid = tidx();
    for (int it = blockIdx.x; it < A1_TOTAL; it += gridDim.x) {
        int t = it;
        if (t < 192) { transpose_4tile(p.in[12], 3072, (bf16_t*)(p.ws + WS_W1T), 1024, (t / 12) * 64, (t % 12) * 256, sm); continue; }
        t -= 192;
        if (t < 32) {
            const int gate = t >> 4, dn = t & 15;
            transpose_tile(p.in[gate ? 18 : 16] + (size_t)dn * 4096, 64, (bf16_t*)(p.ws + WS_WG) + (size_t)(((dn >> 3) * 2 + gate) * 8 + (dn & 7)) * 4096, 64, 0, 0, sm);
            continue;
        }
        {
            float* rc = (float*)(p.ws + WS_ROPE);
            for (int e = tid; e < 1024; e += 512) { const int pos = e >> 4, i = e & 15; const float inv = powf(10000.0f, -(float)i / 16.0f); const float ang = (float)pos * inv;
                rc[e] = cosf(ang); rc[1024 + e] = sinf(ang); }
        }
    }
}

constexpr int A2_TOTAL = 64 + 64 + 128 + 128 + 64 + 256 + 64;
__device__ __forceinline__ void phaseA2(const Params& p, float* sm, int first, int stride) {
    const int tid = tidx();
    for (int it = first; it < A2_TOTAL; it += stride) {
        int t = it;
        if (t < 384) {
            int which; if (t < 64) which = 0; else if (t < 128) { which = 1; t -= 64; } else if (t < 256) { which = 2; t -= 128; } else { which = 3; t -= 256; }
            const float* src = p.in[which == 0 ? 3 : which == 1 ? 4 : which == 2 ? 6 : 7];
            bf16_t* dst = (bf16_t*)(p.ws + (which == 0 ? WS_K0L : which == 1 ? WS_V0L : which == 2 ? WS_K1L : WS_V1L));
            const int W = which < 2 ? 512 : 1024;
            float4 v[8];
#pragma unroll
            for (int i = 0; i < 8; ++i) v[i] = *(const float4*)(src + (size_t)t * 16384 + i * 2048 + tid * 4);
            __builtin_amdgcn_sched_barrier(0);
#pragma unroll
            for (int i = 0; i < 8; ++i) { const size_t e = (size_t)t * 16384 + i * 2048 + tid * 4;
                const size_t row = e / W; const int c = (int)(e % W); const size_t b = row >> 8, j = row & 255;
                u32x2 w; w.x = pk2(v[i].x, v[i].y); w.y = pk2(v[i].z, v[i].w);
                *(u32x2*)(dst + (b * 1280 + j) * W + c) = w; }
            continue; }
        t -= 384;
        if (t < 64) { transpose_4tile(p.in[21], 1024, (bf16_t*)(p.ws + WS_W2T), 1024, (t / 4) * 64, (t % 4) * 256, sm); continue; }
        t -= 64;
        if (t < 256) { transpose_4tile(p.in[25], 4096, (bf16_t*)(p.ws + WS_W3T), 1024, (t / 16) * 64, (t % 16) * 256, sm); continue; }
        t -= 256;
        transpose_4tile(p.in[31], 1024, (bf16_t*)(p.ws + WS_W4T), 1024, (t / 4) * 64, (t % 4) * 256, sm);
    }
}

__device__ __forceinline__ void phase_norm(const Params& p, int layer, const float* xa, const float* xb_) {
    const int lane = tidx() & 63, wave = tidx() >> 6;
    const float* g = p.in[layer ? 22 : 9];
    const float* mod = (const float*)(p.ws + WS_MOD) + layer * 9 * 3072;
    bf16_t* H = (bf16_t*)(p.ws + WS_H);
    float4 gg[4];
#pragma unroll
    for (int i = 0; i < 4; ++i) gg[i] = *(const float4*)(g + i * 256 + lane * 4);
    const int stride = gridDim.x * 8;
    for (int row0 = blockIdx.x * 8 + wave; row0 < NTOK; row0 += 3 * stride) {
        float4 v[3][4], sh[3][4], sc[3][4];
#pragma unroll
        for (int k = 0; k < 3; ++k) { const int row = min(row0 + k * stride, NTOK - 1);
            const float* xr = row < NCTX ? xa + (size_t)row * 1024 : xb_ + (size_t)(row - NCTX) * 1024;
            const float* mv = mod + (row < NCTX ? 0 : 1 + ((row - NCTX) >> 10)) * 3072;
#pragma unroll
            for (int i = 0; i < 4; ++i) { v[k][i] = *(const float4*)(xr + i * 256 + lane * 4); sh[k][i] = *(const float4*)(mv + i * 256 + lane * 4); sc[k][i] = *(const float4*)(mv + 1024 + i * 256 + lane * 4); } }
#pragma unroll
        for (int k = 0; k < 3; ++k) { const int row = row0 + k * stride;
            if (row < NTOK) {
                float ss = 0.f;
#pragma unroll
                for (int i = 0; i < 4; ++i) ss += v[k][i].x * v[k][i].x + v[k][i].y * v[k][i].y + v[k][i].z * v[k][i].z + v[k][i].w * v[k][i].w;
                ss = wave_sum(ss);
                const float rstd = rsqrtf(ss * (1.0f / 1024.0f) + 1e-6f);
#pragma unroll
                for (int i = 0; i < 4; ++i) { u32x2 w;
                    w.x = pk2(v[k][i].x * rstd * gg[i].x * (1.f + sc[k][i].x) + sh[k][i].x, v[k][i].y * rstd * gg[i].y * (1.f + sc[k][i].y) + sh[k][i].y);
                    w.y = pk2(v[k][i].z * rstd * gg[i].z * (1.f + sc[k][i].z) + sh[k][i].z, v[k][i].w * rstd * gg[i].w * (1.f + sc[k][i].w) + sh[k][i].w);
                    *(u32x2*)(H + (size_t)row * 1024 + i * 256 + lane * 4) = w; }
            } }
    }
}

__device__ __forceinline__ void phase_final(const Params& p) {
    const int lane = tidx() & 63, wave = tidx() >> 6;
    const float* g = p.in[32];
    float4 gg[4];
#pragma unroll
    for (int i = 0; i < 4; ++i) gg[i] = *(const float4*)(g + i * 256 + lane * 4);
    const int stride = gridDim.x * 8;
    for (int row0 = blockIdx.x * 8 + wave; row0 < NTOK; row0 += 3 * stride) {
        float4 v[3][4];
#pragma unroll
        for (int k = 0; k < 3; ++k) { const int row = min(row0 + k * stride, NTOK - 1);
#pragma unroll
            for (int i = 0; i < 4; ++i) v[k][i] = *(const float4*)(p.out + (size_t)row * 1024 + i * 256 + lane * 4); }
#pragma unroll
        for (int k = 0; k < 3; ++k) { const int row = row0 + k * stride;
            if (row < NTOK) {
                float ss = 0.f;
#pragma unroll
                for (int i = 0; i < 4; ++i) ss += v[k][i].x * v[k][i].x + v[k][i].y * v[k][i].y + v[k][i].z * v[k][i].z + v[k][i].w * v[k][i].w;
                ss = wave_sum(ss);
                const float rstd = rsqrtf(ss * (1.0f / 1024.0f) + 1e-6f);
#pragma unroll
                for (int i = 0; i < 4; ++i) { float4 o; o.x = v[k][i].x * rstd * gg[i].x; o.y = v[k][i].y * rstd * gg[i].y; o.z = v[k][i].z * rstd * gg[i].z; o.w = v[k][i].w * rstd * gg[i].w;
                    *(float4*)(p.out + (size_t)row * 1024 + i * 256 + lane * 4) = o; }
            } }
    }
}

__device__ __forceinline__ void ld_row16(const bf16_t* r, int lane, float (&x)[16]) {
#pragma unroll
    for (int i = 0; i < 2; ++i) { const u32x4 w = *(const u32x4*)(r + i * 512 + lane * 8);
        x[i * 8 + 0] = __uint_as_float(w.x << 16); x[i * 8 + 1] = __uint_as_float(w.x & 0xffff0000u); x[i * 8 + 2] = __uint_as_float(w.y << 16); x[i * 8 + 3] = __uint_as_float(w.y & 0xffff0000u);
        x[i * 8 + 4] = __uint_as_float(w.z << 16); x[i * 8 + 5] = __uint_as_float(w.z & 0xffff0000u); x[i * 8 + 6] = __uint_as_float(w.w << 16); x[i * 8 + 7] = __uint_as_float(w.w & 0xffff0000u); }
}
__device__ __forceinline__ void ld_vec16(const float* v, int lane, float (&x)[16]) {
#pragma unroll
    for (int i = 0; i < 2; ++i) { const float4 a = *(const float4*)(v + i * 512 + lane * 8), c = *(const float4*)(v + i * 512 + lane * 8 + 4);
        x[i * 8 + 0] = a.x; x[i * 8 + 1] = a.y; x[i * 8 + 2] = a.z; x[i * 8 + 3] = a.w; x[i * 8 + 4] = c.x; x[i * 8 + 5] = c.y; x[i * 8 + 6] = c.z; x[i * 8 + 7] = c.w; }
}
__device__ __forceinline__ void phase_norm16(const Params& p, const bf16_t* X) {
    const int lane = tidx() & 63, wave = tidx() >> 6;
    const float* mod = (const float*)(p.ws + WS_MOD) + 9 * 3072;
    bf16_t* H = (bf16_t*)(p.ws + WS_H);
    float gg[16]; ld_vec16(p.in[22], lane, gg);
    const int stride = gridDim.x * 8;
    for (int row0 = blockIdx.x * 8 + wave; row0 < NTOK; row0 += 3 * stride) {
        u32x4 raw[3][2];
#pragma unroll
        for (int k = 0; k < 3; ++k) { const int row = min(row0 + k * stride, NTOK - 1);
#pragma unroll
            for (int i = 0; i < 2; ++i) raw[k][i] = *(const u32x4*)(X + (size_t)row * 1024 + i * 512 + lane * 8); }
#pragma unroll
        for (int k = 0; k < 3; ++k) { const int row = row0 + k * stride;
            if (row < NTOK) {
                const float* mv = mod + (row < NCTX ? 0 : 1 + ((row - NCTX) >> 10)) * 3072;
                float sh[16], sc[16]; ld_vec16(mv, lane, sh); ld_vec16(mv + 1024, lane, sc);
                float x[16];
#pragma unroll
                for (int i = 0; i < 2; ++i) { const u32x4 w = raw[k][i];
                    x[i * 8 + 0] = __uint_as_float(w.x << 16); x[i * 8 + 1] = __uint_as_float(w.x & 0xffff0000u); x[i * 8 + 2] = __uint_as_float(w.y << 16); x[i * 8 + 3] = __uint_as_float(w.y & 0xffff0000u);
                    x[i * 8 + 4] = __uint_as_float(w.z << 16); x[i * 8 + 5] = __uint_as_float(w.z & 0xffff0000u); x[i * 8 + 6] = __uint_as_float(w.w << 16); x[i * 8 + 7] = __uint_as_float(w.w & 0xffff0000u); }
                float ss = 0.f;
#pragma unroll
                for (int e = 0; e < 16; ++e) ss += x[e] * x[e];
                ss = wave_sum(ss);
                const float rstd = rsqrtf(ss * (1.0f / 1024.0f) + 1e-6f);
#pragma unroll
                for (int i = 0; i < 2; ++i) { u32x4 w; float y[8];
#pragma unroll
                    for (int e = 0; e < 8; ++e) y[e] = x[i * 8 + e] * rstd * gg[i * 8 + e] * (1.f + sc[i * 8 + e]) + sh[i * 8 + e];
                    w.x = pk2(y[0], y[1]); w.y = pk2(y[2], y[3]); w.z = pk2(y[4], y[5]); w.w = pk2(y[6], y[7]);
                    *(u32x4*)(H + (size_t)row * 1024 + i * 512 + lane * 8) = w; }
            } }
    }
}
__device__ __forceinline__ void phase_final16(const Params& p, const bf16_t* X) {
    const int lane = tidx() & 63, wave = tidx() >> 6;
    float gg[16]; ld_vec16(p.in[32], lane, gg);
    const int stride = gridDim.x * 8;
    for (int row0 = blockIdx.x * 8 + wave; row0 < NTOK; row0 += 3 * stride) {
        u32x4 raw[3][2];
#pragma unroll
        for (int k = 0; k < 3; ++k) { const int row = min(row0 + k * stride, NTOK - 1);
#pragma unroll
            for (int i = 0; i < 2; ++i) raw[k][i] = *(const u32x4*)(X + (size_t)row * 1024 + i * 512 + lane * 8); }
#pragma unroll
        for (int k = 0; k < 3; ++k) { const int row = row0 + k * stride;
            if (row < NTOK) {
                float x[16];
#pragma unroll
                for (int i = 0; i < 2; ++i) { const u32x4 w = raw[k][i];
                    x[i * 8 + 0] = __uint_as_float(w.x << 16); x[i * 8 + 1] = __uint_as_float(w.x & 0xffff0000u); x[i * 8 + 2] = __uint_as_float(w.y << 16); x[i * 8 + 3] = __uint_as_float(w.y & 0xffff0000u);
                    x[i * 8 + 4] = __uint_as_float(w.z << 16); x[i * 8 + 5] = __uint_as_float(w.z & 0xffff0000u); x[i * 8 + 6] = __uint_as_float(w.w << 16); x[i * 8 + 7] = __uint_as_float(w.w & 0xffff0000u); }
                float ss = 0.f;
#pragma unroll
                for (int e = 0; e < 16; ++e) ss += x[e] * x[e];
                ss = wave_sum(ss);
                const float rstd = rsqrtf(ss * (1.0f / 1024.0f) + 1e-6f);
                float* yr = p.out + (size_t)row * 1024;
#pragma unroll
                for (int i = 0; i < 2; ++i) {
                    float4 o0, o1;
                    o0.x = x[i * 8 + 0] * rstd * gg[i * 8 + 0]; o0.y = x[i * 8 + 1] * rstd * gg[i * 8 + 1]; o0.z = x[i * 8 + 2] * rstd * gg[i * 8 + 2]; o0.w = x[i * 8 + 3] * rstd * gg[i * 8 + 3];
                    o1.x = x[i * 8 + 4] * rstd * gg[i * 8 + 4]; o1.y = x[i * 8 + 5] * rstd * gg[i * 8 + 5]; o1.z = x[i * 8 + 6] * rstd * gg[i * 8 + 6]; o1.w = x[i * 8 + 7] * rstd * gg[i * 8 + 7];
                    *(float4*)(yr + i * 512 + lane * 8) = o0; *(float4*)(yr + i * 512 + lane * 8 + 4) = o1; }
            } }
    }
}

constexpr float QSCALE = 0.125f * 1.4426950408889634f;
__device__ __forceinline__ u32x2 pk4(const f32x4& v) { u32x2 w; w.x = pg8::cvt_pk_bf16(v[0], v[1]); w.y = pg8::cvt_pk_bf16(v[2], v[3]); return w; }
__device__ __forceinline__ u32x4 pk8(const f32x4& a, const f32x4& b) { u32x4 w; w.x = pg8::cvt_pk_bf16(a[0], a[1]); w.y = pg8::cvt_pk_bf16(a[2], a[3]); w.z = pg8::cvt_pk_bf16(b[0], b[1]); w.w = pg8::cvt_pk_bf16(b[2], b[3]); return w; }

template <bool IN16>
struct EpiRes {
    static constexpr bool PERM = true, AFTER_DRAIN = false;
    const float* xa; const float* xb; const bf16_t* x16; bf16_t* xo; const float* gate;
    __device__ __forceinline__ void operator()(const f32x4 (&acc)[2][2][4][2], const pg8::Unit& u, int wr, int wc, int fr, int fq) const {
        const int row0 = u.pm * 256 + wr * 64 + fr, col0 = u.pn * 256 + wc * 32 + 8 * fq;
        const bool ctx = u.pm < 16;
        const int mi = ctx ? 0 : 1 + ((u.pm - 16) >> 2);
        const float* xbase = (ctx ? xa + (size_t)row0 * 1024 : xb + (size_t)(row0 - NCTX) * 1024) + col0;
        const bf16_t* x16b = x16 + (size_t)row0 * 1024 + col0;
        bf16_t* obase = xo + (size_t)row0 * 1024 + col0;
        f32x4 gv[2][2];
#pragma unroll
        for (int bj = 0; bj < 2; ++bj)
#pragma unroll
            for (int n = 0; n < 2; ++n) gv[bj][n] = *(const f32x4*)(gate + mi * 3072 + col0 + bj * 128 + 4 * n);
#pragma unroll
        for (int ai = 0; ai < 2; ++ai) {
            f32x4 xv[4][2][2];
#pragma unroll
            for (int m = 0; m < 4; ++m)
#pragma unroll
                for (int bj = 0; bj < 2; ++bj) {
                    const size_t off = (size_t)(ai * 128 + m * 16) * 1024 + bj * 128;
                    if (IN16) { const u32x4 w = *(const u32x4*)(x16b + off);
                        xv[m][bj][0] = (f32x4){__uint_as_float(w.x << 16), __uint_as_float(w.x & 0xffff0000u), __uint_as_float(w.y << 16), __uint_as_float(w.y & 0xffff0000u)};
                        xv[m][bj][1] = (f32x4){__uint_as_float(w.z << 16), __uint_as_float(w.z & 0xffff0000u), __uint_as_float(w.w << 16), __uint_as_float(w.w & 0xffff0000u)}; }
                    else { xv[m][bj][0] = *(const f32x4*)(xbase + off); xv[m][bj][1] = *(const f32x4*)(xbase + off + 4); }
                }
            __builtin_amdgcn_sched_barrier(0);
#pragma unroll
            for (int m = 0; m < 4; ++m)
#pragma unroll
                for (int bj = 0; bj < 2; ++bj)
                    *(u32x4*)(obase + (size_t)(ai * 128 + m * 16) * 1024 + bj * 128) = pk8(xv[m][bj][0] + gv[bj][0] * acc[ai][bj][m][0], xv[m][bj][1] + gv[bj][1] * acc[ai][bj][m][1]);
        }
    }
};

struct Epi1 {
    static constexpr bool PERM = true, AFTER_DRAIN = false;
    unsigned char* ws; float* out;
    __device__ __forceinline__ void operator()(const f32x4 (&acc)[2][2][4][2], const pg8::Unit& u, int wr, int wc, int fr, int fq) const {
        const int reg = u.pn >> 1, cb = (u.pn & 1) * 256 + wc * 32 + 8 * fq;
        const bool ctx = u.pm < 16;
        bf16_t* P0 = (bf16_t*)(ws + WS_P);
#pragma unroll
        for (int ai = 0; ai < 2; ++ai)
#pragma unroll
            for (int m = 0; m < 4; ++m) {
                const int row = u.pm * 256 + ai * 128 + wr * 64 + m * 16 + fr;
                const int lt = row - NCTX, b = ctx ? (row >> 8) : (lt >> 10), t = ctx ? (row & 255) : (lt & 1023);
#pragma unroll
                for (int bj = 0; bj < 2; ++bj) {
                    const int c = cb + bj * 128; const f32x4 v0 = acc[ai][bj][m][0], v1 = acc[ai][bj][m][1];
                    if (reg == 0) *(u32x4*)(P0 + (size_t)row * 2048 + c) = pk8(v0 * QSCALE, v1 * QSCALE);
                    else if (reg >= 3) *(u32x4*)(P0 + (size_t)row * 2048 + (reg - 2) * 512 + c) = pk8(v0, v1);
                    else if (reg == 1) {
                        if (ctx) { float* o = out + O_NAK + (size_t)row * 512 + c; *(f32x4*)o = v0; *(f32x4*)(o + 4) = v1;
                            *(u32x4*)((bf16_t*)(ws + WS_K0C) + (size_t)row * 512 + c) = pk8(v0, v1); }
                        else *(u32x4*)((bf16_t*)(ws + WS_K0L) + ((size_t)b * 1280 + 256 + t) * 512 + c) = pk8(v0, v1);
                    } else {
                        if (ctx) { float* o = out + O_NAV + (size_t)row * 512 + c; *(f32x4*)o = v0; *(f32x4*)(o + 4) = v1;
                            *(u32x4*)((bf16_t*)(ws + WS_V0C) + (size_t)row * 512 + c) = pk8(v0, v1); }
                        else *(u32x4*)((bf16_t*)(ws + WS_V0L) + ((size_t)b * 1280 + 256 + t) * 512 + c) = pk8(v0, v1);
                    }
                }
            }
    }
};

struct Epi3 {
    static constexpr bool PERM = true, AFTER_DRAIN = false;
    unsigned char* ws; float* out;
    __device__ __forceinline__ void operator()(const f32x4 (&acc)[2][2][4][2], const pg8::Unit& u, int wr, int wc, int fr, int fq) const {
        const int reg = u.pn >> 2, cb = (u.pn & 3) * 256 + wc * 32 + 8 * fq;
        const bool ctx = u.pm < 16;
        bf16_t* P1 = (bf16_t*)(ws + WS_P);
        const float* rc = (const float*)(ws + WS_ROPE);
        const bool rope = !ctx && reg < 2;
        const float sgn = fq >= 2 ? 1.0f : -1.0f;
#pragma unroll
        for (int ai = 0; ai < 2; ++ai) {
            f32x4 csv[4][2], snv[4][2];
            if (rope) {
#pragma unroll
                for (int m = 0; m < 4; ++m) { const int t = (u.pm * 256 + ai * 128 + wr * 64 + m * 16 + fr - NCTX) & 1023; const int pos = (wc & 1) ? (t & 63) : (t >> 6);
#pragma unroll
                    for (int n = 0; n < 2; ++n) { const int idx = pos * 16 + 8 * (fq & 1) + 4 * n; csv[m][n] = *(const f32x4*)(rc + idx); snv[m][n] = *(const f32x4*)(rc + 1024 + idx); } }
            }
#pragma unroll
            for (int m = 0; m < 4; ++m) {
                const int row = u.pm * 256 + ai * 128 + wr * 64 + m * 16 + fr;
                const int lt = row - NCTX, b = ctx ? (row >> 8) : (lt >> 10), t = ctx ? (row & 255) : (lt & 1023);
#pragma unroll
                for (int bj = 0; bj < 2; ++bj) {
                    f32x4 v0 = acc[ai][bj][m][0], v1 = acc[ai][bj][m][1];
                    if (rope) {
                        f32x4 p0, p1;
#pragma unroll
                        for (int j = 0; j < 4; ++j) { p0[j] = __shfl_xor(v0[j], 32); p1[j] = __shfl_xor(v1[j], 32); }
                        v0 = v0 * csv[m][0] + (p0 * snv[m][0]) * sgn; v1 = v1 * csv[m][1] + (p1 * snv[m][1]) * sgn;
                    }
                    const int c = cb + bj * 128;
                    if (reg == 0) *(u32x4*)(P1 + (size_t)row * 2048 + c) = pk8(v0 * QSCALE, v1 * QSCALE);
                    else if (reg == 3) *(u32x4*)(P1 + (size_t)row * 2048 + 1024 + c) = pk8(v0, v1);
                    else if (reg == 1) {
                        if (ctx) { float* o = out + O_DK + (size_t)row * 1024 + c; *(f32x4*)o = v0; *(f32x4*)(o + 4) = v1;
                            *(u32x4*)((bf16_t*)(ws + WS_K1C) + (size_t)row * 1024 + c) = pk8(v0, v1); }
                        else *(u32x4*)((bf16_t*)(ws + WS_K1L) + ((size_t)b * 1280 + 256 + t) * 1024 + c) = pk8(v0, v1);
                    } else {
                        if (ctx) { float* o = out + O_DV + (size_t)row * 1024 + c; *(f32x4*)o = v0; *(f32x4*)(o + 4) = v1;
                            *(u32x4*)((bf16_t*)(ws + WS_V1C) + (size_t)row * 1024 + c) = pk8(v0, v1); }
                        else *(u32x4*)((bf16_t*)(ws + WS_V1L) + ((size_t)b * 1280 + 256 + t) * 1024 + c) = pk8(v0, v1);
                    }
                }
            }
        }
    }
};
#define MFMA16(a, b, c) __builtin_amdgcn_mfma_f32_16x16x32_bf16(a, b, c, 0, 0, 0)
constexpr float SC_LOG2 = 0.125f * 1.4426950408889634f;
constexpr float LOG2E = 1.4426950408889634f;
constexpr float RS_TAU = 8.0f;
__device__ __forceinline__ float ex2(float x) { return __builtin_amdgcn_exp2f(x); }
__device__ __forceinline__ bf16x8 pack8(const float (&v)[8]) {
    u32x4 w; w.x = pg8::cvt_pk_bf16(v[0], v[1]); w.y = pg8::cvt_pk_bf16(v[2], v[3]); w.z = pg8::cvt_pk_bf16(v[4], v[5]); w.w = pg8::cvt_pk_bf16(v[6], v[7]);
    return __builtin_bit_cast(bf16x8, w);
}
__device__ __forceinline__ bf16x8 cat2(u32x2 a, u32x2 b) { u32x4 w; w.x = a.x; w.y = a.y; w.z = b.x; w.w = b.y; return __builtin_bit_cast(bf16x8, w); }

template <int DK, int DV> struct ACfg {
    static constexpr int TK = (DK == 64) ? 128 : 64;
    static constexpr int KP = DK * 2 + 16, VP = (DK == 64) ? 392 : 136;
    static constexpr int KBYTES = TK * KP, VBYTES = DV * VP, STAGE = KBYTES + VBYTES;
};
template <int DK, int DV>
__device__ __forceinline__ void stage_load(const bf16_t* Ksrc, size_t ldk, const bf16_t* Vsrc, size_t ldv, u32x4 (&kr)[2], u32x4 (&vr)[2], int tid) {
    typedef ACfg<DK, DV> C;
#pragma unroll
    for (int i = 0; i < 2; ++i) { const int idx = tid + i * 512, row = idx / (DK / 8), pc = idx % (DK / 8); kr[i] = *(const u32x4*)(Ksrc + (size_t)row * ldk + pc * 8); }
#pragma unroll
    for (int i = 0; i < 2; ++i) { const int idx = tid + i * 512, key = idx & (C::TK - 1), pc = idx / C::TK; vr[i] = *(const u32x4*)(Vsrc + (size_t)key * ldv + pc * 8); }
}
template <int DK, int DV>
__device__ __forceinline__ void stage_store(LAS unsigned char* base, const u32x4 (&kr)[2], const u32x4 (&vr)[2], int tid) {
    typedef ACfg<DK, DV> C;
#pragma unroll
    for (int i = 0; i < 2; ++i) { const int idx = tid + i * 512, row = idx / (DK / 8), pc = idx % (DK / 8); *(LAS u32x4*)(base + row * C::KP + pc * 16) = kr[i]; }
#pragma unroll
    for (int i = 0; i < 2; ++i) { const int idx = tid + i * 512, key = idx & (C::TK - 1), pc = idx / C::TK;
        LAS unsigned char* d = base + C::KBYTES + (pc * 8) * C::VP + key * 2;
        *(LAS unsigned short*)(d + 0 * C::VP) = (unsigned short)(vr[i].x & 0xffffu); *(LAS unsigned short*)(d + 1 * C::VP) = (unsigned short)(vr[i].x >> 16);
        *(LAS unsigned short*)(d + 2 * C::VP) = (unsigned short)(vr[i].y & 0xffffu); *(LAS unsigned short*)(d + 3 * C::VP) = (unsigned short)(vr[i].y >> 16);
        *(LAS unsigned short*)(d + 4 * C::VP) = (unsigned short)(vr[i].z & 0xffffu); *(LAS unsigned short*)(d + 5 * C::VP) = (unsigned short)(vr[i].z >> 16);
        *(LAS unsigned short*)(d + 6 * C::VP) = (unsigned short)(vr[i].w & 0xffffu); *(LAS unsigned short*)(d + 7 * C::VP) = (unsigned short)(vr[i].w >> 16); }
}

struct St1 { f32x4 O[4]; float m, l; };
template <bool BIAS>
__device__ __forceinline__ void chunk1(const LAS unsigned char* kt, const LAS unsigned char* vt, int fr, int fq, const bf16x8 (&qf)[2], St1& st, const float (&bias)[8]) {
    typedef ACfg<64, 64> C;
    const LAS unsigned char* kl = kt + fr * C::KP + fq * 16;
    const LAS unsigned char* vl = vt + fr * C::VP + fq * 8;
    const bf16x8 k00 = *(const LAS bf16x8*)(kl), k01 = *(const LAS bf16x8*)(kl + 64), k10 = *(const LAS bf16x8*)(kl + 16 * C::KP), k11 = *(const LAS bf16x8*)(kl + 16 * C::KP + 64);
    u32x2 va[4], vb[4];
#pragma unroll
    for (int db = 0; db < 4; ++db) { va[db] = *(const LAS u32x2*)(vl + db * 16 * C::VP); vb[db] = *(const LAS u32x2*)(vl + db * 16 * C::VP + 32); }
    f32x4 s0 = {0.f, 0.f, 0.f, 0.f}, s1 = {0.f, 0.f, 0.f, 0.f};
    s0 = MFMA16(k00, qf[0], s0); s0 = MFMA16(k01, qf[1], s0); s1 = MFMA16(k10, qf[0], s1); s1 = MFMA16(k11, qf[1], s1);
    float sv[8];
#pragma unroll
    for (int j = 0; j < 4; ++j) { sv[j] = s0[j]; sv[4 + j] = s1[j]; }
    if (BIAS) {
#pragma unroll
        for (int i = 0; i < 8; ++i) sv[i] += bias[i];
    }
    float cm = fmaxf(fmaxf(fmaxf(sv[0], sv[1]), fmaxf(sv[2], sv[3])), fmaxf(fmaxf(sv[4], sv[5]), fmaxf(sv[6], sv[7])));
    cm = fmaxf(cm, __shfl_xor(cm, 16)); cm = fmaxf(cm, __shfl_xor(cm, 32));
    float mn = st.m;
    if (__builtin_amdgcn_ballot_w64(cm > st.m + RS_TAU)) {
        mn = fmaxf(st.m, cm);
        const float al = ex2(st.m - mn);
        st.l *= al;
#pragma unroll
        for (int db = 0; db < 4; ++db) st.O[db] *= al;
        st.m = mn;
    }
    float ps = 0.f;
#pragma unroll
    for (int i = 0; i < 8; ++i) { sv[i] = ex2(sv[i] - mn); ps += sv[i]; }
    st.l += ps;
    const bf16x8 pf = pack8(sv);
#pragma unroll
    for (int db = 0; db < 4; ++db) st.O[db] = MFMA16(cat2(va[db], vb[db]), pf, st.O[db]);
}

struct St2 { f32x4 O1[8], O2[8]; float m1, l1, m2, l2; };
__device__ __forceinline__ void qk_sm2(const LAS unsigned char* kt, int fr, int fq, const bf16x8 (&qf)[4], St2& st, bf16x8 (&pf1)[2], bf16x8 (&pf2)[2]) {
    typedef ACfg<128, 128> C;
    const LAS unsigned char* kl = kt + fr * C::KP + fq * 16;
    f32x4 a[4], b[4];
#pragma unroll
    for (int kh = 0; kh < 2; ++kh) {
        bf16x8 kf[2][4];
#pragma unroll
        for (int k2 = 0; k2 < 2; ++k2)
#pragma unroll
            for (int i = 0; i < 4; ++i) kf[k2][i] = *(const LAS bf16x8*)(kl + (kh * 2 + k2) * 16 * C::KP + i * 64);
        __builtin_amdgcn_sched_barrier(0);
#pragma unroll
        for (int k2 = 0; k2 < 2; ++k2) { const int kb = kh * 2 + k2;
            a[kb] = (f32x4){0.f, 0.f, 0.f, 0.f}; b[kb] = (f32x4){0.f, 0.f, 0.f, 0.f};
            a[kb] = MFMA16(kf[k2][0], qf[0], a[kb]); a[kb] = MFMA16(kf[k2][1], qf[1], a[kb]);
            b[kb] = MFMA16(kf[k2][2], qf[2], b[kb]); b[kb] = MFMA16(kf[k2][3], qf[3], b[kb]); }
    }
    float c1 = fmaxf(fmaxf(a[0][0], a[0][1]), fmaxf(a[0][2], a[0][3])), c2 = fmaxf(fmaxf(b[0][0], b[0][1]), fmaxf(b[0][2], b[0][3]));
#pragma unroll
    for (int kb = 1; kb < 4; ++kb) { c1 = fmaxf(c1, fmaxf(fmaxf(a[kb][0], a[kb][1]), fmaxf(a[kb][2], a[kb][3]))); c2 = fmaxf(c2, fmaxf(fmaxf(b[kb][0], b[kb][1]), fmaxf(b[kb][2], b[kb][3]))); }
    c1 = fmaxf(c1, __shfl_xor(c1, 16)); c1 = fmaxf(c1, __shfl_xor(c1, 32));
    c2 = fmaxf(c2, __shfl_xor(c2, 16)); c2 = fmaxf(c2, __shfl_xor(c2, 32));
    float n1 = st.m1, n2 = st.m2;
    const bool grow = (c1 > st.m1 + RS_TAU) || (c2 > st.m2 + RS_TAU);
    if (__builtin_amdgcn_ballot_w64(grow)) {
        n1 = fmaxf(st.m1, c1); n2 = fmaxf(st.m2, c2);
        const float al1 = ex2(st.m1 - n1), al2 = ex2(st.m2 - n2);
        st.l1 *= al1; st.l2 *= al2;
#pragma unroll
        for (int db = 0; db < 8; ++db) { st.O1[db] *= al1; st.O2[db] *= al2; }
        st.m1 = n1; st.m2 = n2;
    }
    float p1 = 0.f, p2 = 0.f;
#pragma unroll
    for (int hf = 0; hf < 2; ++hf) {
        float e1[8], e2[8];
#pragma unroll
        for (int j = 0; j < 4; ++j) { e1[j] = ex2(a[2 * hf][j] - n1); e1[4 + j] = ex2(a[2 * hf + 1][j] - n1); e2[j] = ex2(b[2 * hf][j] - n2); e2[4 + j] = ex2(b[2 * hf + 1][j] - n2); }
#pragma unroll
        for (int i = 0; i < 8; ++i) { p1 += e1[i]; p2 += e2[i]; }
        pf1[hf] = pack8(e1); pf2[hf] = pack8(e2);
    }
    st.l1 += p1; st.l2 += p2;
}
__device__ __forceinline__ void pv2(const LAS unsigned char* vt, int fr, int fq, const bf16x8 (&pf1)[2], const bf16x8 (&pf2)[2], St2& st) {
    typedef ACfg<128, 128> C;
    const LAS unsigned char* vl = vt + fr * C::VP + fq * 8;
#pragma unroll
    for (int dg = 0; dg < 2; ++dg) {
        u32x2 va[4][2], vb[4][2];
#pragma unroll
        for (int d4 = 0; d4 < 4; ++d4)
#pragma unroll
            for (int hf = 0; hf < 2; ++hf) { va[d4][hf] = *(const LAS u32x2*)(vl + (dg * 4 + d4) * 16 * C::VP + hf * 64); vb[d4][hf] = *(const LAS u32x2*)(vl + (dg * 4 + d4) * 16 * C::VP + hf * 64 + 32); }
        __builtin_amdgcn_sched_barrier(0);
#pragma unroll
        for (int d4 = 0; d4 < 4; ++d4)
#pragma unroll
            for (int hf = 0; hf < 2; ++hf) { const int db = dg * 4 + d4; const bf16x8 vf = cat2(va[d4][hf], vb[d4][hf]);
                st.O1[db] = MFMA16(vf, pf1[hf], st.O1[db]);
                st.O2[db] = MFMA16(vf, pf2[hf], st.O2[db]); }
    }
}

__device__ __forceinline__ void step1(const LAS unsigned char* kt, const LAS unsigned char* vt, int fr, int fq, const bf16x8 (&qf)[2], St1& st) {
    typedef ACfg<64, 64> C;
    const LAS unsigned char* kl = kt + fr * C::KP + fq * 16;
    const LAS unsigned char* vl = vt + fr * C::VP + fq * 8;
    f32x4 a[4];
    {
        bf16x8 kf[4][2];
#pragma unroll
        for (int kb = 0; kb < 4; ++kb) { kf[kb][0] = *(const LAS bf16x8*)(kl + kb * 16 * C::KP); kf[kb][1] = *(const LAS bf16x8*)(kl + kb * 16 * C::KP + 64); }
        __builtin_amdgcn_sched_barrier(0);
#pragma unroll
        for (int kb = 0; kb < 4; ++kb) { a[kb] = (f32x4){0.f, 0.f, 0.f, 0.f}; a[kb] = MFMA16(kf[kb][0], qf[0], a[kb]); a[kb] = MFMA16(kf[kb][1], qf[1], a[kb]); }
    }
    float c1 = fmaxf(fmaxf(a[0][0], a[0][1]), fmaxf(a[0][2], a[0][3]));
#pragma unroll
    for (int kb = 1; kb < 4; ++kb) c1 = fmaxf(c1, fmaxf(fmaxf(a[kb][0], a[kb][1]), fmaxf(a[kb][2], a[kb][3])));
    c1 = fmaxf(c1, __shfl_xor(c1, 16)); c1 = fmaxf(c1, __shfl_xor(c1, 32));
    float n1 = st.m;
    if (__builtin_amdgcn_ballot_w64(c1 > st.m + RS_TAU)) {
        n1 = fmaxf(st.m, c1);
        const float al = ex2(st.m - n1);
        st.l *= al;
#pragma unroll
        for (int db = 0; db < 4; ++db) st.O[db] *= al;
        st.m = n1;
    }
    float p1 = 0.f;
    bf16x8 pf[2];
#pragma unroll
    for (int hf = 0; hf < 2; ++hf) {
        float e1[8];
#pragma unroll
        for (int j = 0; j < 4; ++j) { e1[j] = ex2(a[2 * hf][j] - n1); e1[4 + j] = ex2(a[2 * hf + 1][j] - n1); }
#pragma unroll
        for (int i = 0; i < 8; ++i) p1 += e1[i];
        pf[hf] = pack8(e1);
    }
    st.l += p1;
    {
        u32x2 va[4][2], vb[4][2];
#pragma unroll
        for (int db = 0; db < 4; ++db)
#pragma unroll
            for (int hf = 0; hf < 2; ++hf) { va[db][hf] = *(const LAS u32x2*)(vl + db * 16 * C::VP + hf * 64); vb[db][hf] = *(const LAS u32x2*)(vl + db * 16 * C::VP + hf * 64 + 32); }
        __builtin_amdgcn_sched_barrier(0);
#pragma unroll
        for (int db = 0; db < 4; ++db)
#pragma unroll
            for (int hf = 0; hf < 2; ++hf) st.O[db] = MFMA16(cat2(va[db][hf], vb[db][hf]), pf[hf], st.O[db]);
    }
}

constexpr int A0_RPB_OFF = 90112;
__device__ __forceinline__ void attn0_item(const Params& p, int item, LAS unsigned char* lds) {
    typedef ACfg<64, 64> C;
    const int tid = tidx(), lane = tid & 63, w = tid >> 6, fr = lane & 15, fq = lane >> 4;
    const bf16_t* P0 = (const bf16_t*)(p.ws + WS_P);
    bf16_t* Y = (bf16_t*)(p.ws + WS_Y);
    St1 st;
#pragma unroll
    for (int db = 0; db < 4; ++db) st.O[db] = (f32x4){0.f, 0.f, 0.f, 0.f};
    st.m = -1e30f; st.l = 0.f;
    bf16x8 qf[2]; int tok, h;
    float bias[8];
#pragma unroll
    for (int i = 0; i < 8; ++i) bias[i] = 0.f;
    const bf16_t* K; const bf16_t* V; size_t ldv; int nsteps, nwin, rs0, r = 0, rs = 0, span0 = 0, qc = 0, cs = 0;
    LAS float* rpbs = (LAS float*)(lds + A0_RPB_OFF);
    __syncthreads();
    if (item < 512) {
        const int b = item >> 6; h = (item >> 3) & 7; const int rp = item & 7;
        r = 2 * rp + (w >> 2); const int cq = w & 3, c0 = cq * 16;
        tok = NCTX + b * 1024 + r * 64 + c0 + fr;
        span0 = cq == 0 ? 0 : (cq == 1 ? 8 : (cq == 2 ? 24 : 32));
        rs = min(max(r - 4, 0), 8); qc = c0 + fr; cs = min(max(qc - 8, 0), 48);
        rs0 = min(max(2 * rp - 4, 0), 8); const int rs1 = min(max(2 * rp - 3, 0), 8); nwin = (8 + rs1 - rs0 + 1) >> 1; nsteps = nwin + 2;
        K = (const bf16_t*)(p.ws + WS_K0L) + (size_t)b * 1280 * 512 + h * 64;
        V = (const bf16_t*)(p.ws + WS_V0L) + (size_t)b * 1280 * 512 + h * 64; ldv = 512;
        if (tid < 465) rpbs[tid] = p.in[13][h * 465 + tid] * LOG2E;
    } else {
        const int it = item - 512; const int b = it >> 4; h = (it >> 1) & 7; const int qb = it & 1;
        tok = b * 256 + qb * 128 + w * 16 + fr;
        nwin = 0; nsteps = 2; rs0 = 0;
        K = (const bf16_t*)(p.ws + WS_K0C) + (size_t)b * 256 * 512 + h * 64;
        V = (const bf16_t*)(p.ws + WS_V0C) + (size_t)b * 256 * 512 + h * 64; ldv = 512;
    }
    qf[0] = *(const bf16x8*)(P0 + (size_t)tok * 2048 + h * 64 + fq * 8); qf[1] = *(const bf16x8*)(P0 + (size_t)tok * 2048 + h * 64 + 32 + fq * 8);
    u32x2 gwv[4];
#pragma unroll
    for (int db = 0; db < 4; ++db) gwv[db] = *(const u32x2*)(P0 + (size_t)tok * 2048 + 512 + h * 64 + db * 16 + fq * 4);
#define A0_KEY0(s) ((s) < nwin ? 256 + (rs0 + 2 * (s)) * 64 : ((s) - nwin) * 128)
#define A0_LOAD(s, KR, VR) do { const int _k0 = A0_KEY0(s); stage_load<64, 64>(K + (size_t)_k0 * 512, 512, V + (size_t)_k0 * 512, ldv, KR, VR, tid); } while (0)
#define A0_COMPUTE(s, cur) do { \
        if ((s) < nwin) { \
            _Pragma("unroll") for (int rr = 0; rr < 2; ++rr) { const int krow = rs0 + 2 * (s) + rr; \
                if (krow >= rs && krow < rs + 8) { const LAS float* rb = rpbs + (krow - r + 7) * 31; \
                    _Pragma("unroll") for (int i = 0; i < 8; ++i) { const int kc = span0 + (i >> 2) * 16 + fq * 4 + (i & 3); \
                        const bool ok = kc >= cs && kc < cs + 16; const int dc = min(max(kc - qc + 15, 0), 30); bias[i] = ok ? rb[dc] : -1e30f; } \
                    chunk1<true>((cur) + (rr * 64 + span0) * C::KP, (cur) + C::KBYTES + (rr * 64 + span0) * 2, fr, fq, qf, st, bias); } } \
        } else { step1((cur), (cur) + C::KBYTES, fr, fq, qf, st); step1((cur) + 64 * C::KP, (cur) + C::KBYTES + 128, fr, fq, qf, st); } } while (0)
    u32x4 krA[2], vrA[2], krB[2], vrB[2];
    A0_LOAD(0, krA, vrA);
    A0_LOAD(1, krB, vrB);
    stage_store<64, 64>(lds, krA, vrA, tid);
    __syncthreads();
    for (int s = 0; s < nsteps; s += 2) {
        if (s + 2 < nsteps) A0_LOAD(s + 2, krA, vrA);
        A0_COMPUTE(s, lds);
        if (s + 1 < nsteps) stage_store<64, 64>(lds + C::STAGE, krB, vrB, tid);
        __syncthreads();
        if (s + 1 >= nsteps) break;
        if (s + 3 < nsteps) A0_LOAD(s + 3, krB, vrB);
        A0_COMPUTE(s + 1, lds + C::STAGE);
        if (s + 2 < nsteps) stage_store<64, 64>(lds, krA, vrA, tid);
        __syncthreads();
    }
#undef A0_KEY0
#undef A0_LOAD
#undef A0_COMPUTE
    float l = st.l; l += __shfl_xor(l, 16); l += __shfl_xor(l, 32);
    const float il = 1.0f / l;
#pragma unroll
    for (int db = 0; db < 4; ++db) {
        const int d = db * 16 + fq * 4;
        const u32x2 gw = gwv[db];
        f32x4 o;
        o[0] = st.O[db][0] * il * silu_f(__uint_as_float(gw.x << 16)); o[1] = st.O[db][1] * il * silu_f(__uint_as_float(gw.x & 0xffff0000u));
        o[2] = st.O[db][2] * il * silu_f(__uint_as_float(gw.y << 16)); o[3] = st.O[db][3] * il * silu_f(__uint_as_float(gw.y & 0xffff0000u));
        *(u32x2*)(Y + (size_t)tok * 1024 + h * 64 + d) = pk4(o);
    }
}

__device__ __forceinline__ void attn1_item(const Params& p, int item, float lam, LAS unsigned char* lds) {
    typedef ACfg<128, 128> C;
    const int tid = tidx(), lane = tid & 63, w = tid >> 6, fr = lane & 15, fq = lane >> 4;
    const bf16_t* P1 = (const bf16_t*)(p.ws + WS_P);
    bf16_t* Y = (bf16_t*)(p.ws + WS_Y);
    St2 st;
#pragma unroll
    for (int db = 0; db < 8; ++db) { st.O1[db] = (f32x4){0.f, 0.f, 0.f, 0.f}; st.O2[db] = (f32x4){0.f, 0.f, 0.f, 0.f}; }
    st.m1 = -1e30f; st.l1 = 0.f; st.m2 = -1e30f; st.l2 = 0.f;
    int tok, h, nst; const bf16_t* K; const bf16_t* V; size_t ldv;
    if (item < 512) {
        const int b = item >> 6; h = (item >> 3) & 7; const int qb = item & 7;
        tok = NCTX + b * 1024 + qb * 128 + w * 16 + fr; nst = 20;
        K = (const bf16_t*)(p.ws + WS_K1L) + (size_t)b * 1280 * 1024 + h * 128;
        V = (const bf16_t*)(p.ws + WS_V1L) + (size_t)b * 1280 * 1024 + h * 128; ldv = 1024;
    } else {
        const int it = item - 512; const int b = it >> 4; h = (it >> 1) & 7; const int qb = it & 1;
        tok = b * 256 + qb * 128 + w * 16 + fr; nst = 4;
        K = (const bf16_t*)(p.ws + WS_K1C) + (size_t)b * 256 * 1024 + h * 128;
        V = (const bf16_t*)(p.ws + WS_V1C) + (size_t)b * 256 * 1024 + h * 128; ldv = 1024;
    }
    bf16x8 qf[4];
#pragma unroll
    for (int i = 0; i < 4; ++i) qf[i] = *(const bf16x8*)(P1 + (size_t)tok * 2048 + h * 128 + i * 32 + fq * 8);
    u32x2 gwv[8];
#pragma unroll
    for (int db = 0; db < 8; ++db) gwv[db] = *(const u32x2*)(P1 + (size_t)tok * 2048 + 1024 + h * 128 + db * 16 + fq * 4);
    u32x4 kr[2], vr[2];
    bf16x8 pf1[2], pf2[2];
    const bool late = w >= 4;
    __syncthreads();
    stage_load<128, 128>(K, 1024, V, ldv, kr, vr, tid); stage_store<128, 128>(lds, kr, vr, tid);
    __syncthreads();
    int bc = 0, bp = 2;
    if (late) __builtin_amdgcn_s_setprio(1);
    for (int s = 0; s < nst; ++s) {
        LAS unsigned char* cur = lds + bc * C::STAGE;
        const int bn = bc == 2 ? 0 : bc + 1;
        if (s + 1 < nst) stage_load<128, 128>(K + (size_t)(s + 1) * 64 * 1024, 1024, V + (size_t)(s + 1) * 64 * 1024, ldv, kr, vr, tid);
        if (late) {
            if (s > 0) pv2(lds + bp * C::STAGE + C::KBYTES, fr, fq, pf1, pf2, st);
            qk_sm2(cur, fr, fq, qf, st, pf1, pf2);
        } else {
            qk_sm2(cur, fr, fq, qf, st, pf1, pf2);
            pv2(cur + C::KBYTES, fr, fq, pf1, pf2, st);
        }
        if (s + 1 < nst) stage_store<128, 128>(lds + bn * C::STAGE, kr, vr, tid);
        __syncthreads();
        bp = bc; bc = bn;
    }
    if (late) pv2(lds + bp * C::STAGE + C::KBYTES, fr, fq, pf1, pf2, st);
    __builtin_amdgcn_s_setprio(0);
    float l1 = st.l1; l1 += __shfl_xor(l1, 16); l1 += __shfl_xor(l1, 32);
    float l2 = st.l2; l2 += __shfl_xor(l2, 16); l2 += __shfl_xor(l2, 32);
    const float i1 = 1.0f / l1, i2 = lam / l2;
    float ss = 0.f;
#pragma unroll
    for (int db = 0; db < 8; ++db) { st.O1[db] = st.O1[db] * i1 - st.O2[db] * i2;
        ss += st.O1[db][0] * st.O1[db][0] + st.O1[db][1] * st.O1[db][1] + st.O1[db][2] * st.O1[db][2] + st.O1[db][3] * st.O1[db][3]; }
    ss += __shfl_xor(ss, 16); ss += __shfl_xor(ss, 32);
    const float rstd = rsqrtf(ss * (1.0f / 128.0f) + 1e-6f) * (1.0f - LAM_INIT);
    f32x4 sgv[8];
#pragma unroll
    for (int db = 0; db < 8; ++db) sgv[db] = *(const f32x4*)(p.in[30] + db * 16 + fq * 4);
    __builtin_amdgcn_sched_barrier(0);
#pragma unroll
    for (int db = 0; db < 8; ++db) {
        const int d = db * 16 + fq * 4;
        const u32x2 gw = gwv[db];
        const f32x4 sg = sgv[db];
        f32x4 o;
        o[0] = st.O1[db][0] * rstd * sg[0] * silu_f(__uint_as_float(gw.x << 16)); o[1] = st.O1[db][1] * rstd * sg[1] * silu_f(__uint_as_float(gw.x & 0xffff0000u));
        o[2] = st.O1[db][2] * rstd * sg[2] * silu_f(__uint_as_float(gw.y << 16)); o[3] = st.O1[db][3] * rstd * sg[3] * silu_f(__uint_as_float(gw.y & 0xffff0000u));
        *(u32x2*)(Y + (size_t)tok * 1024 + h * 128 + d) = pk4(o);
    }
}
__device__ __forceinline__ float sigm(float x) { return __builtin_amdgcn_rcpf(1.0f + ex2(-LOG2E * x)); }
__device__ __forceinline__ void lru_item(const Params& p, int item, float* sm) {
    const int tid = tidx(), lane = tid & 63, w = tid >> 6, fr = lane & 15, fq = lane >> 4;
    int s, n; if (item < 64) { s = 16 + (item >> 3); n = item & 7; } else { s = (item - 64) >> 3; n = (item - 64) & 7; }
    const bool lat = s >= 16;
    const int T = lat ? 1024 : 256, tok0 = lat ? NCTX + (s - 16) * 1024 : s * 256, nchunk = T >> 8;
    const bf16_t* P0 = (const bf16_t*)(p.ws + WS_P); bf16_t* Y = (bf16_t*)(p.ws + WS_Y); float* Hf = (float*)(p.ws + WS_HF);
    const bf16_t* Wg = (const bf16_t*)(p.ws + WS_WG);
    float* xcs = sm; float* seg = sm + 256 * 68;
    const int cg8 = (tid & 7) * 8, q0 = tid >> 3;
    for (int dir = 0; dir < 2; ++dir) {
        float ba[4], bx[4], nl[4], carry[4];
#pragma unroll
        for (int dt = 0; dt < 4; ++dt) { const int ch = n * 64 + dt * 16 + fr;
            ba[dt] = p.in[17][dir * 512 + ch]; bx[dt] = p.in[19][dir * 512 + ch]; nl[dt] = -8.0f * LOG2E * log1pf(__expf(-p.in[20][dir * 512 + ch]));
            carry[dt] = lat ? p.in[5][((s - 16) * 2 + dir) * 512 + ch] : 0.f;
        }
        for (int ck = 0; ck < nchunk; ++ck) {
            __syncthreads();
            {
                float cw[4][8], cbv[8];
#pragma unroll
                for (int j = 0; j < 4; ++j) { const f32x4 a = *(const f32x4*)(p.in[14] + j * 512 + n * 64 + cg8), b = *(const f32x4*)(p.in[14] + j * 512 + n * 64 + cg8 + 4);
#pragma unroll
                    for (int k = 0; k < 4; ++k) { cw[j][k] = a[k]; cw[j][4 + k] = b[k]; } }
                { const f32x4 a = *(const f32x4*)(p.in[15] + n * 64 + cg8), b = *(const f32x4*)(p.in[15] + n * 64 + cg8 + 4);
#pragma unroll
                    for (int k = 0; k < 4; ++k) { cbv[k] = a[k]; cbv[4 + k] = b[k]; } }
                u32x4 wv[4][4];
#pragma unroll
                for (int i = 0; i < 4; ++i) {
                    const int q = q0 + 64 * i, pp = ck * 256 + q, t = dir ? T - 1 - pp : pp;
#pragma unroll
                    for (int j = 0; j < 4; ++j) { const int tt = min(max(t - 2 + j, 0), T - 1);
                        wv[i][j] = *(const u32x4*)(P0 + (size_t)(tok0 + tt) * 2048 + 1024 + n * 64 + cg8); }
                }
#pragma unroll
                for (int i = 0; i < 4; ++i) {
                    const int q = q0 + 64 * i, pp = ck * 256 + q, t = dir ? T - 1 - pp : pp;
                    float xc[8];
#pragma unroll
                    for (int k = 0; k < 8; ++k) xc[k] = cbv[k];
#pragma unroll
                    for (int j = 0; j < 4; ++j) { const int tt = t - 2 + j; const float ok = (tt >= 0 && tt < T) ? 1.0f : 0.0f; const u32x4 w4 = wv[i][j];
                        xc[0] += ok * cw[j][0] * __uint_as_float(w4.x << 16); xc[1] += ok * cw[j][1] * __uint_as_float(w4.x & 0xffff0000u);
                        xc[2] += ok * cw[j][2] * __uint_as_float(w4.y << 16); xc[3] += ok * cw[j][3] * __uint_as_float(w4.y & 0xffff0000u);
                        xc[4] += ok * cw[j][4] * __uint_as_float(w4.z << 16); xc[5] += ok * cw[j][5] * __uint_as_float(w4.z & 0xffff0000u);
                        xc[6] += ok * cw[j][6] * __uint_as_float(w4.w << 16); xc[7] += ok * cw[j][7] * __uint_as_float(w4.w & 0xffff0000u); }
                    *(f32x4*)(xcs + q * 68 + cg8) = (f32x4){xc[0], xc[1], xc[2], xc[3]};
                    *(f32x4*)(xcs + q * 68 + cg8 + 4) = (f32x4){xc[4], xc[5], xc[6], xc[7]};
                }
            }
            bf16x8 wfa[2][2], wfx[2][2];
#define LRU_WF(dt_, sl_) do { _Pragma("unroll") for (int ks = 0; ks < 2; ++ks) { \
                wfa[sl_][ks] = *(const bf16x8*)(Wg + (size_t)((((dir * 2 + 0) * 8 + n) * 64) + (dt_) * 16 + fr) * 64 + ks * 32 + fq * 8); \
                wfx[sl_][ks] = *(const bf16x8*)(Wg + (size_t)((((dir * 2 + 1) * 8 + n) * 64) + (dt_) * 16 + fr) * 64 + ks * 32 + fq * 8); } } while (0)
            LRU_WF(0, 0);
            __syncthreads();
            bf16x8 af[2][2];
#pragma unroll
            for (int tt = 0; tt < 2; ++tt)
#pragma unroll
                for (int ks = 0; ks < 2; ++ks) { const float* src = xcs + (w * 32 + tt * 16 + fr) * 68 + ks * 32 + fq * 8;
                    const f32x4 x0 = *(const f32x4*)src, x1 = *(const f32x4*)(src + 4);
                    const float v[8] = {x0[0], x0[1], x0[2], x0[3], x1[0], x1[1], x1[2], x1[3]};
                    af[tt][ks] = pack8(v); }
            float hl[2][4][4], ap[2][4][4], Aex[2][4], Hex[2][4];
#pragma unroll
            for (int dt = 0; dt < 4; ++dt) {
                float At0 = 1.f, Ht0 = 0.f;
                if (dt < 3) LRU_WF(dt + 1, (dt + 1) & 1);
#pragma unroll
                for (int tt = 0; tt < 2; ++tt) {
                    f32x4 ca = {0.f, 0.f, 0.f, 0.f}, cx = {0.f, 0.f, 0.f, 0.f};
#pragma unroll
                    for (int ks = 0; ks < 2; ++ks) { ca = MFMA16(af[tt][ks], wfa[dt & 1][ks], ca); cx = MFMA16(af[tt][ks], wfx[dt & 1][ks], cx); }
                    float h = 0.f, A = 1.f;
#pragma unroll
                    for (int j = 0; j < 4; ++j) {
                        const float xcv = xcs[(w * 32 + tt * 16 + fq * 4 + j) * 68 + dt * 16 + fr];
                        const float rr = sigm(ca[j] + ba[dt]), ii = sigm(cx[j] + bx[dt]);
                        const float a = ex2(rr * nl[dt]), uu = __builtin_amdgcn_sqrtf(fmaxf(1.0f - a * a, 0.f)) * (ii * xcv);
                        h = a * h + uu; A *= a; hl[tt][dt][j] = h; ap[tt][dt][j] = A;
                    }
                    { const float A1 = __shfl_up(A, 16), H1 = __shfl_up(h, 16); if (fq >= 1) { h = A * H1 + h; A = A * A1; } }
                    { const float A2 = __shfl_up(A, 32), H2 = __shfl_up(h, 32); if (fq >= 2) { h = A * H2 + h; A = A * A2; } }
                    float Ae = __shfl_up(A, 16), He = __shfl_up(h, 16); if (fq == 0) { Ae = 1.f; He = 0.f; }
                    const float At = __shfl(A, 48 + fr), Ht = __shfl(h, 48 + fr);
                    if (tt == 0) { Aex[0][dt] = Ae; Hex[0][dt] = He; At0 = At; Ht0 = Ht; }
                    else { Aex[1][dt] = At0 * Ae; Hex[1][dt] = Ae * Ht0 + He;
                        if (fq == 0) { seg[(w * 64 + dt * 16 + fr) * 2] = At0 * At; seg[(w * 64 + dt * 16 + fr) * 2 + 1] = At * Ht0 + Ht; } }
                }
            }
            __syncthreads();
#pragma unroll
            for (int dt = 0; dt < 4; ++dt) {
                float hc = carry[dt], hin = hc;
#pragma unroll
                for (int w2 = 0; w2 < 8; ++w2) { const float A = seg[(w2 * 64 + dt * 16 + fr) * 2], H = seg[(w2 * 64 + dt * 16 + fr) * 2 + 1];
                    hc = A * hc + H; if (w2 + 1 == w) hin = hc; }
                carry[dt] = hc;
#pragma unroll
                for (int tt = 0; tt < 2; ++tt) {
                    const float hs = Aex[tt][dt] * hin + Hex[tt][dt];
#pragma unroll
                    for (int j = 0; j < 4; ++j) xcs[(w * 32 + tt * 16 + fq * 4 + j) * 68 + dt * 16 + fr] = ap[tt][dt][j] * hs + hl[tt][dt][j];
                }
            }
            const int tid2 = tidx();
            f32x4 hfa[4][2]; u32x4 gba[4];
            if (dir == 1) {
#pragma unroll
                for (int i = 0; i < 4; ++i) { const int piece = tid2 + i * 512, q = piece >> 3, c8 = (piece & 7) * 8; const size_t tk = (size_t)(tok0 + T - 1 - (ck * 256 + q));
                    hfa[i][0] = *(const f32x4*)(Hf + tk * 512 + n * 64 + c8); hfa[i][1] = *(const f32x4*)(Hf + tk * 512 + n * 64 + c8 + 4);
                    gba[i] = *(const u32x4*)(P0 + tk * 2048 + 1536 + n * 64 + c8); }
            }
            __syncthreads();
#pragma unroll
            for (int i = 0; i < 4; ++i) {
                const int piece = tid2 + i * 512, q = piece >> 3, c8 = (piece & 7) * 8, pp = ck * 256 + q;
                const f32x4 h0 = *(const f32x4*)(xcs + q * 68 + c8), h1 = *(const f32x4*)(xcs + q * 68 + c8 + 4);
                if (dir == 0) { float* o = Hf + (size_t)(tok0 + pp) * 512 + n * 64 + c8; *(f32x4*)o = h0; *(f32x4*)(o + 4) = h1; }
                else {
                    const u32x4 gw = gba[i];
                    f32x4 g0 = {__uint_as_float(gw.x << 16), __uint_as_float(gw.x & 0xffff0000u), __uint_as_float(gw.y << 16), __uint_as_float(gw.y & 0xffff0000u)};
                    f32x4 g1 = {__uint_as_float(gw.z << 16), __uint_as_float(gw.z & 0xffff0000u), __uint_as_float(gw.w << 16), __uint_as_float(gw.w & 0xffff0000u)};
                    f32x4 y0, y1;
#pragma unroll
                    for (int e = 0; e < 4; ++e) { y0[e] = (hfa[i][0][e] + h0[e]) * g0[e] * sigm(g0[e]); y1[e] = (hfa[i][1][e] + h1[e]) * g1[e] * sigm(g1[e]); }
                    *(u32x4*)(Y + (size_t)(tok0 + T - 1 - pp) * 1024 + 512 + n * 64 + c8) = pk8(y0, y1);
                }
            }
        }
#undef LRU_WF
        if (!lat && w == 0 && fq == 0) {
#pragma unroll
            for (int dt = 0; dt < 4; ++dt) p.out[O_LRU + (s * 2 + dir) * 512 + n * 64 + dt * 16 + fr] = carry[dt];
        }
    }
}
__device__ __forceinline__ void gsync(const Params& p) {
    extern __shared__ __attribute__((aligned(16))) unsigned char smem_[];
    XcdBarrier b; b.bar = (unsigned*)(p.ws + WS_BAR); b.x = xb_xcc_id(); b.st = (volatile LAS unsigned*)((LAS unsigned char*)smem_ + 131072);
    xcd_barrier(b);
}
__global__ void __launch_bounds__(512) mega(Params p) {
    extern __shared__ __attribute__((aligned(16))) unsigned char smem[];
    cg::grid_group grid = cg::this_grid();
    PG8_LAS unsigned char* lds = (PG8_LAS unsigned char*)smem;
    const float* mod = (const float*)(p.ws + WS_MOD);
    pg8::StaticOrder S;
    volatile LAS unsigned* xst = (volatile LAS unsigned*)(lds + 131072);
    if (threadIdx.x == 0) { xst[0] = 0u; xst[1] = 0u; }
    __syncthreads();
    (void)xcd_barrier_post((unsigned*)(p.ws + WS_BAR), xst);
    phaseA(p, (float*)smem);
    grid.sync();
    phaseA1b(p, (float*)smem);
    phase_norm(p, 0, p.in[0], p.in[1]);
    gsync(p);
    { pg8::Gemm g{(const bf16_t*)(p.ws + WS_H), (const bf16_t*)(p.ws + WS_W1T), NTOK, 3072, 1024}; S.init(NTOK, 3072, (int)gridDim.x, (int)blockIdx.x);
      Epi1 E{p.ws, p.out};
      pg8::gemm_phase<Epi1, pg8::StaticOrder, false>(lds, g, S, E, nullptr); }
    if (blockIdx.x >= 64) phaseA2(p, (float*)smem, (int)blockIdx.x - 64, (int)gridDim.x - 64);
    gsync(p);
    {
        unsigned* qctr = (unsigned*)(p.ws + WS_BAR);
        volatile LAS int* slot = (volatile LAS int*)(lds + 131072 + 16);
        for (;;) {
            __syncthreads();
            if (threadIdx.x == 0) *slot = (int)__hip_atomic_fetch_add(qctr, 1u, __ATOMIC_RELAXED, __HIP_MEMORY_SCOPE_AGENT);
            __syncthreads();
            const int q = *slot;
            if (q >= 960) break;
            int kind, idx;
            if (q < 64) { kind = 0; idx = q; } else if (q < 576) { kind = 1; idx = q - 64; } else if (q < 704) { kind = 0; idx = 64 + q - 576; } else { kind = 1; idx = 512 + q - 704; }
            if (kind == 0) lru_item(p, idx, (float*)smem); else attn0_item(p, idx, lds);
        }
    }
    gsync(p);
    { pg8::Gemm g{(const bf16_t*)(p.ws + WS_Y), (const bf16_t*)(p.ws + WS_W2T), NTOK, 1024, 1024}; S.init(NTOK, 1024, (int)gridDim.x, (int)blockIdx.x);
      EpiRes<false> E{p.in[0], p.in[1], nullptr, (bf16_t*)(p.ws + WS_X1B), mod + 2048};
      pg8::gemm_phase<EpiRes<false>, pg8::StaticOrder, false>(lds, g, S, E, nullptr); }
    gsync(p);
    phase_norm16(p, (const bf16_t*)(p.ws + WS_X1B));
    gsync(p);
    { pg8::Gemm g{(const bf16_t*)(p.ws + WS_H), (const bf16_t*)(p.ws + WS_W3T), NTOK, 4096, 1024}; S.init(NTOK, 4096, (int)gridDim.x, (int)blockIdx.x);
      Epi3 E{p.ws, p.out};
      pg8::gemm_phase<Epi3, pg8::StaticOrder, false>(lds, g, S, E, nullptr); }
    gsync(p);
    { const int lane = threadIdx.x & 63;
      const float lam = __expf(wave_sum(p.in[26][lane] * p.in[27][lane])) - __expf(wave_sum(p.in[28][lane] * p.in[29][lane])) + LAM_INIT;
      for (int it = blockIdx.x; it < 768; it += gridDim.x) attn1_item(p, it, lam, lds); }
    gsync(p);
    { pg8::Gemm g{(const bf16_t*)(p.ws + WS_Y), (const bf16_t*)(p.ws + WS_W4T), NTOK, 1024, 1024}; S.init(NTOK, 1024, (int)gridDim.x, (int)blockIdx.x);
      EpiRes<true> E{nullptr, nullptr, (const bf16_t*)(p.ws + WS_X1B), (bf16_t*)(p.ws + WS_X2B), mod + 9 * 3072 + 2048};
      pg8::gemm_phase<EpiRes<true>, pg8::StaticOrder, false>(lds, g, S, E, nullptr); }
    gsync(p);
    phase_final16(p, (const bf16_t*)(p.ws + WS_X2B));
}

extern "C" void kernel_launch(void* const* d_in, const int* in_sizes, int n_in, void* d_out, int out_size, void* d_ws, size_t ws_size, hipStream_t stream) {
    static int grid_blocks = 0;
    if (!grid_blocks) {
        int dev = 0, cus = 0, per_cu = 0;
        (void)hipGetDevice(&dev);
        (void)hipDeviceGetAttribute(&cus, hipDeviceAttributeMultiprocessorCount, dev);
        (void)hipFuncSetAttribute((const void*)mega, hipFuncAttributeMaxDynamicSharedMemorySize, LDS_BYTES);
        (void)hipOccupancyMaxActiveBlocksPerMultiprocessor(&per_cu, (const void*)mega, 512, LDS_BYTES);
        if (per_cu < 1) { fprintf(stderr, "occupancy query says %d\n", per_cu); per_cu = 1; }
        grid_blocks = cus;
        if (ws_size < WS_END) fprintf(stderr, "workspace too small: %zu < %zu\n", ws_size, (size_t)WS_END);
    }
    (void)hipMemsetAsync((unsigned char*)d_ws + WS_BAR, 0, XCD_BAR_WORDS * 4, stream);
    Params p{};
    for (int i = 0; i < 33; ++i) p.in[i] = (const float*)d_in[i];
    p.out = (float*)d_out; p.ws = (unsigned char*)d_ws;
    void* args[] = {&p};
    hipError_t e = hipLaunchCooperativeKernel((void*)mega, dim3(grid_blocks), dim3(512), args, LDS_BYTES, stream);
    if (e != hipSuccess) fprintf(stderr, "cooperative launch failed: %s (grid %d)\n", hipGetErrorString(e), grid_blocks);
}
```

```cpp
#include <hip/hip_runtime.h>
#include <hip/hip_cooperative_groups.h>
#include <cstdio>
#include <cstdint>
namespace cg = cooperative_groups;
__device__ __forceinline__ int tidx() { int t = threadIdx.x; asm volatile("" : "+v"(t)); return t; }
namespace pg8 {
#define PG8_LAS __attribute__((address_space(3)))
typedef unsigned short bf16_t;
typedef short bf16x8 __attribute__((ext_vector_type(8)));
typedef float f32x4 __attribute__((ext_vector_type(4)));
typedef unsigned u32x4 __attribute__((ext_vector_type(4)));
constexpr int BM = 256, BK = 64, HALF = 128, HTB = HALF * BK * 2  , STAGE_BYTES = 8 * HTB, NXCD = 8, WGM = 8;

__host__ __device__ __forceinline__ int lds_byte(int r, int c) { const int st = (r >> 4) * 2 + (c >> 5), rr = r & 15, cc = c & 31, ob = rr * 64 + cc * 2; return st * 1024 + (ob ^ (((ob >> 9) & 1) << 5)); }
__host__ __device__ __forceinline__ void stage_rc(int b, int& R, int& C) { const int st = b / 1024, sb = b % 1024, swz = sb ^ (((sb >> 9) & 1) << 5); R = (st >> 1) * 16 + swz / 64; C = (st & 1) * 32 + (swz % 64) / 2; }
__host__ __device__ __forceinline__ int perm32(int rho) { const int n = rho >> 4, i = rho & 15; return 8 * (i >> 2) + 4 * n + (i & 3); }

struct Unit { int pm, pn; };
struct Gemm { const bf16_t* A; const bf16_t* Bt; int M, N, K; };

struct StaticOrder {
    int nM, nN, nwg, G, c;
    __host__ __device__ void init(int M, int N, int G_, int c_) { nM = M / BM; nN = N / BM; nwg = nM * nN; G = G_; c = c_; }
    __host__ __device__ bool next(int i, Unit& u) const {
        const long L = (long)i * G + c; if (L >= nwg) return false;
        int wgid = (int)L; { const int q = nwg / NXCD, r = nwg % NXCD, xcd = wgid % NXCD, off = wgid / NXCD; wgid = (xcd < r ? xcd * (q + 1) : r * (q + 1) + (xcd - r) * q) + off; }
        const int nig = WGM * nN, gid = wgid / nig, fm = gid * WGM, gsz = (nM - fm) < WGM ? (nM - fm) : WGM;
        u.pm = fm + ((wgid % nig) % gsz); u.pn = (wgid % nig) / gsz; return true;
    }
    __device__ __forceinline__ void a_ready(const Unit&) const {}
    __device__ __forceinline__ void done(const Unit&) const {}
};

__device__ __forceinline__ unsigned cvt_pk_bf16(float lo, float hi) { unsigned r; asm volatile("v_cvt_pk_bf16_f32 %0, %1, %2" : "=v"(r) : "v"(lo), "v"(hi)); return r; }
template <int ACT  > struct EpiBf16 {
    static constexpr bool PERM = true, AFTER_DRAIN = false;
    bf16_t* O; int ldc; const float* bias; int split_cols; size_t split_stride;
    __device__ __forceinline__ void operator()(const f32x4 (&acc)[2][2][4][2], const Unit& u, int wr, int wc, int fr, int fq) const {
        const int row0 = u.pm * BM + wr * 64 + fr; int colt = u.pn * BM; bf16_t* base = O;
        if (split_cols) { const int t = colt / split_cols; base += (size_t)t * split_stride; colt -= t * split_cols; }
        const int col0 = colt + wc * 32 + 8 * fq, bcol0 = u.pn * BM + wc * 32 + 8 * fq;
        f32x4 bv[2][2];
#pragma unroll
        for (int bj = 0; bj < 2; ++bj)
#pragma unroll
            for (int n = 0; n < 2; ++n) bv[bj][n] = bias ? *(const f32x4*)(bias + bcol0 + bj * HALF + 4 * n) : (f32x4){0.f, 0.f, 0.f, 0.f};
#pragma unroll
        for (int ai = 0; ai < 2; ++ai)
#pragma unroll
            for (int m = 0; m < 4; ++m) { bf16_t* rowp = base + (size_t)(row0 + ai * HALF + m * 16) * ldc + col0;
#pragma unroll
                for (int bj = 0; bj < 2; ++bj) { f32x4 v0 = acc[ai][bj][m][0] + bv[bj][0], v1 = acc[ai][bj][m][1] + bv[bj][1];
                    u32x4 w; w.x = cvt_pk_bf16(v0[0], v0[1]); w.y = cvt_pk_bf16(v0[2], v0[3]); w.z = cvt_pk_bf16(v1[0], v1[1]); w.w = cvt_pk_bf16(v1[2], v1[3]);
                    *(u32x4*)(rowp + bj * HALF) = w; } }
    }
};

template <class Epi, class Sched, bool STAMP = false>
__device__ __forceinline__ void gemm_phase(PG8_LAS unsigned char* lds, const Gemm g, const Sched& S, const Epi& E, unsigned long long* stamps) {
    const int tid = tidx(), wid = __builtin_amdgcn_readfirstlane(tid >> 6), lane = tid & 63, wr = wid >> 2, wc = wid & 3, fr = lane & 15, fq = lane >> 4;
    const int K = g.K, nt = K / BK;
    int ts_lo = 0, ts_hi = 0, nts = 0; const unsigned long long rt_entry = STAMP ? (unsigned long long)wall_clock64() : 0ull;
#define PG8_STAMP() do { if (STAMP && wid == 0 && nts < 64) { const unsigned long long _c = (unsigned long long)clock64(); \
        ts_lo = (lane == nts) ? (int)(unsigned)_c : ts_lo; ts_hi = (lane == nts) ? (int)(unsigned)(_c >> 32) : ts_hi; ++nts; } } while (0)
    PG8_STAMP();
    unsigned voffA[2], voffB[2];
#pragma unroll
    for (int i = 0; i < 2; ++i) { int R, C; stage_rc(tid * 16 + i * 8192, R, C); const int Rb = Epi::PERM ? ((R & ~31) + perm32(R & 31)) : R;
        voffA[i] = (unsigned)(R * K + C) * 2u; voffB[i] = (unsigned)(Rb * K + C) * 2u; }
    const size_t kstep = (size_t)(BK * 2);
    const size_t hstep = (size_t)HALF * K * 2;
    const size_t tstep = 2 * hstep;
    const unsigned ldsw = (unsigned)wid * 1024u;
    const int aoff = lds_byte(wr * 64 + fr, fq * 8), boff = lds_byte(wc * 32 + fr, fq * 8);
#define PG8_SA(b, h) (((b) * 2 + (h)) * HTB)
#define PG8_SB(b, h) ((4 + (b) * 2 + (h)) * HTB)
#define PG8_STAGE(bufoff, gbase, voff) do { _Pragma("unroll") for (int _i = 0; _i < 2; ++_i) \
        __builtin_amdgcn_global_load_lds((const unsigned*)((const char*)(gbase) + (voff)[_i]), (PG8_LAS unsigned*)(lds + (bufoff) + ldsw + _i * 8192), 16, 0, 0); } while (0)
#define PG8_LDA(dst, b, h) do { _Pragma("unroll") for (int m = 0; m < 4; ++m) _Pragma("unroll") for (int k = 0; k < 2; ++k) dst[m][k] = *(const PG8_LAS bf16x8*)(lds + PG8_SA(b, h) + aoff + m * 2048 + k * 1024); } while (0)
#define PG8_LDB(dst, b, h) do { _Pragma("unroll") for (int n = 0; n < 2; ++n) _Pragma("unroll") for (int k = 0; k < 2; ++k) dst[n][k] = *(const PG8_LAS bf16x8*)(lds + PG8_SB(b, h) + boff + n * 2048 + k * 1024); } while (0)
#define PG8_MMA(ai, bj, At, Bt) do { __builtin_amdgcn_s_setprio(1); _Pragma("unroll") for (int m = 0; m < 4; ++m) _Pragma("unroll") for (int n = 0; n < 2; ++n) _Pragma("unroll") for (int k = 0; k < 2; ++k) \
        acc[ai][bj][m][n] = __builtin_amdgcn_mfma_f32_16x16x32_bf16(Bt[n][k], At[m][k], acc[ai][bj][m][n], 0, 0, 0); __builtin_amdgcn_s_setprio(0); } while (0)
#define PG8_WAIT_V(n) asm volatile("s_waitcnt vmcnt(" #n ")" ::: "memory")
#define PG8_WAIT_L(n) asm volatile("s_waitcnt lgkmcnt(" #n ")" ::: "memory")
#define PG8_BAR __builtin_amdgcn_s_barrier()
#define PG8_SCHED __builtin_amdgcn_sched_barrier(0)
    Unit cur, nxt; int ui = 0;
    if (!S.next(0, cur)) return;
    f32x4 acc[2][2][4][2];
#pragma unroll
    for (int a = 0; a < 2; ++a)
#pragma unroll
        for (int b = 0; b < 2; ++b)
#pragma unroll
            for (int m = 0; m < 4; ++m)
#pragma unroll
                for (int n = 0; n < 2; ++n) acc[a][b][m][n] = (f32x4){0.f, 0.f, 0.f, 0.f};
    bf16x8 At[4][2], B0[2][2], B1[2][2];
    const char* cA = (const char*)g.A + (size_t)cur.pm * tstep; const char* cB = (const char*)g.Bt + (size_t)cur.pn * tstep;
    S.a_ready(cur);
    PG8_STAGE(PG8_SB(0, 0), cB, voffB); PG8_STAGE(PG8_SA(0, 0), cA, voffA); PG8_STAGE(PG8_SB(0, 1), cB + hstep, voffB); PG8_STAGE(PG8_SA(0, 1), cA + hstep, voffA);
    if (wr == 1) PG8_BAR;
    PG8_WAIT_V(4); PG8_BAR;
    PG8_STAGE(PG8_SB(1, 0), cB + kstep, voffB); PG8_STAGE(PG8_SA(1, 0), cA + kstep, voffA); PG8_STAGE(PG8_SB(1, 1), cB + hstep + kstep, voffB);
    PG8_WAIT_V(6); PG8_BAR;
    PG8_STAMP();
    for (;;) {
        const bool has_next = S.next(ui + 1, nxt);
        const char* nA = has_next ? (const char*)g.A + (size_t)nxt.pm * tstep : cA; const char* nB = has_next ? (const char*)g.Bt + (size_t)nxt.pn * tstep : cB;
        for (int t = 0; t < nt; t += 2) {
            const bool last = (t == nt - 2);
            const char* a1 = cA + (size_t)(t + 1) * kstep;
            const char* a2 = last ? nA : cA + (size_t)(t + 2) * kstep; const char* b2 = last ? nB : cB + (size_t)(t + 2) * kstep;
            const char* a3 = a2 + kstep; const char* b3 = b2 + kstep;
            if (last && has_next) S.a_ready(nxt);
            PG8_LDB(B0, 0, 0); PG8_SCHED; PG8_LDA(At, 0, 0); PG8_STAGE(PG8_SA(1, 1), a1 + hstep, voffA);
            PG8_WAIT_L(8); PG8_BAR; PG8_WAIT_L(0); PG8_MMA(0, 0, At, B0); PG8_BAR; PG8_SCHED;
            PG8_LDB(B1, 0, 1); PG8_STAGE(PG8_SB(0, 0), b2, voffB);
            PG8_BAR; PG8_WAIT_L(0); PG8_MMA(0, 1, At, B1); PG8_BAR;
            PG8_LDA(At, 0, 1); PG8_STAGE(PG8_SA(0, 0), a2, voffA);
            PG8_BAR; PG8_WAIT_L(0); PG8_MMA(1, 0, At, B0); PG8_BAR; PG8_SCHED;
            PG8_STAGE(PG8_SB(0, 1), b2 + hstep, voffB);
            PG8_WAIT_V(6); PG8_BAR; PG8_MMA(1, 1, At, B1); PG8_BAR;
            PG8_LDB(B0, 1, 0); PG8_SCHED; PG8_LDA(At, 1, 0); PG8_STAGE(PG8_SA(0, 1), a2 + hstep, voffA);
            PG8_WAIT_L(8); PG8_BAR; PG8_WAIT_L(0); PG8_MMA(0, 0, At, B0); PG8_BAR; PG8_SCHED;
            PG8_LDB(B1, 1, 1); PG8_STAGE(PG8_SB(1, 0), b3, voffB);
            PG8_BAR; PG8_WAIT_L(0); PG8_MMA(0, 1, At, B1); PG8_BAR;
            PG8_LDA(At, 1, 1); PG8_STAGE(PG8_SA(1, 0), a3, voffA);
            PG8_BAR; PG8_WAIT_L(0); PG8_MMA(1, 0, At, B0); PG8_BAR; PG8_SCHED;
            PG8_STAGE(PG8_SB(1, 1), b3 + hstep, voffB);
            PG8_WAIT_V(6); PG8_BAR; PG8_MMA(1, 1, At, B1); PG8_BAR;
        }
        PG8_STAMP();
        if constexpr (!Epi::AFTER_DRAIN) { E(acc, cur, wr, wc, fr, fq); S.done(cur); }
        PG8_STAMP();
        if (!has_next) break;
#pragma unroll
        for (int a = 0; a < 2; ++a)
#pragma unroll
            for (int b = 0; b < 2; ++b)
#pragma unroll
                for (int m = 0; m < 4; ++m)
#pragma unroll
                    for (int n = 0; n < 2; ++n) acc[a][b][m][n] = (f32x4){0.f, 0.f, 0.f, 0.f};
        cur = nxt; cA = nA; cB = nB; ++ui;
    }
    PG8_WAIT_V(0);
    if (wr == 0) PG8_BAR;
    PG8_BAR;
    if constexpr (Epi::AFTER_DRAIN) { E.fused(acc, cur, wr, wc, fr, fq, lds, wid, lane); S.done(cur); }
    PG8_STAMP();
    if (STAMP && wid == 0) { stamps[lane] = lane < nts ? (((unsigned long long)(unsigned)ts_hi << 32) | (unsigned)ts_lo) : 0ull;
        if (lane == 62) stamps[62] = rt_entry; if (lane == 63) stamps[63] = (unsigned long long)wall_clock64(); }
#undef PG8_STAMP
#undef PG8_SA
#undef PG8_SB
#undef PG8_STAGE
#undef PG8_LDA
#undef PG8_LDB
#undef PG8_MMA
#undef PG8_WAIT_V
#undef PG8_WAIT_L
#undef PG8_BAR
#undef PG8_SCHED
}
}
using pg8::bf16_t; using pg8::bf16x8; using pg8::f32x4; using pg8::u32x4;
#define LAS __attribute__((address_space(3)))
typedef unsigned u32x2 __attribute__((ext_vector_type(2)));

constexpr int NTOK = 12288, NCTX = 4096;
constexpr int LDS_BYTES = 131072 + 64;
constexpr float LAM_INIT = 0.35550906759f;
constexpr size_t O_YP = 0, O_YS = 4194304, O_NAK = 12582912, O_NAV = 14680064, O_LRU = 16777216, O_DK = 16793600, O_DV = 20987904;

struct Params { const float* in[33]; float* out; unsigned char* ws; };

__device__ __forceinline__ float bf2f(bf16_t v) { return __uint_as_float(((unsigned)v) << 16); }
__device__ __forceinline__ bf16_t f2bf(float f) { unsigned u = __float_as_uint(f); u += 0x7FFFu + ((u >> 16) & 1u); return (bf16_t)(u >> 16); }
__device__ __forceinline__ unsigned pk2(float lo, float hi) { return (unsigned)f2bf(lo) | ((unsigned)f2bf(hi) << 16); }
__device__ __forceinline__ float silu_f(float x) { return x / (1.0f + __expf(-x)); }
__device__ __forceinline__ float sigmoid_f(float x) { return 1.0f / (1.0f + __expf(-x)); }
__device__ __forceinline__ float wave_sum(float v) {
#pragma unroll
    for (int o = 32; o >= 1; o >>= 1) v += __shfl_xor(v, o);
    return v;
}
#define XB_TMO      128
#define XB_XCNT(j)  (256  + 64 * (j))
#define XB_XSUB(j)  (1280 + 64 * (j))
#define XB_XGEN(j)  (2304 + 64 * (j))
#define XB_TOP      3328
#define XB_TOPGEN   3392
#define XCD_BAR_WORDS 3456
#define XB_SPIN_CAP (1u << 18)
#define LAS __attribute__((address_space(3)))
__device__ __forceinline__ unsigned xb_ld(unsigned* p)              { return __hip_atomic_load(p, __ATOMIC_RELAXED, __HIP_MEMORY_SCOPE_AGENT); }
__device__ __forceinline__ unsigned xb_add(unsigned* p, unsigned v) { return __hip_atomic_fetch_add(p, v, __ATOMIC_RELAXED, __HIP_MEMORY_SCOPE_AGENT); }
__device__ __forceinline__ unsigned xb_xcc_id() { return (unsigned)__builtin_amdgcn_s_getreg((3 << 11) | 20) & 0xFu; }
#define XB_SPIN(cond, bar) do { unsigned _sp = 0; while (cond) { __builtin_amdgcn_s_sleep(1); \
    if ((++_sp & 255u) == 0u) { if (xb_ld(&(bar)[XB_TMO])) break; if (_sp > XB_SPIN_CAP) { atomicAdd(&(bar)[XB_TMO], 1u); break; } } } } while (0)

struct XcdBarrier {
    unsigned* bar; unsigned x;
    volatile LAS unsigned* st;
};

__device__ __forceinline__ XcdBarrier xcd_barrier_post(unsigned* bar, volatile LAS unsigned* st) {
    XcdBarrier b; b.bar = bar; b.x = xb_xcc_id(); b.st = st;
    if (threadIdx.x == 0) (void)xb_add(&bar[XB_XCNT(b.x)], 1u);
    return b;
}
__device__ __forceinline__ void xcd_barrier_complete(unsigned* bar, unsigned x, unsigned& nloc, unsigned& nx) {
    const unsigned G = gridDim.x * gridDim.y * gridDim.z;
    unsigned sum, cnt, mine, sp = 0u;
    for (;;) {
        sum = 0u; cnt = 0u; mine = 0u;
#pragma unroll
        for (unsigned j = 0; j < 16; ++j) { const unsigned c = xb_ld(&bar[XB_XCNT(j)]); sum += c; cnt += (c > 0u) ? 1u : 0u; mine = (j == x) ? c : mine; }
        if (sum == G) break;
        __builtin_amdgcn_s_sleep(1);
        if ((++sp & 255u) == 0u) { if (xb_ld(&bar[XB_TMO])) break; if (sp > XB_SPIN_CAP) { atomicAdd(&bar[XB_TMO], 1u); break; } }
    }
    nloc = mine > 0u ? mine : 1u; nx = cnt > 0u ? cnt : 1u;
}

__device__ __forceinline__ void xcd_barrier(const XcdBarrier& b) {
    asm volatile("s_waitcnt vmcnt(0)" ::: "memory");
    __syncthreads();
    if (threadIdx.x == 0) {
        unsigned* bar = b.bar;
        __builtin_amdgcn_s_waitcnt(0);
        unsigned nloc = b.st[0], nx = b.st[1];
        if (nloc == 0u) { xcd_barrier_complete(bar, b.x, nloc, nx); b.st[0] = nloc; b.st[1] = nx; }
        const unsigned old = xb_add(&bar[XB_XSUB(b.x)], 1u);
        const unsigned gen = old / nloc;
        if (old + 1u == (gen + 1u) * nloc) {
            __builtin_amdgcn_fence(__ATOMIC_RELEASE, "agent");
            asm volatile("s_waitcnt vmcnt(0)" ::: "memory");
            const unsigned og = xb_add(&bar[XB_TOP], 1u);
            const unsigned tg = og / nx;
            if (og + 1u == (tg + 1u) * nx) xb_add(&bar[XB_TOPGEN], 1u);
            else XB_SPIN(xb_ld(&bar[XB_TOPGEN]) == tg, bar);
            __builtin_amdgcn_fence(__ATOMIC_ACQUIRE, "agent");
            xb_add(&bar[XB_XGEN(b.x)], 1u);
            asm volatile("s_waitcnt vmcnt(0)" ::: "memory");
        } else {
            XB_SPIN(xb_ld(&bar[XB_XGEN(b.x)]) == gen, bar);
            __builtin_amdgcn_fence(__ATOMIC_ACQUIRE, "agent");
            asm volatile("s_waitcnt vmcnt(0)" ::: "memory");
        }
    }
    __syncthreads();
}
constexpr size_t WS_MOD = 0;
constexpr size_t WS_ROPE = 229376;
constexpr size_t WS_WG = 262144;
constexpr size_t WS_W1T = WS_WG + 262144;
constexpr size_t WS_W2T = WS_W1T + 6291456;
constexpr size_t WS_W3T = WS_W2T + 2097152;
constexpr size_t WS_W4T = WS_W3T + 8388608;
constexpr size_t WS_H = WS_W4T + 2097152;
constexpr size_t WS_HF = WS_H;
constexpr size_t WS_P = WS_H + 25165824;
constexpr size_t WS_Y = WS_P + 50331648;
constexpr size_t WS_K0L = WS_Y + 25165824;
constexpr size_t WS_V0L = WS_K0L + 10485760;
constexpr size_t WS_K0C = WS_V0L + 10485760;
constexpr size_t WS_V0C = WS_K0C + 4194304;
constexpr size_t WS_K1L = WS_V0C + 4194304;
constexpr size_t WS_V1L = WS_K1L + 20971520;
constexpr size_t WS_K1C = WS_V1L + 20971520;
constexpr size_t WS_V1C = WS_K1C + 8388608;
constexpr size_t WS_X1B = WS_K0L;
constexpr size_t WS_X2B = WS_P;
constexpr size_t WS_BAR = WS_V1C + 8388608;
constexpr size_t WS_END = WS_BAR + 16384;

__device__ __forceinline__ void transpose_tile(const float* __restrict__ src, int lds_, bf16_t* __restrict__ dst, int ldd, int r0, int c0, float* sm) {
    const int tid = tidx();
    __syncthreads();
#pragma unroll
    for (int i = 0; i < 2; ++i) {
        const int r = (tid >> 4) + i * 32, c4 = (tid & 15) * 4;
        const float4 v = *(const float4*)(src + (size_t)(r0 + r) * lds_ + c0 + c4);
        sm[r * 65 + c4 + 0] = v.x; sm[r * 65 + c4 + 1] = v.y; sm[r * 65 + c4 + 2] = v.z; sm[r * 65 + c4 + 3] = v.w;
    }
    __syncthreads();
    const int c = tid >> 3, r8 = (tid & 7) * 8;
    u32x4 w;
    w.x = pk2(sm[(r8 + 0) * 65 + c], sm[(r8 + 1) * 65 + c]); w.y = pk2(sm[(r8 + 2) * 65 + c], sm[(r8 + 3) * 65 + c]);
    w.z = pk2(sm[(r8 + 4) * 65 + c], sm[(r8 + 5) * 65 + c]); w.w = pk2(sm[(r8 + 6) * 65 + c], sm[(r8 + 7) * 65 + c]);
    *(u32x4*)(dst + (size_t)(c0 + c) * ldd + r0 + r8) = w;
}

__device__ __forceinline__ void transpose_4tile(const float* __restrict__ src, int lds_, bf16_t* __restrict__ dst, int ldd, int r0, int c0, float* sm) {
    const int tid = tidx();
    float4 v[8];
#pragma unroll
    for (int i = 0; i < 8; ++i) { const int idx = tid + 512 * i, r = idx >> 6, c4 = (idx & 63) * 4; { const f32x4 t4 = __builtin_nontemporal_load((const f32x4*)(src + (size_t)(r0 + r) * lds_ + c0 + c4)); v[i] = make_float4(t4[0], t4[1], t4[2], t4[3]); }     }
    __syncthreads();
#pragma unroll
    for (int i = 0; i < 8; ++i) { const int idx = tid + 512 * i, r = idx >> 6, c4 = (idx & 63) * 4;
        sm[r * 257 + c4 + 0] = v[i].x; sm[r * 257 + c4 + 1] = v[i].y; sm[r * 257 + c4 + 2] = v[i].z; sm[r * 257 + c4 + 3] = v[i].w; }
    __syncthreads();
    const int c = tid >> 1, rh = (tid & 1) * 32;
#pragma unroll
    for (int q = 0; q < 4; ++q) { const int rb = rh + q * 8; u32x4 w;
        w.x = pk2(sm[(rb + 0) * 257 + c], sm[(rb + 1) * 257 + c]); w.y = pk2(sm[(rb + 2) * 257 + c], sm[(rb + 3) * 257 + c]);
        w.z = pk2(sm[(rb + 4) * 257 + c], sm[(rb + 5) * 257 + c]); w.w = pk2(sm[(rb + 6) * 257 + c], sm[(rb + 7) * 257 + c]);
        *(u32x4*)(dst + (size_t)(c0 + c) * ldd + r0 + rb) = w; }
}

constexpr int A1_TOTAL = 192 + 32 + 1;
__device__ __forceinline__ void phaseA(const Params& p, float* sm) {
    const int tid = tidx();
    float* mod = (float*)(p.ws + WS_MOD);
    for (int it = blockIdx.x; it < 192; it += gridDim.x) {
        {
            const int layer = it / 96, col0 = (it % 96) * 32;
            const float* W = p.in[layer ? 23 : 10]; const float* Bv = p.in[layer ? 24 : 11];
            const int col = tid & 31, kp = tid >> 5;
            float wv[32];
#pragma unroll
            for (int u = 0; u < 32; ++u) wv[u] = __builtin_nontemporal_load((const float*)((const char*)W + (unsigned)(((kp * 64 + u) * 3072 + col0 + col) * 4)));
            __syncthreads();
            for (int e = tid; e < 9 * 1024; e += 512) { const float cvv = e < 1024 ? p.in[8][e] : p.in[2][e - 1024]; sm[e] = silu_f(cvv); }
            __syncthreads();
            float acc[9];
#pragma unroll
            for (int v = 0; v < 9; ++v) acc[v] = 0.f;
#pragma unroll
            for (int hb = 0; hb < 2; ++hb) {
                float wn[32];
                if (hb == 0) {
#pragma unroll
                    for (int u = 0; u < 32; ++u) wn[u] = __builtin_nontemporal_load((const float*)((const char*)W + (unsigned)(((kp * 64 + 32 + u) * 3072 + col0 + col) * 4)));
                }
#pragma unroll
                for (int u = 0; u < 32; ++u)
#pragma unroll
                    for (int v = 0; v < 9; ++v) acc[v] += sm[v * 1024 + kp * 64 + hb * 32 + u] * wv[u];
                if (hb == 0) {
#pragma unroll
                    for (int u = 0; u < 32; ++u) wv[u] = wn[u];
                }
            }
            __syncthreads();
#pragma unroll
            for (int v = 0; v < 9; ++v) sm[9216 + (kp * 9 + v) * 32 + col] = acc[v];
            __syncthreads();
            if (tid < 288) { const int v = tid >> 5, c = tid & 31; float s = Bv[col0 + c];
                for (int k2 = 0; k2 < 16; ++k2) s += sm[9216 + (k2 * 9 + v) * 32 + c];
                mod[(layer * 9 + v) * 3072 + col0 + c] = s; }
        }
    }
}
__device__ __forceinline__ void phaseA1b(const Params& p, float* sm) {
    const int tid = tidx();
    for (int it = blockIdx.x; it < A1_TOTAL; it += gridDim.x) {
        int t = it;
        if (t < 192) { transpose_4tile(p.in[12], 3072, (bf16_t*)(p.ws + WS_W1T), 1024, (t / 12) * 64, (t % 12) * 256, sm); continue; }
        t -= 192;
        if (t < 32) {
            const int gate = t >> 4, dn = t & 15;
            transpose_tile(p.in[gate ? 18 : 16] + (size_t)dn * 4096, 64, (bf16_t*)(p.ws + WS_WG) + (size_t)(((dn >> 3) * 2 + gate) * 8 + (dn & 7)) * 4096, 64, 0, 0, sm);
            continue;
        }
        {
            float* rc = (float*)(p.ws + WS_ROPE);
            for (int e = tid; e < 1024; e += 512) { const int pos = e >> 4, i = e & 15; const float inv = powf(10000.0f, -(float)i / 16.0f); const float ang = (float)pos * inv;
                rc[e] = cosf(ang); rc[1024 + e] = sinf(ang); }
        }
    }
}

constexpr int A2_TOTAL = 64 + 64 + 128 + 128 + 64 + 256 + 64;
__device__ __forceinline__ void phaseA2(const Params& p, float* sm, int first, int stride) {
    const int tid = tidx();
    for (int it = first; it < A2_TOTAL; it += stride) {
        int t = it;
        if (t < 384) {
            int which; if (t < 64) which = 0; else if (t < 128) { which = 1; t -= 64; } else if (t < 256) { which = 2; t -= 128; } else { which = 3; t -= 256; }
            const float* src = p.in[which == 0 ? 3 : which == 1 ? 4 : which == 2 ? 6 : 7];
            bf16_t* dst = (bf16_t*)(p.ws + (which == 0 ? WS_K0L : which == 1 ? WS_V0L : which == 2 ? WS_K1L : WS_V1L));
            const int W = which < 2 ? 512 : 1024;
            float4 v[8];
#pragma unroll
            for (int i = 0; i < 8; ++i) { const f32x4 t4 = __builtin_nontemporal_load((const f32x4*)(src + (size_t)t * 16384 + i * 2048 + tid * 4)); v[i] = make_float4(t4[0], t4[1], t4[2], t4[3]); }
            __builtin_amdgcn_sched_barrier(0);
#pragma unroll
            for (int i = 0; i < 8; ++i) { const size_t e = (size_t)t * 16384 + i * 2048 + tid * 4;
                const size_t row = e / W; const int c = (int)(e % W); const size_t b = row >> 8, j = row & 255;
                u32x2 w; w.x = pk2(v[i].x, v[i].y); w.y = pk2(v[i].z, v[i].w);
                *(u32x2*)(dst + (b * 1280 + j) * W + c) = w; }
            continue; }
        t -= 384;
        if (t < 64) { transpose_4tile(p.in[21], 1024, (bf16_t*)(p.ws + WS_W2T), 1024, (t / 4) * 64, (t % 4) * 256, sm); continue; }
        t -= 64;
        if (t < 256) { transpose_4tile(p.in[25], 4096, (bf16_t*)(p.ws + WS_W3T), 1024, (t / 16) * 64, (t % 16) * 256, sm); continue; }
        t -= 256;
        transpose_4tile(p.in[31], 1024, (bf16_t*)(p.ws + WS_W4T), 1024, (t / 4) * 64, (t % 4) * 256, sm);
    }
}

__device__ __forceinline__ void phase_norm(const Params& p, int layer, const float* xa, const float* xb_) {
    const int lane = tidx() & 63, wave = tidx() >> 6;
    const float* g = p.in[layer ? 22 : 9];
    const float* mod = (const float*)(p.ws + WS_MOD) + layer * 9 * 3072;
    bf16_t* H = (bf16_t*)(p.ws + WS_H);
    float4 gg[4];
#pragma unroll
    for (int i = 0; i < 4; ++i) gg[i] = *(const float4*)(g + i * 256 + lane * 4);
    const int stride = gridDim.x * 8;
    for (int row0 = blockIdx.x * 8 + wave; row0 < NTOK; row0 += 3 * stride) {
        float4 v[3][4], sh[3][4], sc[3][4];
#pragma unroll
        for (int k = 0; k < 3; ++k) { const int row = min(row0 + k * stride, NTOK - 1);
            const float* xr = row < NCTX ? xa + (size_t)row * 1024 : xb_ + (size_t)(row - NCTX) * 1024;
            const float* mv = mod + (row < NCTX ? 0 : 1 + ((row - NCTX) >> 10)) * 3072;
#pragma unroll
            for (int i = 0; i < 4; ++i) { v[k][i] = *(const float4*)(xr + i * 256 + lane * 4); sh[k][i] = *(const float4*)(mv + i * 256 + lane * 4); sc[k][i] = *(const float4*)(mv + 1024 + i * 256 + lane * 4); } }
#pragma unroll
        for (int k = 0; k < 3; ++k) { const int row = row0 + k * stride;
            if (row < NTOK) {
                float ss = 0.f;
#pragma unroll
                for (int i = 0; i < 4; ++i) ss += v[k][i].x * v[k][i].x + v[k][i].y * v[k][i].y + v[k][i].z * v[k][i].z + v[k][i].w * v[k][i].w;
                ss = wave_sum(ss);
                const float rstd = rsqrtf(ss * (1.0f / 1024.0f) + 1e-6f);
#pragma unroll
                for (int i = 0; i < 4; ++i) { u32x2 w;
                    w.x = pk2(v[k][i].x * rstd * gg[i].x * (1.f + sc[k][i].x) + sh[k][i].x, v[k][i].y * rstd * gg[i].y * (1.f + sc[k][i].y) + sh[k][i].y);
                    w.y = pk2(v[k][i].z * rstd * gg[i].z * (1.f + sc[k][i].z) + sh[k][i].z, v[k][i].w * rstd * gg[i].w * (1.f + sc[k][i].w) + sh[k][i].w);
                    *(u32x2*)(H + (size_t)row * 1024 + i * 256 + lane * 4) = w; }
            } }
    }
}

__device__ __forceinline__ void phase_final(const Params& p) {
    const int lane = tidx() & 63, wave = tidx() >> 6;
    const float* g = p.in[32];
    float4 gg[4];
#pragma unroll
    for (int i = 0; i < 4; ++i) gg[i] = *(const float4*)(g + i * 256 + lane * 4);
    const int stride = gridDim.x * 8;
    for (int row0 = blockIdx.x * 8 + wave; row0 < NTOK; row0 += 3 * stride) {
        float4 v[3][4];
#pragma unroll
        for (int k = 0; k < 3; ++k) { const int row = min(row0 + k * stride, NTOK - 1);
#pragma unroll
            for (int i = 0; i < 4; ++i) v[k][i] = *(const float4*)(p.out + (size_t)row * 1024 + i * 256 + lane * 4); }
#pragma unroll
        for (int k = 0; k < 3; ++k) { const int row = row0 + k * stride;
            if (row < NTOK) {
                float ss = 0.f;
#pragma unroll
                for (int i = 0; i < 4; ++i) ss += v[k][i].x * v[k][i].x + v[k][i].y * v[k][i].y + v[k][i].z * v[k][i].z + v[k][i].w * v[k][i].w;
                ss = wave_sum(ss);
                const float rstd = rsqrtf(ss * (1.0f / 1024.0f) + 1e-6f);
#pragma unroll
                for (int i = 0; i < 4; ++i) { float4 o; o.x = v[k][i].x * rstd * gg[i].x; o.y = v[k][i].y * rstd * gg[i].y; o.z = v[k][i].z * rstd * gg[i].z; o.w = v[k][i].w * rstd * gg[i].w;
                    *(float4*)(p.out + (size_t)row * 1024 + i * 256 + lane * 4) = o; }
            } }
    }
}

__device__ __forceinline__ void ld_row16(const bf16_t* r, int lane, float (&x)[16]) {
#pragma unroll
    for (int i = 0; i < 2; ++i) { const u32x4 w = *(const u32x4*)(r + i * 512 + lane * 8);
        x[i * 8 + 0] = __uint_as_float(w.x << 16); x[i * 8 + 1] = __uint_as_float(w.x & 0xffff0000u); x[i * 8 + 2] = __uint_as_float(w.y << 16); x[i * 8 + 3] = __uint_as_float(w.y & 0xffff0000u);
        x[i * 8 + 4] = __uint_as_float(w.z << 16); x[i * 8 + 5] = __uint_as_float(w.z & 0xffff0000u); x[i * 8 + 6] = __uint_as_float(w.w << 16); x[i * 8 + 7] = __uint_as_float(w.w & 0xffff0000u); }
}
__device__ __forceinline__ void ld_vec16(const float* v, int lane, float (&x)[16]) {
#pragma unroll
    for (int i = 0; i < 2; ++i) { const float4 a = *(const float4*)(v + i * 512 + lane * 8), c = *(const float4*)(v + i * 512 + lane * 8 + 4);
        x[i * 8 + 0] = a.x; x[i * 8 + 1] = a.y; x[i * 8 + 2] = a.z; x[i * 8 + 3] = a.w; x[i * 8 + 4] = c.x; x[i * 8 + 5] = c.y; x[i * 8 + 6] = c.z; x[i * 8 + 7] = c.w; }
}
__device__ __forceinline__ void phase_norm16(const Params& p, const bf16_t* X) {
    const int lane = tidx() & 63, wave = tidx() >> 6;
    const float* mod = (const float*)(p.ws + WS_MOD) + 9 * 3072;
    bf16_t* H = (bf16_t*)(p.ws + WS_H);
    float gg[16]; ld_vec16(p.in[22], lane, gg);
    const int stride = gridDim.x * 8;
    for (int row0 = blockIdx.x * 8 + wave; row0 < NTOK; row0 += 3 * stride) {
        u32x4 raw[3][2];
#pragma unroll
        for (int k = 0; k < 3; ++k) { const int row = min(row0 + k * stride, NTOK - 1);
#pragma unroll
            for (int i = 0; i < 2; ++i) raw[k][i] = *(const u32x4*)(X + (size_t)row * 1024 + i * 512 + lane * 8); }
#pragma unroll
        for (int k = 0; k < 3; ++k) { const int row = row0 + k * stride;
            if (row < NTOK) {
                const float* mv = mod + (row < NCTX ? 0 : 1 + ((row - NCTX) >> 10)) * 3072;
                float sh[16], sc[16]; ld_vec16(mv, lane, sh); ld_vec16(mv + 1024, lane, sc);
                float x[16];
#pragma unroll
                for (int i = 0; i < 2; ++i) { const u32x4 w = raw[k][i];
                    x[i * 8 + 0] = __uint_as_float(w.x << 16); x[i * 8 + 1] = __uint_as_float(w.x & 0xffff0000u); x[i * 8 + 2] = __uint_as_float(w.y << 16); x[i * 8 + 3] = __uint_as_float(w.y & 0xffff0000u);
                    x[i * 8 + 4] = __uint_as_float(w.z << 16); x[i * 8 + 5] = __uint_as_float(w.z & 0xffff0000u); x[i * 8 + 6] = __uint_as_float(w.w << 16); x[i * 8 + 7] = __uint_as_float(w.w & 0xffff0000u); }
                float ss = 0.f;
#pragma unroll
                for (int e = 0; e < 16; ++e) ss += x[e] * x[e];
                ss = wave_sum(ss);
                const float rstd = rsqrtf(ss * (1.0f / 1024.0f) + 1e-6f);
#pragma unroll
                for (int i = 0; i < 2; ++i) { u32x4 w; float y[8];
#pragma unroll
                    for (int e = 0; e < 8; ++e) y[e] = x[i * 8 + e] * rstd * gg[i * 8 + e] * (1.f + sc[i * 8 + e]) + sh[i * 8 + e];
                    w.x = pk2(y[0], y[1]); w.y = pk2(y[2], y[3]); w.z = pk2(y[4], y[5]); w.w = pk2(y[6], y[7]);
                    *(u32x4*)(H + (size_t)row * 1024 + i * 512 + lane * 8) = w; }
            } }
    }
}
__device__ __forceinline__ void phase_final16(const Params& p, const bf16_t* X) {
    const int lane = tidx() & 63, wave = tidx() >> 6;
    float gg[16]; ld_vec16(p.in[32], lane, gg);
    const int stride = gridDim.x * 8;
    for (int row0 = blockIdx.x * 8 + wave; row0 < NTOK; row0 += 3 * stride) {
        u32x4 raw[3][2];
#pragma unroll
        for (int k = 0; k < 3; ++k) { const int row = min(row0 + k * stride, NTOK - 1);
#pragma unroll
            for (int i = 0; i < 2; ++i) raw[k][i] = *(const u32x4*)(X + (size_t)row * 1024 + i * 512 + lane * 8); }
#pragma unroll
        for (int k = 0; k < 3; ++k) { const int row = row0 + k * stride;
            if (row < NTOK) {
                float x[16];
#pragma unroll
                for (int i = 0; i < 2; ++i) { const u32x4 w = raw[k][i];
                    x[i * 8 + 0] = __uint_as_float(w.x << 16); x[i * 8 + 1] = __uint_as_float(w.x & 0xffff0000u); x[i * 8 + 2] = __uint_as_float(w.y << 16); x[i * 8 + 3] = __uint_as_float(w.y & 0xffff0000u);
                    x[i * 8 + 4] = __uint_as_float(w.z << 16); x[i * 8 + 5] = __uint_as_float(w.z & 0xffff0000u); x[i * 8 + 6] = __uint_as_float(w.w << 16); x[i * 8 + 7] = __uint_as_float(w.w & 0xffff0000u); }
                float ss = 0.f;
#pragma unroll
                for (int e = 0; e < 16; ++e) ss += x[e] * x[e];
                ss = wave_sum(ss);
                const float rstd = rsqrtf(ss * (1.0f / 1024.0f) + 1e-6f);
                float* yr = p.out + (size_t)row * 1024;
#pragma unroll
                for (int i = 0; i < 2; ++i) {
                    float4 o0, o1;
                    o0.x = x[i * 8 + 0] * rstd * gg[i * 8 + 0]; o0.y = x[i * 8 + 1] * rstd * gg[i * 8 + 1]; o0.z = x[i * 8 + 2] * rstd * gg[i * 8 + 2]; o0.w = x[i * 8 + 3] * rstd * gg[i * 8 + 3];
                    o1.x = x[i * 8 + 4] * rstd * gg[i * 8 + 4]; o1.y = x[i * 8 + 5] * rstd * gg[i * 8 + 5]; o1.z = x[i * 8 + 6] * rstd * gg[i * 8 + 6]; o1.w = x[i * 8 + 7] * rstd * gg[i * 8 + 7];
                    *(float4*)(yr + i * 512 + lane * 8) = o0; *(float4*)(yr + i * 512 + lane * 8 + 4) = o1; }
            } }
    }
}

constexpr float QSCALE = 0.125f * 1.4426950408889634f;
__device__ __forceinline__ u32x2 pk4(const f32x4& v) { u32x2 w; w.x = pg8::cvt_pk_bf16(v[0], v[1]); w.y = pg8::cvt_pk_bf16(v[2], v[3]); return w; }
__device__ __forceinline__ u32x4 pk8(const f32x4& a, const f32x4& b) { u32x4 w; w.x = pg8::cvt_pk_bf16(a[0], a[1]); w.y = pg8::cvt_pk_bf16(a[2], a[3]); w.z = pg8::cvt_pk_bf16(b[0], b[1]); w.w = pg8::cvt_pk_bf16(b[2], b[3]); return w; }

template <bool IN16>
struct EpiRes {
    static constexpr bool PERM = true, AFTER_DRAIN = false;
    const float* xa; const float* xb; const bf16_t* x16; bf16_t* xo; const float* gate;
    __device__ __forceinline__ void operator()(const f32x4 (&acc)[2][2][4][2], const pg8::Unit& u, int wr, int wc, int fr, int fq) const {
        const int row0 = u.pm * 256 + wr * 64 + fr, col0 = u.pn * 256 + wc * 32 + 8 * fq;
        const bool ctx = u.pm < 16;
        const int mi = ctx ? 0 : 1 + ((u.pm - 16) >> 2);
        const float* xbase = (ctx ? xa + (size_t)row0 * 1024 : xb + (size_t)(row0 - NCTX) * 1024) + col0;
        const bf16_t* x16b = x16 + (size_t)row0 * 1024 + col0;
        bf16_t* obase = xo + (size_t)row0 * 1024 + col0;
        f32x4 gv[2][2];
#pragma unroll
        for (int bj = 0; bj < 2; ++bj)
#pragma unroll
            for (int n = 0; n < 2; ++n) gv[bj][n] = *(const f32x4*)(gate + mi * 3072 + col0 + bj * 128 + 4 * n);
#pragma unroll
        for (int ai = 0; ai < 2; ++ai) {
            f32x4 xv[4][2][2];
#pragma unroll
            for (int m = 0; m < 4; ++m)
#pragma unroll
                for (int bj = 0; bj < 2; ++bj) {
                    const size_t off = (size_t)(ai * 128 + m * 16) * 1024 + bj * 128;
                    if (IN16) { const u32x4 w = *(const u32x4*)(x16b + off);
                        xv[m][bj][0] = (f32x4){__uint_as_float(w.x << 16), __uint_as_float(w.x & 0xffff0000u), __uint_as_float(w.y << 16), __uint_as_float(w.y & 0xffff0000u)};
                        xv[m][bj][1] = (f32x4){__uint_as_float(w.z << 16), __uint_as_float(w.z & 0xffff0000u), __uint_as_float(w.w << 16), __uint_as_float(w.w & 0xffff0000u)}; }
                    else { xv[m][bj][0] = *(const f32x4*)(xbase + off); xv[m][bj][1] = *(const f32x4*)(xbase + off + 4); }
                }
            __builtin_amdgcn_sched_barrier(0);
#pragma unroll
            for (int m = 0; m < 4; ++m)
#pragma unroll
                for (int bj = 0; bj < 2; ++bj)
                    *(u32x4*)(obase + (size_t)(ai * 128 + m * 16) * 1024 + bj * 128) = pk8(xv[m][bj][0] + gv[bj][0] * acc[ai][bj][m][0], xv[m][bj][1] + gv[bj][1] * acc[ai][bj][m][1]);
        }
    }
};

struct Epi1 {
    static constexpr bool PERM = true, AFTER_DRAIN = false;
    unsigned char* ws; float* out;
    __device__ __forceinline__ void operator()(const f32x4 (&acc)[2][2][4][2], const pg8::Unit& u, int wr, int wc, int fr, int fq) const {
        const int reg = u.pn >> 1, cb = (u.pn & 1) * 256 + wc * 32 + 8 * fq;
        const bool ctx = u.pm < 16;
        bf16_t* P0 = (bf16_t*)(ws + WS_P);
#pragma unroll
        for (int ai = 0; ai < 2; ++ai)
#pragma unroll
            for (int m = 0; m < 4; ++m) {
                const int row = u.pm * 256 + ai * 128 + wr * 64 + m * 16 + fr;
                const int lt = row - NCTX, b = ctx ? (row >> 8) : (lt >> 10), t = ctx ? (row & 255) : (lt & 1023);
#pragma unroll
                for (int bj = 0; bj < 2; ++bj) {
                    const int c = cb + bj * 128; const f32x4 v0 = acc[ai][bj][m][0], v1 = acc[ai][bj][m][1];
                    if (reg == 0) *(u32x4*)(P0 + (size_t)row * 2048 + c) = pk8(v0 * QSCALE, v1 * QSCALE);
                    else if (reg >= 3) *(u32x4*)(P0 + (size_t)row * 2048 + (reg - 2) * 512 + c) = pk8(v0, v1);
                    else if (reg == 1) {
                        if (ctx) { float* o = out + O_NAK + (size_t)row * 512 + c; *(f32x4*)o = v0; *(f32x4*)(o + 4) = v1;
                            *(u32x4*)((bf16_t*)(ws + WS_K0C) + (size_t)row * 512 + c) = pk8(v0, v1); }
                        else *(u32x4*)((bf16_t*)(ws + WS_K0L) + ((size_t)b * 1280 + 256 + t) * 512 + c) = pk8(v0, v1);
                    } else {
                        if (ctx) { float* o = out + O_NAV + (size_t)row * 512 + c; *(f32x4*)o = v0; *(f32x4*)(o + 4) = v1;
                            *(u32x4*)((bf16_t*)(ws + WS_V0C) + (size_t)row * 512 + c) = pk8(v0, v1); }
                        else *(u32x4*)((bf16_t*)(ws + WS_V0L) + ((size_t)b * 1280 + 256 + t) * 512 + c) = pk8(v0, v1);
                    }
                }
            }
    }
};

struct Epi3 {
    static constexpr bool PERM = true, AFTER_DRAIN = false;
    unsigned char* ws; float* out;
    __device__ __forceinline__ void operator()(const f32x4 (&acc)[2][2][4][2], const pg8::Unit& u, int wr, int wc, int fr, int fq) const {
        const int reg = u.pn >> 2, cb = (u.pn & 3) * 256 + wc * 32 + 8 * fq;
        const bool ctx = u.pm < 16;
        bf16_t* P1 = (bf16_t*)(ws + WS_P);
        const float* rc = (const float*)(ws + WS_ROPE);
        const bool rope = !ctx && reg < 2;
        const float sgn = fq >= 2 ? 1.0f : -1.0f;
#pragma unroll
        for (int ai = 0; ai < 2; ++ai) {
            f32x4 csv[4][2], snv[4][2];
            if (rope) {
#pragma unroll
                for (int m = 0; m < 4; ++m) { const int t = (u.pm * 256 + ai * 128 + wr * 64 + m * 16 + fr - NCTX) & 1023; const int pos = (wc & 1) ? (t & 63) : (t >> 6);
#pragma unroll
                    for (int n = 0; n < 2; ++n) { const int idx = pos * 16 + 8 * (fq & 1) + 4 * n; csv[m][n] = *(const f32x4*)(rc + idx); snv[m][n] = *(const f32x4*)(rc + 1024 + idx); } }
            }
#pragma unroll
            for (int m = 0; m < 4; ++m) {
                const int row = u.pm * 256 + ai * 128 + wr * 64 + m * 16 + fr;
                const int lt = row - NCTX, b = ctx ? (row >> 8) : (lt >> 10), t = ctx ? (row & 255) : (lt & 1023);
#pragma unroll
                for (int bj = 0; bj < 2; ++bj) {
                    f32x4 v0 = acc[ai][bj][m][0], v1 = acc[ai][bj][m][1];
                    if (rope) {
                        f32x4 p0, p1;
#pragma unroll
                        for (int j = 0; j < 4; ++j) { p0[j] = __shfl_xor(v0[j], 32); p1[j] = __shfl_xor(v1[j], 32); }
                        v0 = v0 * csv[m][0] + (p0 * snv[m][0]) * sgn; v1 = v1 * csv[m][1] + (p1 * snv[m][1]) * sgn;
                    }
                    const int c = cb + bj * 128;
                    if (reg == 0) *(u32x4*)(P1 + (size_t)row * 2048 + c) = pk8(v0 * QSCALE, v1 * QSCALE);
                    else if (reg == 3) *(u32x4*)(P1 + (size_t)row * 2048 + 1024 + c) = pk8(v0, v1);
                    else if (reg == 1) {
                        if (ctx) { float* o = out + O_DK + (size_t)row * 1024 + c; *(f32x4*)o = v0; *(f32x4*)(o + 4) = v1;
                            *(u32x4*)((bf16_t*)(ws + WS_K1C) + (size_t)row * 1024 + c) = pk8(v0, v1); }
                        else *(u32x4*)((bf16_t*)(ws + WS_K1L) + ((size_t)b * 1280 + 256 + t) * 1024 + c) = pk8(v0, v1);
                    } else {
                        if (ctx) { float* o = out + O_DV + (size_t)row * 1024 + c; *(f32x4*)o = v0; *(f32x4*)(o + 4) = v1;
                            *(u32x4*)((bf16_t*)(ws + WS_V1C) + (size_t)row * 1024 + c) = pk8(v0, v1); }
                        else *(u32x4*)((bf16_t*)(ws + WS_V1L) + ((size_t)b * 1280 + 256 + t) * 1024 + c) = pk8(v0, v1);
                    }
                }
            }
        }
    }
};
#define MFMA16(a, b, c) __builtin_amdgcn_mfma_f32_16x16x32_bf16(a, b, c, 0, 0, 0)
constexpr float SC_LOG2 = 0.125f * 1.4426950408889634f;
constexpr float LOG2E = 1.4426950408889634f;
constexpr float RS_TAU = 8.0f;
__device__ __forceinline__ float ex2(float x) { return __builtin_amdgcn_exp2f(x); }
__device__ __forceinline__ bf16x8 pack8(const float (&v)[8]) {
    u32x4 w; w.x = pg8::cvt_pk_bf16(v[0], v[1]); w.y = pg8::cvt_pk_bf16(v[2], v[3]); w.z = pg8::cvt_pk_bf16(v[4], v[5]); w.w = pg8::cvt_pk_bf16(v[6], v[7]);
    return __builtin_bit_cast(bf16x8, w);
}
__device__ __forceinline__ bf16x8 cat2(u32x2 a, u32x2 b) { u32x4 w; w.x = a.x; w.y = a.y; w.z = b.x; w.w = b.y; return __builtin_bit_cast(bf16x8, w); }

template <int DK, int DV> struct ACfg {
    static constexpr int KP = DK * 2 + 16, VP = 136;
    static constexpr int KBYTES = 64 * KP, VBYTES = DV * VP, STAGE = KBYTES + VBYTES;
    static constexpr int NK = DK / 64, NV = DV / 64;
};
template <int DK, int DV>
__device__ __forceinline__ void stage_load(const bf16_t* Ksrc, size_t ldk, const bf16_t* Vsrc, size_t ldv, u32x4 (&kr)[DK / 64], u32x4 (&vr)[DV / 64], int tid) {
#pragma unroll
    for (int i = 0; i < DK / 64; ++i) { const int idx = tid + i * 512, row = idx / (DK / 8), pc = idx % (DK / 8); kr[i] = *(const u32x4*)(Ksrc + (size_t)row * ldk + pc * 8); }
#pragma unroll
    for (int i = 0; i < DV / 64; ++i) { const int idx = tid + i * 512, key = idx & 63, pc = idx >> 6; vr[i] = *(const u32x4*)(Vsrc + (size_t)key * ldv + pc * 8); }
}
template <int DK, int DV>
__device__ __forceinline__ void stage_store(LAS unsigned char* base, const u32x4 (&kr)[DK / 64], const u32x4 (&vr)[DV / 64], int tid) {
    typedef ACfg<DK, DV> C;
#pragma unroll
    for (int i = 0; i < DK / 64; ++i) { const int idx = tid + i * 512, row = idx / (DK / 8), pc = idx % (DK / 8); *(LAS u32x4*)(base + row * C::KP + pc * 16) = kr[i]; }
#pragma unroll
    for (int i = 0; i < DV / 64; ++i) { const int idx = tid + i * 512, key = idx & 63, pc = idx >> 6;
        LAS unsigned char* d = base + C::KBYTES + (pc * 8) * C::VP + key * 2;
        *(LAS unsigned short*)(d + 0 * C::VP) = (unsigned short)(vr[i].x & 0xffffu); *(LAS unsigned short*)(d + 1 * C::VP) = (unsigned short)(vr[i].x >> 16);
        *(LAS unsigned short*)(d + 2 * C::VP) = (unsigned short)(vr[i].y & 0xffffu); *(LAS unsigned short*)(d + 3 * C::VP) = (unsigned short)(vr[i].y >> 16);
        *(LAS unsigned short*)(d + 4 * C::VP) = (unsigned short)(vr[i].z & 0xffffu); *(LAS unsigned short*)(d + 5 * C::VP) = (unsigned short)(vr[i].z >> 16);
        *(LAS unsigned short*)(d + 6 * C::VP) = (unsigned short)(vr[i].w & 0xffffu); *(LAS unsigned short*)(d + 7 * C::VP) = (unsigned short)(vr[i].w >> 16); }
}

struct St1 { f32x4 O[4]; float m, l; };
template <bool BIAS>
__device__ __forceinline__ void chunk1(const LAS unsigned char* kt, const LAS unsigned char* vt, int fr, int fq, const bf16x8 (&qf)[2], St1& st, const float (&bias)[8]) {
    typedef ACfg<64, 64> C;
    const LAS unsigned char* kl = kt + fr * C::KP + fq * 16;
    const LAS unsigned char* vl = vt + fr * C::VP + fq * 8;
    const bf16x8 k00 = *(const LAS bf16x8*)(kl), k01 = *(const LAS bf16x8*)(kl + 64), k10 = *(const LAS bf16x8*)(kl + 16 * C::KP), k11 = *(const LAS bf16x8*)(kl + 16 * C::KP + 64);
    u32x2 va[4], vb[4];
#pragma unroll
    for (int db = 0; db < 4; ++db) { va[db] = *(const LAS u32x2*)(vl + db * 16 * C::VP); vb[db] = *(const LAS u32x2*)(vl + db * 16 * C::VP + 32); }
    f32x4 s0 = {0.f, 0.f, 0.f, 0.f}, s1 = {0.f, 0.f, 0.f, 0.f};
    s0 = MFMA16(k00, qf[0], s0); s0 = MFMA16(k01, qf[1], s0); s1 = MFMA16(k10, qf[0], s1); s1 = MFMA16(k11, qf[1], s1);
    float sv[8];
#pragma unroll
    for (int j = 0; j < 4; ++j) { sv[j] = s0[j]; sv[4 + j] = s1[j]; }
    if (BIAS) {
#pragma unroll
        for (int i = 0; i < 8; ++i) sv[i] += bias[i];
    }
    float cm = fmaxf(fmaxf(fmaxf(sv[0], sv[1]), fmaxf(sv[2], sv[3])), fmaxf(fmaxf(sv[4], sv[5]), fmaxf(sv[6], sv[7])));
    cm = fmaxf(cm, __shfl_xor(cm, 16)); cm = fmaxf(cm, __shfl_xor(cm, 32));
    float mn = st.m;
    if (__builtin_amdgcn_ballot_w64(cm > st.m + RS_TAU)) {
        mn = fmaxf(st.m, cm);
        const float al = ex2(st.m - mn);
        st.l *= al;
#pragma unroll
        for (int db = 0; db < 4; ++db) st.O[db] *= al;
        st.m = mn;
    }
    float ps = 0.f;
#pragma unroll
    for (int i = 0; i < 8; ++i) { sv[i] = ex2(sv[i] - mn); ps += sv[i]; }
    st.l += ps;
    const bf16x8 pf = pack8(sv);
#pragma unroll
    for (int db = 0; db < 4; ++db) st.O[db] = MFMA16(cat2(va[db], vb[db]), pf, st.O[db]);
}

struct St2 { f32x4 O1[8], O2[8]; float m1, l1, m2, l2; };
__device__ __forceinline__ void qk_sm2(const LAS unsigned char* kt, int fr, int fq, const bf16x8 (&qf)[4], St2& st, bf16x8 (&pf1)[2], bf16x8 (&pf2)[2]) {
    typedef ACfg<128, 128> C;
    const LAS unsigned char* kl = kt + fr * C::KP + fq * 16;
    f32x4 a[4], b[4];
#pragma unroll
    for (int kh = 0; kh < 2; ++kh) {
        bf16x8 kf[2][4];
#pragma unroll
        for (int k2 = 0; k2 < 2; ++k2)
#pragma unroll
            for (int i = 0; i < 4; ++i) kf[k2][i] = *(const LAS bf16x8*)(kl + (kh * 2 + k2) * 16 * C::KP + i * 64);
        __builtin_amdgcn_sched_barrier(0);
#pragma unroll
        for (int k2 = 0; k2 < 2; ++k2) { const int kb = kh * 2 + k2;
            a[kb] = (f32x4){0.f, 0.f, 0.f, 0.f}; b[kb] = (f32x4){0.f, 0.f, 0.f, 0.f};
            a[kb] = MFMA16(kf[k2][0], qf[0], a[kb]); a[kb] = MFMA16(kf[k2][1], qf[1], a[kb]);
            b[kb] = MFMA16(kf[k2][2], qf[2], b[kb]); b[kb] = MFMA16(kf[k2][3], qf[3], b[kb]); }
    }
    float c1 = fmaxf(fmaxf(a[0][0], a[0][1]), fmaxf(a[0][2], a[0][3])), c2 = fmaxf(fmaxf(b[0][0], b[0][1]), fmaxf(b[0][2], b[0][3]));
#pragma unroll
    for (int kb = 1; kb < 4; ++kb) { c1 = fmaxf(c1, fmaxf(fmaxf(a[kb][0], a[kb][1]), fmaxf(a[kb][2], a[kb][3]))); c2 = fmaxf(c2, fmaxf(fmaxf(b[kb][0], b[kb][1]), fmaxf(b[kb][2], b[kb][3]))); }
    c1 = fmaxf(c1, __shfl_xor(c1, 16)); c1 = fmaxf(c1, __shfl_xor(c1, 32));
    c2 = fmaxf(c2, __shfl_xor(c2, 16)); c2 = fmaxf(c2, __shfl_xor(c2, 32));
    float n1 = st.m1, n2 = st.m2;
    const bool grow = (c1 > st.m1 + RS_TAU) || (c2 > st.m2 + RS_TAU);
    if (__builtin_amdgcn_ballot_w64(grow)) {
        n1 = fmaxf(st.m1, c1); n2 = fmaxf(st.m2, c2);
        const float al1 = ex2(st.m1 - n1), al2 = ex2(st.m2 - n2);
        st.l1 *= al1; st.l2 *= al2;
#pragma unroll
        for (int db = 0; db < 8; ++db) { st.O1[db] *= al1; st.O2[db] *= al2; }
        st.m1 = n1; st.m2 = n2;
    }
    float p1 = 0.f, p2 = 0.f;
#pragma unroll
    for (int hf = 0; hf < 2; ++hf) {
        float e1[8], e2[8];
#pragma unroll
        for (int j = 0; j < 4; ++j) { e1[j] = ex2(a[2 * hf][j] - n1); e1[4 + j] = ex2(a[2 * hf + 1][j] - n1); e2[j] = ex2(b[2 * hf][j] - n2); e2[4 + j] = ex2(b[2 * hf + 1][j] - n2); }
#pragma unroll
        for (int i = 0; i < 8; ++i) { p1 += e1[i]; p2 += e2[i]; }
        pf1[hf] = pack8(e1); pf2[hf] = pack8(e2);
    }
    st.l1 += p1; st.l2 += p2;
}
__device__ __forceinline__ void pv2(const LAS unsigned char* vt, int fr, int fq, const bf16x8 (&pf1)[2], const bf16x8 (&pf2)[2], St2& st) {
    typedef ACfg<128, 128> C;
    const LAS unsigned char* vl = vt + fr * C::VP + fq * 8;
#pragma unroll
    for (int dg = 0; dg < 2; ++dg) {
        u32x2 va[4][2], vb[4][2];
#pragma unroll
        for (int d4 = 0; d4 < 4; ++d4)
#pragma unroll
            for (int hf = 0; hf < 2; ++hf) { va[d4][hf] = *(const LAS u32x2*)(vl + (dg * 4 + d4) * 16 * C::VP + hf * 64); vb[d4][hf] = *(const LAS u32x2*)(vl + (dg * 4 + d4) * 16 * C::VP + hf * 64 + 32); }
        __builtin_amdgcn_sched_barrier(0);
#pragma unroll
        for (int d4 = 0; d4 < 4; ++d4)
#pragma unroll
            for (int hf = 0; hf < 2; ++hf) { const int db = dg * 4 + d4; const bf16x8 vf = cat2(va[d4][hf], vb[d4][hf]);
                st.O1[db] = MFMA16(vf, pf1[hf], st.O1[db]);
                st.O2[db] = MFMA16(vf, pf2[hf], st.O2[db]); }
    }
}

__device__ __forceinline__ void step1(const LAS unsigned char* kt, const LAS unsigned char* vt, int fr, int fq, const bf16x8 (&qf)[2], St1& st) {
    typedef ACfg<64, 64> C;
    const LAS unsigned char* kl = kt + fr * C::KP + fq * 16;
    const LAS unsigned char* vl = vt + fr * C::VP + fq * 8;
    f32x4 a[4];
    {
        bf16x8 kf[4][2];
#pragma unroll
        for (int kb = 0; kb < 4; ++kb) { kf[kb][0] = *(const LAS bf16x8*)(kl + kb * 16 * C::KP); kf[kb][1] = *(const LAS bf16x8*)(kl + kb * 16 * C::KP + 64); }
        __builtin_amdgcn_sched_barrier(0);
#pragma unroll
        for (int kb = 0; kb < 4; ++kb) { a[kb] = (f32x4){0.f, 0.f, 0.f, 0.f}; a[kb] = MFMA16(kf[kb][0], qf[0], a[kb]); a[kb] = MFMA16(kf[kb][1], qf[1], a[kb]); }
    }
    float c1 = fmaxf(fmaxf(a[0][0], a[0][1]), fmaxf(a[0][2], a[0][3]));
#pragma unroll
    for (int kb = 1; kb < 4; ++kb) c1 = fmaxf(c1, fmaxf(fmaxf(a[kb][0], a[kb][1]), fmaxf(a[kb][2], a[kb][3])));
    c1 = fmaxf(c1, __shfl_xor(c1, 16)); c1 = fmaxf(c1, __shfl_xor(c1, 32));
    float n1 = st.m;
    if (__builtin_amdgcn_ballot_w64(c1 > st.m + RS_TAU)) {
        n1 = fmaxf(st.m, c1);
        const float al = ex2(st.m - n1);
        st.l *= al;
#pragma unroll
        for (int db = 0; db < 4; ++db) st.O[db] *= al;
        st.m = n1;
    }
    float p1 = 0.f;
    bf16x8 pf[2];
#pragma unroll
    for (int hf = 0; hf < 2; ++hf) {
        float e1[8];
#pragma unroll
        for (int j = 0; j < 4; ++j) { e1[j] = ex2(a[2 * hf][j] - n1); e1[4 + j] = ex2(a[2 * hf + 1][j] - n1); }
#pragma unroll
        for (int i = 0; i < 8; ++i) p1 += e1[i];
        pf[hf] = pack8(e1);
    }
    st.l += p1;
    {
        u32x2 va[4][2], vb[4][2];
#pragma unroll
        for (int db = 0; db < 4; ++db)
#pragma unroll
            for (int hf = 0; hf < 2; ++hf) { va[db][hf] = *(const LAS u32x2*)(vl + db * 16 * C::VP + hf * 64); vb[db][hf] = *(const LAS u32x2*)(vl + db * 16 * C::VP + hf * 64 + 32); }
        __builtin_amdgcn_sched_barrier(0);
#pragma unroll
        for (int db = 0; db < 4; ++db)
#pragma unroll
            for (int hf = 0; hf < 2; ++hf) st.O[db] = MFMA16(cat2(va[db][hf], vb[db][hf]), pf[hf], st.O[db]);
    }
}

constexpr int A0_RPB_OFF = 36864;
__device__ __forceinline__ void attn0_item(const Params& p, int item, LAS unsigned char* lds) {
    typedef ACfg<64, 64> C;
    const int tid = tidx(), lane = tid & 63, w = tid >> 6, fr = lane & 15, fq = lane >> 4;
    const bf16_t* P0 = (const bf16_t*)(p.ws + WS_P);
    bf16_t* Y = (bf16_t*)(p.ws + WS_Y);
    St1 st;
#pragma unroll
    for (int db = 0; db < 4; ++db) st.O[db] = (f32x4){0.f, 0.f, 0.f, 0.f};
    st.m = -1e30f; st.l = 0.f;
    bf16x8 qf[2]; int tok, h;
    float bias[8];
#pragma unroll
    for (int i = 0; i < 8; ++i) bias[i] = 0.f;
    const bf16_t* K; const bf16_t* V; size_t ldv; int nsteps, nwin, rs0, r = 0, rs = 0, span0 = 0, qc = 0, cs = 0;
    LAS float* rpbs = (LAS float*)(lds + A0_RPB_OFF);
    __syncthreads();
    if (item < 512) {
        const int b = item >> 6; h = (item >> 3) & 7; const int rp = item & 7;
        r = 2 * rp + (w >> 2); const int cq = w & 3, c0 = cq * 16;
        tok = NCTX + b * 1024 + r * 64 + c0 + fr;
        span0 = cq == 0 ? 0 : (cq == 1 ? 8 : (cq == 2 ? 24 : 32));
        rs = min(max(r - 4, 0), 8); qc = c0 + fr; cs = min(max(qc - 8, 0), 48);
        rs0 = min(max(2 * rp - 4, 0), 8); const int rs1 = min(max(2 * rp - 3, 0), 8); nwin = 8 + rs1 - rs0; nsteps = nwin + 4;
        K = (const bf16_t*)(p.ws + WS_K0L) + (size_t)b * 1280 * 512 + h * 64;
        V = (const bf16_t*)(p.ws + WS_V0L) + (size_t)b * 1280 * 512 + h * 64; ldv = 512;
        if (tid < 465) rpbs[tid] = p.in[13][h * 465 + tid] * LOG2E;
    } else {
        const int it = item - 512; const int b = it >> 4; h = (it >> 1) & 7; const int qb = it & 1;
        tok = b * 256 + qb * 128 + w * 16 + fr;
        nwin = 0; nsteps = 4; rs0 = 0;
        K = (const bf16_t*)(p.ws + WS_K0C) + (size_t)b * 256 * 512 + h * 64;
        V = (const bf16_t*)(p.ws + WS_V0C) + (size_t)b * 256 * 512 + h * 64; ldv = 512;
    }
    qf[0] = *(const bf16x8*)(P0 + (size_t)tok * 2048 + h * 64 + fq * 8); qf[1] = *(const bf16x8*)(P0 + (size_t)tok * 2048 + h * 64 + 32 + fq * 8);
    u32x2 gwv[4];
#pragma unroll
    for (int db = 0; db < 4; ++db) gwv[db] = *(const u32x2*)(P0 + (size_t)tok * 2048 + 512 + h * 64 + db * 16 + fq * 4);
#define A0_KEY0(s) ((s) < nwin ? 256 + (rs0 + (s)) * 64 : ((s) - nwin) * 64)
#define A0_LOAD(s, KR, VR) do { const int _k0 = A0_KEY0(s); stage_load<64, 64>(K + (size_t)_k0 * 512, 512, V + (size_t)_k0 * 512, ldv, KR, VR, tid); } while (0)
#define A0_COMPUTE(s, cur) do { \
        if ((s) < nwin) { const int krow = rs0 + (s); \
            if (krow >= rs && krow < rs + 8) { const LAS float* rb = rpbs + (krow - r + 7) * 31; \
                _Pragma("unroll") for (int i = 0; i < 8; ++i) { const int kc = span0 + (i >> 2) * 16 + fq * 4 + (i & 3); \
                    const bool ok = kc >= cs && kc < cs + 16; const int dc = min(max(kc - qc + 15, 0), 30); bias[i] = ok ? rb[dc] : -1e30f; } \
                chunk1<true>((cur) + span0 * C::KP, (cur) + C::KBYTES + span0 * 2, fr, fq, qf, st, bias); } \
        } else step1((cur), (cur) + C::KBYTES, fr, fq, qf, st); } while (0)
    u32x4 krA[1], vrA[1], krB[1], vrB[1];
    A0_LOAD(0, krA, vrA);
    A0_LOAD(1, krB, vrB);
    stage_store<64, 64>(lds, krA, vrA, tid);
    __syncthreads();
    for (int s = 0; s < nsteps; s += 2) {
        if (s + 2 < nsteps) A0_LOAD(s + 2, krA, vrA);
        A0_COMPUTE(s, lds);
        if (s + 1 < nsteps) stage_store<64, 64>(lds + C::STAGE, krB, vrB, tid);
        __syncthreads();
        if (s + 1 >= nsteps) break;
        if (s + 3 < nsteps) A0_LOAD(s + 3, krB, vrB);
        A0_COMPUTE(s + 1, lds + C::STAGE);
        if (s + 2 < nsteps) stage_store<64, 64>(lds, krA, vrA, tid);
        __syncthreads();
    }
#undef A0_KEY0
#undef A0_LOAD
#undef A0_COMPUTE
    float l = st.l; l += __shfl_xor(l, 16); l += __shfl_xor(l, 32);
    const float il = 1.0f / l;
#pragma unroll
    for (int db = 0; db < 4; ++db) {
        const int d = db * 16 + fq * 4;
        const u32x2 gw = gwv[db];
        f32x4 o;
        o[0] = st.O[db][0] * il * silu_f(__uint_as_float(gw.x << 16)); o[1] = st.O[db][1] * il * silu_f(__uint_as_float(gw.x & 0xffff0000u));
        o[2] = st.O[db][2] * il * silu_f(__uint_as_float(gw.y << 16)); o[3] = st.O[db][3] * il * silu_f(__uint_as_float(gw.y & 0xffff0000u));
        *(u32x2*)(Y + (size_t)tok * 1024 + h * 64 + d) = pk4(o);
    }
}

__device__ __forceinline__ void attn1_item(const Params& p, int item, float lam, LAS unsigned char* lds) {
    typedef ACfg<128, 128> C;
    const int tid = tidx(), lane = tid & 63, w = tid >> 6, fr = lane & 15, fq = lane >> 4;
    const bf16_t* P1 = (const bf16_t*)(p.ws + WS_P);
    bf16_t* Y = (bf16_t*)(p.ws + WS_Y);
    St2 st;
#pragma unroll
    for (int db = 0; db < 8; ++db) { st.O1[db] = (f32x4){0.f, 0.f, 0.f, 0.f}; st.O2[db] = (f32x4){0.f, 0.f, 0.f, 0.f}; }
    st.m1 = -1e30f; st.l1 = 0.f; st.m2 = -1e30f; st.l2 = 0.f;
    int tok, h, nst; const bf16_t* K; const bf16_t* V; size_t ldv;
    if (item < 512) {
        const int b = item >> 6; h = (item >> 3) & 7; const int qb = item & 7;
        tok = NCTX + b * 1024 + qb * 128 + w * 16 + fr; nst = 20;
        K = (const bf16_t*)(p.ws + WS_K1L) + (size_t)b * 1280 * 1024 + h * 128;
        V = (const bf16_t*)(p.ws + WS_V1L) + (size_t)b * 1280 * 1024 + h * 128; ldv = 1024;
    } else {
        const int it = item - 512; const int b = it >> 4; h = (it >> 1) & 7; const int qb = it & 1;
        tok = b * 256 + qb * 128 + w * 16 + fr; nst = 4;
        K = (const bf16_t*)(p.ws + WS_K1C) + (size_t)b * 256 * 1024 + h * 128;
        V = (const bf16_t*)(p.ws + WS_V1C) + (size_t)b * 256 * 1024 + h * 128; ldv = 1024;
    }
    bf16x8 qf[4];
#pragma unroll
    for (int i = 0; i < 4; ++i) qf[i] = *(const bf16x8*)(P1 + (size_t)tok * 2048 + h * 128 + i * 32 + fq * 8);
    u32x2 gwv[8];
#pragma unroll
    for (int db = 0; db < 8; ++db) gwv[db] = *(const u32x2*)(P1 + (size_t)tok * 2048 + 1024 + h * 128 + db * 16 + fq * 4);
    u32x4 kr[2], vr[2];
    bf16x8 pf1[2], pf2[2];
    const bool late = w >= 4;
    __syncthreads();
    stage_load<128, 128>(K, 1024, V, ldv, kr, vr, tid); stage_store<128, 128>(lds, kr, vr, tid);
    __syncthreads();
    int bc = 0, bp = 2;
    if (late) __builtin_amdgcn_s_setprio(1);
    for (int s = 0; s < nst; ++s) {
        LAS unsigned char* cur = lds + bc * C::STAGE;
        const int bn = bc == 2 ? 0 : bc + 1;
        if (s + 1 < nst) stage_load<128, 128>(K + (size_t)(s + 1) * 64 * 1024, 1024, V + (size_t)(s + 1) * 64 * 1024, ldv, kr, vr, tid);
        if (late) {
            if (s > 0) pv2(lds + bp * C::STAGE + C::KBYTES, fr, fq, pf1, pf2, st);
            qk_sm2(cur, fr, fq, qf, st, pf1, pf2);
        } else {
            qk_sm2(cur, fr, fq, qf, st, pf1, pf2);
            pv2(cur + C::KBYTES, fr, fq, pf1, pf2, st);
        }
        if (s + 1 < nst) stage_store<128, 128>(lds + bn * C::STAGE, kr, vr, tid);
        __syncthreads();
        bp = bc; bc = bn;
    }
    if (late) pv2(lds + bp * C::STAGE + C::KBYTES, fr, fq, pf1, pf2, st);
    __builtin_amdgcn_s_setprio(0);
    float l1 = st.l1; l1 += __shfl_xor(l1, 16); l1 += __shfl_xor(l1, 32);
    float l2 = st.l2; l2 += __shfl_xor(l2, 16); l2 += __shfl_xor(l2, 32);
    const float i1 = 1.0f / l1, i2 = lam / l2;
    float ss = 0.f;
#pragma unroll
    for (int db = 0; db < 8; ++db) { st.O1[db] = st.O1[db] * i1 - st.O2[db] * i2;
        ss += st.O1[db][0] * st.O1[db][0] + st.O1[db][1] * st.O1[db][1] + st.O1[db][2] * st.O1[db][2] + st.O1[db][3] * st.O1[db][3]; }
    ss += __shfl_xor(ss, 16); ss += __shfl_xor(ss, 32);
    const float rstd = rsqrtf(ss * (1.0f / 128.0f) + 1e-6f) * (1.0f - LAM_INIT);
    f32x4 sgv[8];
#pragma unroll
    for (int db = 0; db < 8; ++db) sgv[db] = *(const f32x4*)(p.in[30] + db * 16 + fq * 4);
    __builtin_amdgcn_sched_barrier(0);
#pragma unroll
    for (int db = 0; db < 8; ++db) {
        const int d = db * 16 + fq * 4;
        const u32x2 gw = gwv[db];
        const f32x4 sg = sgv[db];
        f32x4 o;
        o[0] = st.O1[db][0] * rstd * sg[0] * silu_f(__uint_as_float(gw.x << 16)); o[1] = st.O1[db][1] * rstd * sg[1] * silu_f(__uint_as_float(gw.x & 0xffff0000u));
        o[2] = st.O1[db][2] * rstd * sg[2] * silu_f(__uint_as_float(gw.y << 16)); o[3] = st.O1[db][3] * rstd * sg[3] * silu_f(__uint_as_float(gw.y & 0xffff0000u));
        *(u32x2*)(Y + (size_t)tok * 1024 + h * 128 + d) = pk4(o);
    }
}
__device__ __forceinline__ float sigm(float x) { return __builtin_amdgcn_rcpf(1.0f + ex2(-LOG2E * x)); }
__device__ __forceinline__ void lru_item(const Params& p, int item, float* sm) {
    const int tid = tidx(), lane = tid & 63, w = tid >> 6, fr = lane & 15, fq = lane >> 4;
    int s, n; if (item < 64) { s = 16 + (item >> 3); n = item & 7; } else { s = (item - 64) >> 3; n = (item - 64) & 7; }
    const bool lat = s >= 16;
    const int T = lat ? 1024 : 256, tok0 = lat ? NCTX + (s - 16) * 1024 : s * 256, nchunk = T >> 8;
    const bf16_t* P0 = (const bf16_t*)(p.ws + WS_P); bf16_t* Y = (bf16_t*)(p.ws + WS_Y); float* Hf = (float*)(p.ws + WS_HF);
    const bf16_t* Wg = (const bf16_t*)(p.ws + WS_WG);
    float* xcs = sm; float* seg = sm + 256 * 68;
    const int cg8 = (tid & 7) * 8, q0 = tid >> 3;
    for (int dir = 0; dir < 2; ++dir) {
        float ba[4], bx[4], nl[4], carry[4];
#pragma unroll
        for (int dt = 0; dt < 4; ++dt) { const int ch = n * 64 + dt * 16 + fr;
            ba[dt] = p.in[17][dir * 512 + ch]; bx[dt] = p.in[19][dir * 512 + ch]; nl[dt] = -8.0f * LOG2E * log1pf(__expf(-p.in[20][dir * 512 + ch]));
            carry[dt] = lat ? p.in[5][((s - 16) * 2 + dir) * 512 + ch] : 0.f;
        }
        for (int ck = 0; ck < nchunk; ++ck) {
            __syncthreads();
            {
                float cw[4][8], cbv[8];
#pragma unroll
                for (int j = 0; j < 4; ++j) { const f32x4 a = *(const f32x4*)(p.in[14] + j * 512 + n * 64 + cg8), b = *(const f32x4*)(p.in[14] + j * 512 + n * 64 + cg8 + 4);
#pragma unroll
                    for (int k = 0; k < 4; ++k) { cw[j][k] = a[k]; cw[j][4 + k] = b[k]; } }
                { const f32x4 a = *(const f32x4*)(p.in[15] + n * 64 + cg8), b = *(const f32x4*)(p.in[15] + n * 64 + cg8 + 4);
#pragma unroll
                    for (int k = 0; k < 4; ++k) { cbv[k] = a[k]; cbv[4 + k] = b[k]; } }
                u32x4 wv[4][4];
#pragma unroll
                for (int i = 0; i < 4; ++i) {
                    const int q = q0 + 64 * i, pp = ck * 256 + q, t = dir ? T - 1 - pp : pp;
#pragma unroll
                    for (int j = 0; j < 4; ++j) { const int tt = min(max(t - 2 + j, 0), T - 1);
                        wv[i][j] = *(const u32x4*)(P0 + (size_t)(tok0 + tt) * 2048 + 1024 + n * 64 + cg8); }
                }
#pragma unroll
                for (int i = 0; i < 4; ++i) {
                    const int q = q0 + 64 * i, pp = ck * 256 + q, t = dir ? T - 1 - pp : pp;
                    float xc[8];
#pragma unroll
                    for (int k = 0; k < 8; ++k) xc[k] = cbv[k];
#pragma unroll
                    for (int j = 0; j < 4; ++j) { const int tt = t - 2 + j; const float ok = (tt >= 0 && tt < T) ? 1.0f : 0.0f; const u32x4 w4 = wv[i][j];
                        xc[0] += ok * cw[j][0] * __uint_as_float(w4.x << 16); xc[1] += ok * cw[j][1] * __uint_as_float(w4.x & 0xffff0000u);
                        xc[2] += ok * cw[j][2] * __uint_as_float(w4.y << 16); xc[3] += ok * cw[j][3] * __uint_as_float(w4.y & 0xffff0000u);
                        xc[4] += ok * cw[j][4] * __uint_as_float(w4.z << 16); xc[5] += ok * cw[j][5] * __uint_as_float(w4.z & 0xffff0000u);
                        xc[6] += ok * cw[j][6] * __uint_as_float(w4.w << 16); xc[7] += ok * cw[j][7] * __uint_as_float(w4.w & 0xffff0000u); }
                    *(f32x4*)(xcs + q * 68 + cg8) = (f32x4){xc[0], xc[1], xc[2], xc[3]};
                    *(f32x4*)(xcs + q * 68 + cg8 + 4) = (f32x4){xc[4], xc[5], xc[6], xc[7]};
                }
            }
            bf16x8 wfa[2][2], wfx[2][2];
#define LRU_WF(dt_, sl_) do { _Pragma("unroll") for (int ks = 0; ks < 2; ++ks) { \
                wfa[sl_][ks] = *(const bf16x8*)(Wg + (size_t)((((dir * 2 + 0) * 8 + n) * 64) + (dt_) * 16 + fr) * 64 + ks * 32 + fq * 8); \
                wfx[sl_][ks] = *(const bf16x8*)(Wg + (size_t)((((dir * 2 + 1) * 8 + n) * 64) + (dt_) * 16 + fr) * 64 + ks * 32 + fq * 8); } } while (0)
            LRU_WF(0, 0);
            __syncthreads();
            bf16x8 af[2][2];
#pragma unroll
            for (int tt = 0; tt < 2; ++tt)
#pragma unroll
                for (int ks = 0; ks < 2; ++ks) { const float* src = xcs + (w * 32 + tt * 16 + fr) * 68 + ks * 32 + fq * 8;
                    const f32x4 x0 = *(const f32x4*)src, x1 = *(const f32x4*)(src + 4);
                    const float v[8] = {x0[0], x0[1], x0[2], x0[3], x1[0], x1[1], x1[2], x1[3]};
                    af[tt][ks] = pack8(v); }
            float hl[2][4][4], ap[2][4][4], Aex[2][4], Hex[2][4];
#pragma unroll
            for (int dt = 0; dt < 4; ++dt) {
                float At0 = 1.f, Ht0 = 0.f;
                if (dt < 3) LRU_WF(dt + 1, (dt + 1) & 1);
#pragma unroll
                for (int tt = 0; tt < 2; ++tt) {
                    f32x4 ca = {0.f, 0.f, 0.f, 0.f}, cx = {0.f, 0.f, 0.f, 0.f};
#pragma unroll
                    for (int ks = 0; ks < 2; ++ks) { ca = MFMA16(af[tt][ks], wfa[dt & 1][ks], ca); cx = MFMA16(af[tt][ks], wfx[dt & 1][ks], cx); }
                    float h = 0.f, A = 1.f;
#pragma unroll
                    for (int j = 0; j < 4; ++j) {
                        const float xcv = xcs[(w * 32 + tt * 16 + fq * 4 + j) * 68 + dt * 16 + fr];
                        const float rr = sigm(ca[j] + ba[dt]), ii = sigm(cx[j] + bx[dt]);
                        const float a = ex2(rr * nl[dt]), uu = __builtin_amdgcn_sqrtf(fmaxf(1.0f - a * a, 0.f)) * (ii * xcv);
                        h = a * h + uu; A *= a; hl[tt][dt][j] = h; ap[tt][dt][j] = A;
                    }
                    { const float A1 = __shfl_up(A, 16), H1 = __shfl_up(h, 16); if (fq >= 1) { h = A * H1 + h; A = A * A1; } }
                    { const float A2 = __shfl_up(A, 32), H2 = __shfl_up(h, 32); if (fq >= 2) { h = A * H2 + h; A = A * A2; } }
                    float Ae = __shfl_up(A, 16), He = __shfl_up(h, 16); if (fq == 0) { Ae = 1.f; He = 0.f; }
                    const float At = __shfl(A, 48 + fr), Ht = __shfl(h, 48 + fr);
                    if (tt == 0) { Aex[0][dt] = Ae; Hex[0][dt] = He; At0 = At; Ht0 = Ht; }
                    else { Aex[1][dt] = At0 * Ae; Hex[1][dt] = Ae * Ht0 + He;
                        if (fq == 0) { seg[(w * 64 + dt * 16 + fr) * 2] = At0 * At; seg[(w * 64 + dt * 16 + fr) * 2 + 1] = At * Ht0 + Ht; } }
                }
            }
            __syncthreads();
#pragma unroll
            for (int dt = 0; dt < 4; ++dt) {
                float hc = carry[dt], hin = hc;
#pragma unroll
                for (int w2 = 0; w2 < 8; ++w2) { const float A = seg[(w2 * 64 + dt * 16 + fr) * 2], H = seg[(w2 * 64 + dt * 16 + fr) * 2 + 1];
                    hc = A * hc + H; if (w2 + 1 == w) hin = hc; }
                carry[dt] = hc;
#pragma unroll
                for (int tt = 0; tt < 2; ++tt) {
                    const float hs = Aex[tt][dt] * hin + Hex[tt][dt];
#pragma unroll
                    for (int j = 0; j < 4; ++j) xcs[(w * 32 + tt * 16 + fq * 4 + j) * 68 + dt * 16 + fr] = ap[tt][dt][j] * hs + hl[tt][dt][j];
                }
            }
            const int tid2 = tidx();
            f32x4 hfa[4][2]; u32x4 gba[4];
            if (dir == 1) {
#pragma unroll
                for (int i = 0; i < 4; ++i) { const int piece = tid2 + i * 512, q = piece >> 3, c8 = (piece & 7) * 8; const size_t tk = (size_t)(tok0 + T - 1 - (ck * 256 + q));
                    hfa[i][0] = *(const f32x4*)(Hf + tk * 512 + n * 64 + c8); hfa[i][1] = *(const f32x4*)(Hf + tk * 512 + n * 64 + c8 + 4);
                    gba[i] = *(const u32x4*)(P0 + tk * 2048 + 1536 + n * 64 + c8); }
            }
            __syncthreads();
#pragma unroll
            for (int i = 0; i < 4; ++i) {
                const int piece = tid2 + i * 512, q = piece >> 3, c8 = (piece & 7) * 8, pp = ck * 256 + q;
                const f32x4 h0 = *(const f32x4*)(xcs + q * 68 + c8), h1 = *(const f32x4*)(xcs + q * 68 + c8 + 4);
                if (dir == 0) { float* o = Hf + (size_t)(tok0 + pp) * 512 + n * 64 + c8; *(f32x4*)o = h0; *(f32x4*)(o + 4) = h1; }
                else {
                    const u32x4 gw = gba[i];
                    f32x4 g0 = {__uint_as_float(gw.x << 16), __uint_as_float(gw.x & 0xffff0000u), __uint_as_float(gw.y << 16), __uint_as_float(gw.y & 0xffff0000u)};
                    f32x4 g1 = {__uint_as_float(gw.z << 16), __uint_as_float(gw.z & 0xffff0000u), __uint_as_float(gw.w << 16), __uint_as_float(gw.w & 0xffff0000u)};
                    f32x4 y0, y1;
#pragma unroll
                    for (int e = 0; e < 4; ++e) { y0[e] = (hfa[i][0][e] + h0[e]) * g0[e] * sigm(g0[e]); y1[e] = (hfa[i][1][e] + h1[e]) * g1[e] * sigm(g1[e]); }
                    *(u32x4*)(Y + (size_t)(tok0 + T - 1 - pp) * 1024 + 512 + n * 64 + c8) = pk8(y0, y1);
                }
            }
        }
#undef LRU_WF
        if (!lat && w == 0 && fq == 0) {
#pragma unroll
            for (int dt = 0; dt < 4; ++dt) p.out[O_LRU + (s * 2 + dir) * 512 + n * 64 + dt * 16 + fr] = carry[dt];
        }
    }
}
__device__ __forceinline__ void gsync(const Params& p) {
    extern __shared__ __attribute__((aligned(16))) unsigned char smem_[];
    XcdBarrier b; b.bar = (unsigned*)(p.ws + WS_BAR); b.x = xb_xcc_id(); b.st = (volatile LAS unsigned*)((LAS unsigned char*)smem_ + 131072);
    xcd_barrier(b);
}
__global__ void __launch_bounds__(512) mega(Params p) {
    extern __shared__ __attribute__((aligned(16))) unsigned char smem[];
    cg::grid_group grid = cg::this_grid();
    PG8_LAS unsigned char* lds = (PG8_LAS unsigned char*)smem;
    const float* mod = (const float*)(p.ws + WS_MOD);
    pg8::StaticOrder S;
    volatile LAS unsigned* xst = (volatile LAS unsigned*)(lds + 131072);
    if (threadIdx.x == 0) { xst[0] = 0u; xst[1] = 0u; }
    __syncthreads();
    (void)xcd_barrier_post((unsigned*)(p.ws + WS_BAR), xst);
    phaseA(p, (float*)smem);
    grid.sync();
    phaseA1b(p, (float*)smem);
    phase_norm(p, 0, p.in[0], p.in[1]);
    gsync(p);
    { pg8::Gemm g{(const bf16_t*)(p.ws + WS_H), (const bf16_t*)(p.ws + WS_W1T), NTOK, 3072, 1024}; S.init(NTOK, 3072, (int)gridDim.x, (int)blockIdx.x);
      Epi1 E{p.ws, p.out};
      pg8::gemm_phase<Epi1, pg8::StaticOrder, false>(lds, g, S, E, nullptr); }
    if (blockIdx.x >= 64) phaseA2(p, (float*)smem, (int)blockIdx.x - 64, (int)gridDim.x - 64);
    gsync(p);
    {
        unsigned* qctr = (unsigned*)(p.ws + WS_BAR);
        volatile LAS int* slot = (volatile LAS int*)(lds + 131072 + 16);
        for (;;) {
            __syncthreads();
            if (threadIdx.x == 0) *slot = (int)__hip_atomic_fetch_add(qctr, 1u, __ATOMIC_RELAXED, __HIP_MEMORY_SCOPE_AGENT);
            __syncthreads();
            const int q = *slot;
            if (q >= 960) break;
            int kind, idx;
            if (q < 64) { kind = 0; idx = q; } else if (q < 576) { kind = 1; idx = q - 64; } else if (q < 704) { kind = 0; idx = 64 + q - 576; } else { kind = 1; idx = 512 + q - 704; }
            if (kind == 0) lru_item(p, idx, (float*)smem); else attn0_item(p, idx, lds);
        }
    }
    gsync(p);
    { pg8::Gemm g{(const bf16_t*)(p.ws + WS_Y), (const bf16_t*)(p.ws + WS_W2T), NTOK, 1024, 1024}; S.init(NTOK, 1024, (int)gridDim.x, (int)blockIdx.x);
      EpiRes<false> E{p.in[0], p.in[1], nullptr, (bf16_t*)(p.ws + WS_X1B), mod + 2048};
      pg8::gemm_phase<EpiRes<false>, pg8::StaticOrder, false>(lds, g, S, E, nullptr); }
    gsync(p);
    phase_norm16(p, (const bf16_t*)(p.ws + WS_X1B));
    gsync(p);
    { pg8::Gemm g{(const bf16_t*)(p.ws + WS_H), (const bf16_t*)(p.ws + WS_W3T), NTOK, 4096, 1024}; S.init(NTOK, 4096, (int)gridDim.x, (int)blockIdx.x);
      Epi3 E{p.ws, p.out};
      pg8::gemm_phase<Epi3, pg8::StaticOrder, false>(lds, g, S, E, nullptr); }
    gsync(p);
    { const int lane = threadIdx.x & 63;
      const float lam = __expf(wave_sum(p.in[26][lane] * p.in[27][lane])) - __expf(wave_sum(p.in[28][lane] * p.in[29][lane])) + LAM_INIT;
      for (int it = blockIdx.x; it < 768; it += gridDim.x) attn1_item(p, it, lam, lds); }
    gsync(p);
    { pg8::Gemm g{(const bf16_t*)(p.ws + WS_Y), (const bf16_t*)(p.ws + WS_W4T), NTOK, 1024, 1024}; S.init(NTOK, 1024, (int)gridDim.x, (int)blockIdx.x);
      EpiRes<true> E{nullptr, nullptr, (const bf16_t*)(p.ws + WS_X1B), (bf16_t*)(p.ws + WS_X2B), mod + 9 * 3072 + 2048};
      pg8::gemm_phase<EpiRes<true>, pg8::StaticOrder, false>(lds, g, S, E, nullptr); }
    gsync(p);
    phase_final16(p, (const bf16_t*)(p.ws + WS_X2B));
}

extern "C" void kernel_launch(void* const* d_in, const int* in_sizes, int n_in, void* d_out, int out_size, void* d_ws, size_t ws_size, hipStream_t stream) {
    static int grid_blocks = 0;
    if (!grid_blocks) {
        int dev = 0, cus = 0, per_cu = 0;
        (void)hipGetDevice(&dev);
        (void)hipDeviceGetAttribute(&cus, hipDeviceAttributeMultiprocessorCount, dev);
        (void)hipFuncSetAttribute((const void*)mega, hipFuncAttributeMaxDynamicSharedMemorySize, LDS_BYTES);
        (void)hipOccupancyMaxActiveBlocksPerMultiprocessor(&per_cu, (const void*)mega, 512, LDS_BYTES);
        if (per_cu < 1) { fprintf(stderr, "occupancy query says %d\n", per_cu); per_cu = 1; }
        grid_blocks = cus;
        if (ws_size < WS_END) fprintf(stderr, "workspace too small: %zu < %zu\n", ws_size, (size_t)WS_END);
    }
    (void)hipMemsetAsync((unsigned char*)d_ws + WS_BAR, 0, XCD_BAR_WORDS * 4, stream);
    Params p{};
    for (int i = 0; i < 33; ++i) p.in[i] = (const float*)d_in[i];
    p.out = (float*)d_out; p.ws = (unsigned char*)d_ws;
    void* args[] = {&p};
    hipError_t e = hipLaunchCooperativeKernel((void*)mega, dim3(grid_blocks), dim3(512), args, LDS_BYTES, stream);
    if (e != hipSuccess) fprintf(stderr, "cooperative launch failed: %s (grid %d)\n", hipGetErrorString(e), grid_blocks);
}
```

```cpp
#include <hip/hip_runtime.h>
#include <hip/hip_cooperative_groups.h>
#include <cstdio>
#include <cstdint>
namespace cg = cooperative_groups;
__device__ __forceinline__ int tidx() { int t = threadIdx.x; asm volatile("" : "+v"(t)); return t; }
namespace pg8 {
#define PG8_LAS __attribute__((address_space(3)))
typedef unsigned short bf16_t;
typedef short bf16x8 __attribute__((ext_vector_type(8)));
typedef float f32x4 __attribute__((ext_vector_type(4)));
typedef unsigned u32x4 __attribute__((ext_vector_type(4)));
constexpr int BM = 256, BK = 64, HALF = 128, HTB = HALF * BK * 2  , STAGE_BYTES = 8 * HTB, NXCD = 8, WGM = 8;

__host__ __device__ __forceinline__ int lds_byte(int r, int c) { const int st = (r >> 4) * 2 + (c >> 5), rr = r & 15, cc = c & 31, ob = rr * 64 + cc * 2; return st * 1024 + (ob ^ (((ob >> 9) & 1) << 5)); }
__host__ __device__ __forceinline__ void stage_rc(int b, int& R, int& C) { const int st = b / 1024, sb = b % 1024, swz = sb ^ (((sb >> 9) & 1) << 5); R = (st >> 1) * 16 + swz / 64; C = (st & 1) * 32 + (swz % 64) / 2; }
__host__ __device__ __forceinline__ int perm32(int rho) { const int n = rho >> 4, i = rho & 15; return 8 * (i >> 2) + 4 * n + (i & 3); }

struct Unit { int pm, pn; };
struct Gemm { const bf16_t* A; const bf16_t* Bt; int M, N, K; };

struct StaticOrder {
    int nM, nN, nwg, G, c;
    __host__ __device__ void init(int M, int N, int G_, int c_) { nM = M / BM; nN = N / BM; nwg = nM * nN; G = G_; c = c_; }
    __host__ __device__ bool next(int i, Unit& u) const {
        const long L = (long)i * G + c; if (L >= nwg) return false;
        int wgid = (int)L; { const int q = nwg / NXCD, r = nwg % NXCD, xcd = wgid % NXCD, off = wgid / NXCD; wgid = (xcd < r ? xcd * (q + 1) : r * (q + 1) + (xcd - r) * q) + off; }
        const int nig = WGM * nN, gid = wgid / nig, fm = gid * WGM, gsz = (nM - fm) < WGM ? (nM - fm) : WGM;
        u.pm = fm + ((wgid % nig) % gsz); u.pn = (wgid % nig) / gsz; return true;
    }
    __device__ __forceinline__ void a_ready(const Unit&) const {}
    __device__ __forceinline__ void done(const Unit&) const {}
};

__device__ __forceinline__ unsigned cvt_pk_bf16(float lo, float hi) { unsigned r; asm volatile("v_cvt_pk_bf16_f32 %0, %1, %2" : "=v"(r) : "v"(lo), "v"(hi)); return r; }
template <int ACT  > struct EpiBf16 {
    static constexpr bool PERM = true, AFTER_DRAIN = false;
    bf16_t* O; int ldc; const float* bias; int split_cols; size_t split_stride;
    __device__ __forceinline__ void operator()(const f32x4 (&acc)[2][2][4][2], const Unit& u, int wr, int wc, int fr, int fq) const {
        const int row0 = u.pm * BM + wr * 64 + fr; int colt = u.pn * BM; bf16_t* base = O;
        if (split_cols) { const int t = colt / split_cols; base += (size_t)t * split_stride; colt -= t * split_cols; }
        const int col0 = colt + wc * 32 + 8 * fq, bcol0 = u.pn * BM + wc * 32 + 8 * fq;
        f32x4 bv[2][2];
#pragma unroll
        for (int bj = 0; bj < 2; ++bj)
#pragma unroll
            for (int n = 0; n < 2; ++n) bv[bj][n] = bias ? *(const f32x4*)(bias + bcol0 + bj * HALF + 4 * n) : (f32x4){0.f, 0.f, 0.f, 0.f};
#pragma unroll
        for (int ai = 0; ai < 2; ++ai)
#pragma unroll
            for (int m = 0; m < 4; ++m) { bf16_t* rowp = base + (size_t)(row0 + ai * HALF + m * 16) * ldc + col0;
#pragma unroll
                for (int bj = 0; bj < 2; ++bj) { f32x4 v0 = acc[ai][bj][m][0] + bv[bj][0], v1 = acc[ai][bj][m][1] + bv[bj][1];
                    u32x4 w; w.x = cvt_pk_bf16(v0[0], v0[1]); w.y = cvt_pk_bf16(v0[2], v0[3]); w.z = cvt_pk_bf16(v1[0], v1[1]); w.w = cvt_pk_bf16(v1[2], v1[3]);
                    *(u32x4*)(rowp + bj * HALF) = w; } }
    }
};

template <class Epi, class Sched, bool STAMP = false>
__device__ __forceinline__ void gemm_phase(PG8_LAS unsigned char* lds, const Gemm g, const Sched& S, const Epi& E, unsigned long long* stamps) {
    const int tid = tidx(), wid = __builtin_amdgcn_readfirstlane(tid >> 6), lane = tid & 63, wr = wid >> 2, wc = wid & 3, fr = lane & 15, fq = lane >> 4;
    const int K = g.K, nt = K / BK;
    int ts_lo = 0, ts_hi = 0, nts = 0; const unsigned long long rt_entry = STAMP ? (unsigned long long)wall_clock64() : 0ull;
#define PG8_STAMP() do { if (STAMP && wid == 0 && nts < 64) { const unsigned long long _c = (unsigned long long)clock64(); \
        ts_lo = (lane == nts) ? (int)(unsigned)_c : ts_lo; ts_hi = (lane == nts) ? (int)(unsigned)(_c >> 32) : ts_hi; ++nts; } } while (0)
    PG8_STAMP();
    unsigned voffA[2], voffB[2];
#pragma unroll
    for (int i = 0; i < 2; ++i) { int R, C; stage_rc(tid * 16 + i * 8192, R, C); const int Rb = Epi::PERM ? ((R & ~31) + perm32(R & 31)) : R;
        voffA[i] = (unsigned)(R * K + C) * 2u; voffB[i] = (unsigned)(Rb * K + C) * 2u; }
    const size_t kstep = (size_t)(BK * 2);
    const size_t hstep = (size_t)HALF * K * 2;
    const size_t tstep = 2 * hstep;
    const unsigned ldsw = (unsigned)wid * 1024u;
    const int aoff = lds_byte(wr * 64 + fr, fq * 8), boff = lds_byte(wc * 32 + fr, fq * 8);
#define PG8_SA(b, h) (((b) * 2 + (h)) * HTB)
#define PG8_SB(b, h) ((4 + (b) * 2 + (h)) * HTB)
#define PG8_STAGE(bufoff, gbase, voff) do { _Pragma("unroll") for (int _i = 0; _i < 2; ++_i) \
        __builtin_amdgcn_global_load_lds((const unsigned*)((const char*)(gbase) + (voff)[_i]), (PG8_LAS unsigned*)(lds + (bufoff) + ldsw + _i * 8192), 16, 0, 0); } while (0)
#define PG8_LDA(dst, b, h) do { _Pragma("unroll") for (int m = 0; m < 4; ++m) _Pragma("unroll") for (int k = 0; k < 2; ++k) dst[m][k] = *(const PG8_LAS bf16x8*)(lds + PG8_SA(b, h) + aoff + m * 2048 + k * 1024); } while (0)
#define PG8_LDB(dst, b, h) do { _Pragma("unroll") for (int n = 0; n < 2; ++n) _Pragma("unroll") for (int k = 0; k < 2; ++k) dst[n][k] = *(const PG8_LAS bf16x8*)(lds + PG8_SB(b, h) + boff + n * 2048 + k * 1024); } while (0)
#define PG8_MMA(ai, bj, At, Bt) do { __builtin_amdgcn_s_setprio(1); _Pragma("unroll") for (int m = 0; m < 4; ++m) _Pragma("unroll") for (int n = 0; n < 2; ++n) _Pragma("unroll") for (int k = 0; k < 2; ++k) \
        acc[ai][bj][m][n] = __builtin_amdgcn_mfma_f32_16x16x32_bf16(Bt[n][k], At[m][k], acc[ai][bj][m][n], 0, 0, 0); __builtin_amdgcn_s_setprio(0); } while (0)
#define PG8_WAIT_V(n) asm volatile("s_waitcnt vmcnt(" #n ")" ::: "memory")
#define PG8_WAIT_L(n) asm volatile("s_waitcnt lgkmcnt(" #n ")" ::: "memory")
#define PG8_BAR __builtin_amdgcn_s_barrier()
#define PG8_SCHED __builtin_amdgcn_sched_barrier(0)
    Unit cur, nxt; int ui = 0;
    if (!S.next(0, cur)) return;
    f32x4 acc[2][2][4][2];
#pragma unroll
    for (int a = 0; a < 2; ++a)
#pragma unroll
        for (int b = 0; b < 2; ++b)
#pragma unroll
            for (int m = 0; m < 4; ++m)
#pragma unroll
                for (int n = 0; n < 2; ++n) acc[a][b][m][n] = (f32x4){0.f, 0.f, 0.f, 0.f};
    bf16x8 At[4][2], B0[2][2], B1[2][2];
    const char* cA = (const char*)g.A + (size_t)cur.pm * tstep; const char* cB = (const char*)g.Bt + (size_t)cur.pn * tstep;
    S.a_ready(cur);
    PG8_STAGE(PG8_SB(0, 0), cB, voffB); PG8_STAGE(PG8_SA(0, 0), cA, voffA); PG8_STAGE(PG8_SB(0, 1), cB + hstep, voffB); PG8_STAGE(PG8_SA(0, 1), cA + hstep, voffA);
    if (wr == 1) PG8_BAR;
    PG8_WAIT_V(4); PG8_BAR;
    PG8_STAGE(PG8_SB(1, 0), cB + kstep, voffB); PG8_STAGE(PG8_SA(1, 0), cA + kstep, voffA); PG8_STAGE(PG8_SB(1, 1), cB + hstep + kstep, voffB);
    PG8_WAIT_V(6); PG8_BAR;
    PG8_STAMP();
    for (;;) {
        const bool has_next = S.next(ui + 1, nxt);
        const char* nA = has_next ? (const char*)g.A + (size_t)nxt.pm * tstep : cA; const char* nB = has_next ? (const char*)g.Bt + (size_t)nxt.pn * tstep : cB;
        for (int t = 0; t < nt; t += 2) {
            const bool last = (t == nt - 2);
            const char* a1 = cA + (size_t)(t + 1) * kstep;
            const char* a2 = last ? nA : cA + (size_t)(t + 2) * kstep; const char* b2 = last ? nB : cB + (size_t)(t + 2) * kstep;
            const char* a3 = a2 + kstep; const char* b3 = b2 + kstep;
            if (last && has_next) S.a_ready(nxt);
            PG8_LDB(B0, 0, 0); PG8_SCHED; PG8_LDA(At, 0, 0); PG8_STAGE(PG8_SA(1, 1), a1 + hstep, voffA);
            PG8_WAIT_L(8); PG8_BAR; PG8_WAIT_L(0); PG8_MMA(0, 0, At, B0); PG8_BAR; PG8_SCHED;
            PG8_LDB(B1, 0, 1); PG8_STAGE(PG8_SB(0, 0), b2, voffB);
            PG8_BAR; PG8_WAIT_L(0); PG8_MMA(0, 1, At, B1); PG8_BAR;
            PG8_LDA(At, 0, 1); PG8_STAGE(PG8_SA(0, 0), a2, voffA);
            PG8_BAR; PG8_WAIT_L(0); PG8_MMA(1, 0, At, B0); PG8_BAR; PG8_SCHED;
            PG8_STAGE(PG8_SB(0, 1), b2 + hstep, voffB);
            PG8_WAIT_V(6); PG8_BAR; PG8_MMA(1, 1, At, B1); PG8_BAR;
            PG8_LDB(B0, 1, 0); PG8_SCHED; PG8_LDA(At, 1, 0); PG8_STAGE(PG8_SA(0, 1), a2 + hstep, voffA);
            PG8_WAIT_L(8); PG8_BAR; PG8_WAIT_L(0); PG8_MMA(0, 0, At, B0); PG8_BAR; PG8_SCHED;
            PG8_LDB(B1, 1, 1); PG8_STAGE(PG8_SB(1, 0), b3, voffB);
            PG8_BAR; PG8_WAIT_L(0); PG8_MMA(0, 1, At, B1); PG8_BAR;
            PG8_LDA(At, 1, 1); PG8_STAGE(PG8_SA(1, 0), a3, voffA);
            PG8_BAR; PG8_WAIT_L(0); PG8_MMA(1, 0, At, B0); PG8_BAR; PG8_SCHED;
            PG8_STAGE(PG8_SB(1, 1), b3 + hstep, voffB);
            PG8_WAIT_V(6); PG8_BAR; PG8_MMA(1, 1, At, B1); PG8_BAR;
        }
        PG8_STAMP();
        if constexpr (!Epi::AFTER_DRAIN) { E(acc, cur, wr, wc, fr, fq); S.done(cur); }
        PG8_STAMP();
        if (!has_next) break;
#pragma unroll
        for (int a = 0; a < 2; ++a)
#pragma unroll
            for (int b = 0; b < 2; ++b)
#pragma unroll
                for (int m = 0; m < 4; ++m)
#pragma unroll
                    for (int n = 0; n < 2; ++n) acc[a][b][m][n] = (f32x4){0.f, 0.f, 0.f, 0.f};
        cur = nxt; cA = nA; cB = nB; ++ui;
    }
    PG8_WAIT_V(0);
    if (wr == 0) PG8_BAR;
    PG8_BAR;
    if constexpr (Epi::AFTER_DRAIN) { E.fused(acc, cur, wr, wc, fr, fq, lds, wid, lane); S.done(cur); }
    PG8_STAMP();
    if (STAMP && wid == 0) { stamps[lane] = lane < nts ? (((unsigned long long)(unsigned)ts_hi << 32) | (unsigned)ts_lo) : 0ull;
        if (lane == 62) stamps[62] = rt_entry; if (lane == 63) stamps[63] = (unsigned long long)wall_clock64(); }
#undef PG8_STAMP
#undef PG8_SA
#undef PG8_SB
#undef PG8_STAGE
#undef PG8_LDA
#undef PG8_LDB
#undef PG8_MMA
#undef PG8_WAIT_V
#undef PG8_WAIT_L
#undef PG8_BAR
#undef PG8_SCHED
}
}
using pg8::bf16_t; using pg8::bf16x8; using pg8::f32x4; using pg8::u32x4;
#define LAS __attribute__((address_space(3)))
typedef unsigned u32x2 __attribute__((ext_vector_type(2)));

constexpr int NTOK = 12288, NCTX = 4096;
constexpr int LDS_BYTES = 131072 + 64;
constexpr float LAM_INIT = 0.35550906759f;
constexpr size_t O_YP = 0, O_YS = 4194304, O_NAK = 12582912, O_NAV = 14680064, O_LRU = 16777216, O_DK = 16793600, O_DV = 20987904;

struct Params { const float* in[33]; float* out; unsigned char* ws; };

__device__ __forceinline__ float bf2f(bf16_t v) { return __uint_as_float(((unsigned)v) << 16); }
__device__ __forceinline__ bf16_t f2bf(float f) { unsigned u = __float_as_uint(f); u += 0x7FFFu + ((u >> 16) & 1u); return (bf16_t)(u >> 16); }
__device__ __forceinline__ unsigned pk2(float lo, float hi) { return (unsigned)f2bf(lo) | ((unsigned)f2bf(hi) << 16); }
__device__ __forceinline__ float silu_f(float x) { return x / (1.0f + __expf(-x)); }
__device__ __forceinline__ float sigmoid_f(float x) { return 1.0f / (1.0f + __expf(-x)); }
__device__ __forceinline__ float wave_sum(float v) {
#pragma unroll
    for (int o = 32; o >= 1; o >>= 1) v += __shfl_xor(v, o);
    return v;
}
#define XB_TMO      128
#define XB_XCNT(j)  (256  + 64 * (j))
#define XB_XSUB(j)  (1280 + 64 * (j))
#define XB_XGEN(j)  (2304 + 64 * (j))
#define XB_TOP      3328
#define XB_TOPGEN   3392
#define XCD_BAR_WORDS 3456
#define XB_SPIN_CAP (1u << 18)
#define LAS __attribute__((address_space(3)))
__device__ __forceinline__ unsigned xb_ld(unsigned* p)              { return __hip_atomic_load(p, __ATOMIC_RELAXED, __HIP_MEMORY_SCOPE_AGENT); }
__device__ __forceinline__ unsigned xb_add(unsigned* p, unsigned v) { return __hip_atomic_fetch_add(p, v, __ATOMIC_RELAXED, __HIP_MEMORY_SCOPE_AGENT); }
__device__ __forceinline__ unsigned xb_xcc_id() { return (unsigned)__builtin_amdgcn_s_getreg((3 << 11) | 20) & 0xFu; }
#define XB_SPIN(cond, bar) do { unsigned _sp = 0; while (cond) { __builtin_amdgcn_s_sleep(1); \
    if ((++_sp & 255u) == 0u) { if (xb_ld(&(bar)[XB_TMO])) break; if (_sp > XB_SPIN_CAP) { atomicAdd(&(bar)[XB_TMO], 1u); break; } } } } while (0)

struct XcdBarrier {
    unsigned* bar; unsigned x;
    volatile LAS unsigned* st;
};

__device__ __forceinline__ XcdBarrier xcd_barrier_post(unsigned* bar, volatile LAS unsigned* st) {
    XcdBarrier b; b.bar = bar; b.x = xb_xcc_id(); b.st = st;
    if (threadIdx.x == 0) (void)xb_add(&bar[XB_XCNT(b.x)], 1u);
    return b;
}
__device__ __forceinline__ void xcd_barrier_complete(unsigned* bar, unsigned x, unsigned& nloc, unsigned& nx) {
    const unsigned G = gridDim.x * gridDim.y * gridDim.z;
    unsigned sum, cnt, mine, sp = 0u;
    for (;;) {
        sum = 0u; cnt = 0u; mine = 0u;
#pragma unroll
        for (unsigned j = 0; j < 16; ++j) { const unsigned c = xb_ld(&bar[XB_XCNT(j)]); sum += c; cnt += (c > 0u) ? 1u : 0u; mine = (j == x) ? c : mine; }
        if (sum == G) break;
        __builtin_amdgcn_s_sleep(1);
        if ((++sp & 255u) == 0u) { if (xb_ld(&bar[XB_TMO])) break; if (sp > XB_SPIN_CAP) { atomicAdd(&bar[XB_TMO], 1u); break; } }
    }
    nloc = mine > 0u ? mine : 1u; nx = cnt > 0u ? cnt : 1u;
}

__device__ __forceinline__ void xcd_barrier(const XcdBarrier& b) {
    asm volatile("s_waitcnt vmcnt(0)" ::: "memory");
    __syncthreads();
    if (threadIdx.x == 0) {
        unsigned* bar = b.bar;
        __builtin_amdgcn_s_waitcnt(0);
        unsigned nloc = b.st[0], nx = b.st[1];
        if (nloc == 0u) { xcd_barrier_complete(bar, b.x, nloc, nx); b.st[0] = nloc; b.st[1] = nx; }
        const unsigned old = xb_add(&bar[XB_XSUB(b.x)], 1u);
        const unsigned gen = old / nloc;
        if (old + 1u == (gen + 1u) * nloc) {
            __builtin_amdgcn_fence(__ATOMIC_RELEASE, "agent");
            asm volatile("s_waitcnt vmcnt(0)" ::: "memory");
            const unsigned og = xb_add(&bar[XB_TOP], 1u);
            const unsigned tg = og / nx;
            if (og + 1u == (tg + 1u) * nx) xb_add(&bar[XB_TOPGEN], 1u);
            else XB_SPIN(xb_ld(&bar[XB_TOPGEN]) == tg, bar);
            __builtin_amdgcn_fence(__ATOMIC_ACQUIRE, "agent");
            xb_add(&bar[XB_XGEN(b.x)], 1u);
            asm volatile("s_waitcnt vmcnt(0)" ::: "memory");
        } else {
            XB_SPIN(xb_ld(&bar[XB_XGEN(b.x)]) == gen, bar);
            __builtin_amdgcn_fence(__ATOMIC_ACQUIRE, "agent");
            asm volatile("s_waitcnt vmcnt(0)" ::: "memory");
        }
    }
    __syncthreads();
}
constexpr size_t WS_MOD = 0;
constexpr size_t WS_ROPE = 229376;
constexpr size_t WS_WG = 262144;
constexpr size_t WS_W1T = WS_WG + 262144;
constexpr size_t WS_W2T = WS_W1T + 6291456;
constexpr size_t WS_W3T = WS_W2T + 2097152;
constexpr size_t WS_W4T = WS_W3T + 8388608;
constexpr size_t WS_H = WS_W4T + 2097152;
constexpr size_t WS_HF = WS_H;
constexpr size_t WS_P = WS_H + 25165824;
constexpr size_t WS_Y = WS_P + 50331648;
constexpr size_t WS_K0L = WS_Y + 25165824;
constexpr size_t WS_V0L = WS_K0L + 10485760;
constexpr size_t WS_K0C = WS_V0L + 10485760;
constexpr size_t WS_V0C = WS_K0C + 4194304;
constexpr size_t WS_K1L = WS_V0C + 4194304;
constexpr size_t WS_V1L = WS_K1L + 20971520;
constexpr size_t WS_K1C = WS_V1L + 20971520;
constexpr size_t WS_V1C = WS_K1C + 8388608;
constexpr size_t WS_X1B = WS_K0L;
constexpr size_t WS_X2B = WS_P;
constexpr size_t WS_BAR = WS_V1C + 8388608;
constexpr size_t WS_END = WS_BAR + 16384;

__device__ __forceinline__ void transpose_tile(const float* __restrict__ src, int lds_, bf16_t* __restrict__ dst, int ldd, int r0, int c0, float* sm) {
    const int tid = tidx();
    __syncthreads();
#pragma unroll
    for (int i = 0; i < 2; ++i) {
        const int r = (tid >> 4) + i * 32, c4 = (tid & 15) * 4;
        const float4 v = *(const float4*)(src + (size_t)(r0 + r) * lds_ + c0 + c4);
        sm[r * 65 + c4 + 0] = v.x; sm[r * 65 + c4 + 1] = v.y; sm[r * 65 + c4 + 2] = v.z; sm[r * 65 + c4 + 3] = v.w;
    }
    __syncthreads();
    const int c = tid >> 3, r8 = (tid & 7) * 8;
    u32x4 w;
    w.x = pk2(sm[(r8 + 0) * 65 + c], sm[(r8 + 1) * 65 + c]); w.y = pk2(sm[(r8 + 2) * 65 + c], sm[(r8 + 3) * 65 + c]);
    w.z = pk2(sm[(r8 + 4) * 65 + c], sm[(r8 + 5) * 65 + c]); w.w = pk2(sm[(r8 + 6) * 65 + c], sm[(r8 + 7) * 65 + c]);
    *(u32x4*)(dst + (size_t)(c0 + c) * ldd + r0 + r8) = w;
}

__device__ __forceinline__ void transpose_4tile(const float* __restrict__ src, int lds_, bf16_t* __restrict__ dst, int ldd, int r0, int c0, float* sm) {
    const int tid = tidx();
    float4 v[8];
#pragma unroll
    for (int i = 0; i < 8; ++i) { const int idx = tid + 512 * i, r = idx >> 6, c4 = (idx & 63) * 4; { const f32x4 t4 = __builtin_nontemporal_load((const f32x4*)(src + (size_t)(r0 + r) * lds_ + c0 + c4)); v[i] = make_float4(t4[0], t4[1], t4[2], t4[3]); }     }
    __syncthreads();
#pragma unroll
    for (int i = 0; i < 8; ++i) { const int idx = tid + 512 * i, r = idx >> 6, c4 = (idx & 63) * 4;
        sm[r * 257 + c4 + 0] = v[i].x; sm[r * 257 + c4 + 1] = v[i].y; sm[r * 257 + c4 + 2] = v[i].z; sm[r * 257 + c4 + 3] = v[i].w; }
    __syncthreads();
    const int c = tid >> 1, rh = (tid & 1) * 32;
#pragma unroll
    for (int q = 0; q < 4; ++q) { const int rb = rh + q * 8; u32x4 w;
        w.x = pk2(sm[(rb + 0) * 257 + c], sm[(rb + 1) * 257 + c]); w.y = pk2(sm[(rb + 2) * 257 + c], sm[(rb + 3) * 257 + c]);
        w.z = pk2(sm[(rb + 4) * 257 + c], sm[(rb + 5) * 257 + c]); w.w = pk2(sm[(rb + 6) * 257 + c], sm[(rb + 7) * 257 + c]);
        *(u32x4*)(dst + (size_t)(c0 + c) * ldd + r0 + rb) = w; }
}

constexpr int A1_TOTAL = 192 + 32 + 1;
__device__ __forceinline__ void phaseA(const Params& p, float* sm) {
    const int tid = tidx();
    float* mod = (float*)(p.ws + WS_MOD);
    for (int it = blockIdx.x; it < 192; it += gridDim.x) {
        {
            const int layer = it / 96, col0 = (it % 96) * 32;
            const float* W = p.in[layer ? 23 : 10]; const float* Bv = p.in[layer ? 24 : 11];
            const int col = tid & 31, kp = tid >> 5;
            float wv[32];
#pragma unroll
            for (int u = 0; u < 32; ++u) wv[u] = __builtin_nontemporal_load((const float*)((const char*)W + (unsigned)(((kp * 64 + u) * 3072 + col0 + col) * 4)));
            __syncthreads();
            for (int e = tid; e < 9 * 1024; e += 512) { const float cvv = e < 1024 ? p.in[8][e] : p.in[2][e - 1024]; sm[e] = silu_f(cvv); }
            __syncthreads();
            float acc[9];
#pragma unroll
            for (int v = 0; v < 9; ++v) acc[v] = 0.f;
#pragma unroll
            for (int hb = 0; hb < 2; ++hb) {
                float wn[32];
                if (hb == 0) {
#pragma unroll
                    for (int u = 0; u < 32; ++u) wn[u] = __builtin_nontemporal_load((const float*)((const char*)W + (unsigned)(((kp * 64 + 32 + u) * 3072 + col0 + col) * 4)));
                }
#pragma unroll
                for (int u = 0; u < 32; ++u)
#pragma unroll
                    for (int v = 0; v < 9; ++v) acc[v] += sm[v * 1024 + kp * 64 + hb * 32 + u] * wv[u];
                if (hb == 0) {
#pragma unroll
                    for (int u = 0; u < 32; ++u) wv[u] = wn[u];
                }
            }
            __syncthreads();
#pragma unroll
            for (int v = 0; v < 9; ++v) sm[9216 + (kp * 9 + v) * 32 + col] = acc[v];
            __syncthreads();
            if (tid < 288) { const int v = tid >> 5, c = tid & 31; float s = Bv[col0 + c];
                for (int k2 = 0; k2 < 16; ++k2) s += sm[9216 + (k2 * 9 + v) * 32 + c];
                mod[(layer * 9 + v) * 3072 + col0 + c] = s; }
        }
    }
}
__device__ __forceinline__ void phaseA1b(const Params& p, float* sm) {
    const int tid = tidx();
    for (int it = blockIdx.x; it < A1_TOTAL; it += gridDim.x) {
        int t = it;
        if (t < 192) { transpose_4tile(p.in[12], 3072, (bf16_t*)(p.ws + WS_W1T), 1024, (t / 12) * 64, (t % 12) * 256, sm); continue; }
        t -= 192;
        if (t < 32) {
            const int gate = t >> 4, dn = t & 15;
            transpose_tile(p.in[gate ? 18 : 16] + (size_t)dn * 4096, 64, (bf16_t*)(p.ws + WS_WG) + (size_t)(((dn >> 3) * 2 + gate) * 8 + (dn & 7)) * 4096, 64, 0, 0, sm);
            continue;
        }
        {
            float* rc = (float*)(p.ws + WS_ROPE);
            for (int e = tid; e < 1024; e += 512) { const int pos = e >> 4, i = e & 15; const float inv = powf(10000.0f, -(float)i / 16.0f); const float ang = (float)pos * inv;
                rc[e] = cosf(ang); rc[1024 + e] = sinf(ang); }
        }
    }
}

constexpr int A2_TOTAL = 64 + 64 + 128 + 128 + 64 + 256 + 64;
__device__ __forceinline__ void phaseA2(const Params& p, float* sm, int first, int stride) {
    const int tid = tidx();
    for (int it = first; it < A2_TOTAL; it += stride) {
        int t = it;
        if (t < 384) {
            int which; if (t < 64) which = 0; else if (t < 128) { which = 1; t -= 64; } else if (t < 256) { which = 2; t -= 128; } else { which = 3; t -= 256; }
            const float* src = p.in[which == 0 ? 3 : which == 1 ? 4 : which == 2 ? 6 : 7];
            bf16_t* dst = (bf16_t*)(p.ws + (which == 0 ? WS_K0L : which == 1 ? WS_V0L : which == 2 ? WS_K1L : WS_V1L));
            const int W = which < 2 ? 512 : 1024;
            float4 v[8];
#pragma unroll
            for (int i = 0; i < 8; ++i) { const f32x4 t4 = __builtin_nontemporal_load((const f32x4*)(src + (size_t)t * 16384 + i * 2048 + tid * 4)); v[i] = make_float4(t4[0], t4[1], t4[2], t4[3]); }
            __builtin_amdgcn_sched_barrier(0);
#pragma unroll
            for (int i = 0; i < 8; ++i) { const size_t e = (size_t)t * 16384 + i * 2048 + tid * 4;
                const size_t row = e / W; const int c = (int)(e % W); const size_t b = row >> 8, j = row & 255;
                u32x2 w; w.x = pk2(v[i].x, v[i].y); w.y = pk2(v[i].z, v[i].w);
                *(u32x2*)(dst + (b * 1280 + j) * W + c) = w; }
            continue; }
        t -= 384;
        if (t < 64) { transpose_4tile(p.in[21], 1024, (bf16_t*)(p.ws + WS_W2T), 1024, (t / 4) * 64, (t % 4) * 256, sm); continue; }
        t -= 64;
        if (t < 256) { transpose_4tile(p.in[25], 4096, (bf16_t*)(p.ws + WS_W3T), 1024, (t / 16) * 64, (t % 16) * 256, sm); continue; }
        t -= 256;
        transpose_4tile(p.in[31], 1024, (bf16_t*)(p.ws + WS_W4T), 1024, (t / 4) * 64, (t % 4) * 256, sm);
    }
}

__device__ __forceinline__ void phase_norm(const Params& p, int layer, const float* xa, const float* xb_) {
    const int lane = tidx() & 63, wave = tidx() >> 6;
    const float* g = p.in[layer ? 22 : 9];
    const float* mod = (const float*)(p.ws + WS_MOD) + layer * 9 * 3072;
    bf16_t* H = (bf16_t*)(p.ws + WS_H);
    float4 gg[4];
#pragma unroll
    for (int i = 0; i < 4; ++i) gg[i] = *(const float4*)(g + i * 256 + lane * 4);
    const int stride = gridDim.x * 8;
    for (int row0 = blockIdx.x * 8 + wave; row0 < NTOK; row0 += 3 * stride) {
        float4 v[3][4], sh[3][4], sc[3][4];
#pragma unroll
        for (int k = 0; k < 3; ++k) { const int row = min(row0 + k * stride, NTOK - 1);
            const float* xr = row < NCTX ? xa + (size_t)row * 1024 : xb_ + (size_t)(row - NCTX) * 1024;
            const float* mv = mod + (row < NCTX ? 0 : 1 + ((row - NCTX) >> 10)) * 3072;
#pragma unroll
            for (int i = 0; i < 4; ++i) { { const f32x4 t4 = __builtin_nontemporal_load((const f32x4*)(xr + i * 256 + lane * 4)); v[k][i] = make_float4(t4[0], t4[1], t4[2], t4[3]); } sh[k][i] = *(const float4*)(mv + i * 256 + lane * 4); sc[k][i] = *(const float4*)(mv + 1024 + i * 256 + lane * 4); } }
#pragma unroll
        for (int k = 0; k < 3; ++k) { const int row = row0 + k * stride;
            if (row < NTOK) {
                float ss = 0.f;
#pragma unroll
                for (int i = 0; i < 4; ++i) ss += v[k][i].x * v[k][i].x + v[k][i].y * v[k][i].y + v[k][i].z * v[k][i].z + v[k][i].w * v[k][i].w;
                ss = wave_sum(ss);
                const float rstd = rsqrtf(ss * (1.0f / 1024.0f) + 1e-6f);
#pragma unroll
                for (int i = 0; i < 4; ++i) { u32x2 w;
                    w.x = pk2(v[k][i].x * rstd * gg[i].x * (1.f + sc[k][i].x) + sh[k][i].x, v[k][i].y * rstd * gg[i].y * (1.f + sc[k][i].y) + sh[k][i].y);
                    w.y = pk2(v[k][i].z * rstd * gg[i].z * (1.f + sc[k][i].z) + sh[k][i].z, v[k][i].w * rstd * gg[i].w * (1.f + sc[k][i].w) + sh[k][i].w);
                    *(u32x2*)(H + (size_t)row * 1024 + i * 256 + lane * 4) = w; }
            } }
    }
}

__device__ __forceinline__ void phase_final(const Params& p) {
    const int lane = tidx() & 63, wave = tidx() >> 6;
    const float* g = p.in[32];
    float4 gg[4];
#pragma unroll
    for (int i = 0; i < 4; ++i) gg[i] = *(const float4*)(g + i * 256 + lane * 4);
    const int stride = gridDim.x * 8;
    for (int row0 = blockIdx.x * 8 + wave; row0 < NTOK; row0 += 3 * stride) {
        float4 v[3][4];
#pragma unroll
        for (int k = 0; k < 3; ++k) { const int row = min(row0 + k * stride, NTOK - 1);
#pragma unroll
            for (int i = 0; i < 4; ++i) v[k][i] = *(const float4*)(p.out + (size_t)row * 1024 + i * 256 + lane * 4); }
#pragma unroll
        for (int k = 0; k < 3; ++k) { const int row = row0 + k * stride;
            if (row < NTOK) {
                float ss = 0.f;
#pragma unroll
                for (int i = 0; i < 4; ++i) ss += v[k][i].x * v[k][i].x + v[k][i].y * v[k][i].y + v[k][i].z * v[k][i].z + v[k][i].w * v[k][i].w;
                ss = wave_sum(ss);
                const float rstd = rsqrtf(ss * (1.0f / 1024.0f) + 1e-6f);
#pragma unroll
                for (int i = 0; i < 4; ++i) { float4 o; o.x = v[k][i].x * rstd * gg[i].x; o.y = v[k][i].y * rstd * gg[i].y; o.z = v[k][i].z * rstd * gg[i].z; o.w = v[k][i].w * rstd * gg[i].w;
                    *(float4*)(p.out + (size_t)row * 1024 + i * 256 + lane * 4) = o; }
            } }
    }
}

__device__ __forceinline__ void ld_row16(const bf16_t* r, int lane, float (&x)[16]) {
#pragma unroll
    for (int i = 0; i < 2; ++i) { const u32x4 w = *(const u32x4*)(r + i * 512 + lane * 8);
        x[i * 8 + 0] = __uint_as_float(w.x << 16); x[i * 8 + 1] = __uint_as_float(w.x & 0xffff0000u); x[i * 8 + 2] = __uint_as_float(w.y << 16); x[i * 8 + 3] = __uint_as_float(w.y & 0xffff0000u);
        x[i * 8 + 4] = __uint_as_float(w.z << 16); x[i * 8 + 5] = __uint_as_float(w.z & 0xffff0000u); x[i * 8 + 6] = __uint_as_float(w.w << 16); x[i * 8 + 7] = __uint_as_float(w.w & 0xffff0000u); }
}
__device__ __forceinline__ void ld_vec16(const float* v, int lane, float (&x)[16]) {
#pragma unroll
    for (int i = 0; i < 2; ++i) { const float4 a = *(const float4*)(v + i * 512 + lane * 8), c = *(const float4*)(v + i * 512 + lane * 8 + 4);
        x[i * 8 + 0] = a.x; x[i * 8 + 1] = a.y; x[i * 8 + 2] = a.z; x[i * 8 + 3] = a.w; x[i * 8 + 4] = c.x; x[i * 8 + 5] = c.y; x[i * 8 + 6] = c.z; x[i * 8 + 7] = c.w; }
}
__device__ __forceinline__ void phase_norm16(const Params& p, const bf16_t* X) {
    const int lane = tidx() & 63, wave = tidx() >> 6;
    const float* mod = (const float*)(p.ws + WS_MOD) + 9 * 3072;
    bf16_t* H = (bf16_t*)(p.ws + WS_H);
    float gg[16]; ld_vec16(p.in[22], lane, gg);
    const int stride = gridDim.x * 8;
    for (int row0 = blockIdx.x * 8 + wave; row0 < NTOK; row0 += 3 * stride) {
        u32x4 raw[3][2];
#pragma unroll
        for (int k = 0; k < 3; ++k) { const int row = min(row0 + k * stride, NTOK - 1);
#pragma unroll
            for (int i = 0; i < 2; ++i) raw[k][i] = *(const u32x4*)(X + (size_t)row * 1024 + i * 512 + lane * 8); }
#pragma unroll
        for (int k = 0; k < 3; ++k) { const int row = row0 + k * stride;
            if (row < NTOK) {
                const float* mv = mod + (row < NCTX ? 0 : 1 + ((row - NCTX) >> 10)) * 3072;
                float sh[16], sc[16]; ld_vec16(mv, lane, sh); ld_vec16(mv + 1024, lane, sc);
                float x[16];
#pragma unroll
                for (int i = 0; i < 2; ++i) { const u32x4 w = raw[k][i];
                    x[i * 8 + 0] = __uint_as_float(w.x << 16); x[i * 8 + 1] = __uint_as_float(w.x & 0xffff0000u); x[i * 8 + 2] = __uint_as_float(w.y << 16); x[i * 8 + 3] = __uint_as_float(w.y & 0xffff0000u);
                    x[i * 8 + 4] = __uint_as_float(w.z << 16); x[i * 8 + 5] = __uint_as_float(w.z & 0xffff0000u); x[i * 8 + 6] = __uint_as_float(w.w << 16); x[i * 8 + 7] = __uint_as_float(w.w & 0xffff0000u); }
                float ss = 0.f;
#pragma unroll
                for (int e = 0; e < 16; ++e) ss += x[e] * x[e];
                ss = wave_sum(ss);
                const float rstd = rsqrtf(ss * (1.0f / 1024.0f) + 1e-6f);
#pragma unroll
                for (int i = 0; i < 2; ++i) { u32x4 w; float y[8];
#pragma unroll
                    for (int e = 0; e < 8; ++e) y[e] = x[i * 8 + e] * rstd * gg[i * 8 + e] * (1.f + sc[i * 8 + e]) + sh[i * 8 + e];
                    w.x = pk2(y[0], y[1]); w.y = pk2(y[2], y[3]); w.z = pk2(y[4], y[5]); w.w = pk2(y[6], y[7]);
                    *(u32x4*)(H + (size_t)row * 1024 + i * 512 + lane * 8) = w; }
            } }
    }
}
__device__ __forceinline__ void phase_final16(const Params& p, const bf16_t* X) {
    const int lane = tidx() & 63, wave = tidx() >> 6;
    float gg[16]; ld_vec16(p.in[32], lane, gg);
    const int stride = gridDim.x * 8;
    for (int row0 = blockIdx.x * 8 + wave; row0 < NTOK; row0 += 3 * stride) {
        u32x4 raw[3][2];
#pragma unroll
        for (int k = 0; k < 3; ++k) { const int row = min(row0 + k * stride, NTOK - 1);
#pragma unroll
            for (int i = 0; i < 2; ++i) raw[k][i] = *(const u32x4*)(X + (size_t)row * 1024 + i * 512 + lane * 8); }
#pragma unroll
        for (int k = 0; k < 3; ++k) { const int row = row0 + k * stride;
            if (row < NTOK) {
                float x[16];
#pragma unroll
                for (int i = 0; i < 2; ++i) { const u32x4 w = raw[k][i];
                    x[i * 8 + 0] = __uint_as_float(w.x << 16); x[i * 8 + 1] = __uint_as_float(w.x & 0xffff0000u); x[i * 8 + 2] = __uint_as_float(w.y << 16); x[i * 8 + 3] = __uint_as_float(w.y & 0xffff0000u);
                    x[i * 8 + 4] = __uint_as_float(w.z << 16); x[i * 8 + 5] = __uint_as_float(w.z & 0xffff0000u); x[i * 8 + 6] = __uint_as_float(w.w << 16); x[i * 8 + 7] = __uint_as_float(w.w & 0xffff0000u); }
                float ss = 0.f;
#pragma unroll
                for (int e = 0; e < 16; ++e) ss += x[e] * x[e];
                ss = wave_sum(ss);
                const float rstd = rsqrtf(ss * (1.0f / 1024.0f) + 1e-6f);
                float* yr = p.out + (size_t)row * 1024;
#pragma unroll
                for (int i = 0; i < 2; ++i) {
                    float4 o0, o1;
                    o0.x = x[i * 8 + 0] * rstd * gg[i * 8 + 0]; o0.y = x[i * 8 + 1] * rstd * gg[i * 8 + 1]; o0.z = x[i * 8 + 2] * rstd * gg[i * 8 + 2]; o0.w = x[i * 8 + 3] * rstd * gg[i * 8 + 3];
                    o1.x = x[i * 8 + 4] * rstd * gg[i * 8 + 4]; o1.y = x[i * 8 + 5] * rstd * gg[i * 8 + 5]; o1.z = x[i * 8 + 6] * rstd * gg[i * 8 + 6]; o1.w = x[i * 8 + 7] * rstd * gg[i * 8 + 7];
                    *(float4*)(yr + i * 512 + lane * 8) = o0; *(float4*)(yr + i * 512 + lane * 8 + 4) = o1; }
            } }
    }
}

constexpr float QSCALE = 0.125f * 1.4426950408889634f;
__device__ __forceinline__ u32x2 pk4(const f32x4& v) { u32x2 w; w.x = pg8::cvt_pk_bf16(v[0], v[1]); w.y = pg8::cvt_pk_bf16(v[2], v[3]); return w; }
__device__ __forceinline__ u32x4 pk8(const f32x4& a, const f32x4& b) { u32x4 w; w.x = pg8::cvt_pk_bf16(a[0], a[1]); w.y = pg8::cvt_pk_bf16(a[2], a[3]); w.z = pg8::cvt_pk_bf16(b[0], b[1]); w.w = pg8::cvt_pk_bf16(b[2], b[3]); return w; }

template <bool IN16>
struct EpiRes {
    static constexpr bool PERM = true, AFTER_DRAIN = false;
    const float* xa; const float* xb; const bf16_t* x16; bf16_t* xo; const float* gate;
    __device__ __forceinline__ void operator()(const f32x4 (&acc)[2][2][4][2], const pg8::Unit& u, int wr, int wc, int fr, int fq) const {
        const int row0 = u.pm * 256 + wr * 64 + fr, col0 = u.pn * 256 + wc * 32 + 8 * fq;
        const bool ctx = u.pm < 16;
        const int mi = ctx ? 0 : 1 + ((u.pm - 16) >> 2);
        const float* xbase = (ctx ? xa + (size_t)row0 * 1024 : xb + (size_t)(row0 - NCTX) * 1024) + col0;
        const bf16_t* x16b = x16 + (size_t)row0 * 1024 + col0;
        bf16_t* obase = xo + (size_t)row0 * 1024 + col0;
        f32x4 gv[2][2];
#pragma unroll
        for (int bj = 0; bj < 2; ++bj)
#pragma unroll
            for (int n = 0; n < 2; ++n) gv[bj][n] = *(const f32x4*)(gate + mi * 3072 + col0 + bj * 128 + 4 * n);
#pragma unroll
        for (int ai = 0; ai < 2; ++ai) {
            f32x4 xv[4][2][2];
#pragma unroll
            for (int m = 0; m < 4; ++m)
#pragma unroll
                for (int bj = 0; bj < 2; ++bj) {
                    const size_t off = (size_t)(ai * 128 + m * 16) * 1024 + bj * 128;
                    if (IN16) { const u32x4 w = *(const u32x4*)(x16b + off);
                        xv[m][bj][0] = (f32x4){__uint_as_float(w.x << 16), __uint_as_float(w.x & 0xffff0000u), __uint_as_float(w.y << 16), __uint_as_float(w.y & 0xffff0000u)};
                        xv[m][bj][1] = (f32x4){__uint_as_float(w.z << 16), __uint_as_float(w.z & 0xffff0000u), __uint_as_float(w.w << 16), __uint_as_float(w.w & 0xffff0000u)}; }
                    else { xv[m][bj][0] = __builtin_nontemporal_load((const f32x4*)(xbase + off)); xv[m][bj][1] = __builtin_nontemporal_load((const f32x4*)(xbase + off + 4)); }
                }
            __builtin_amdgcn_sched_barrier(0);
#pragma unroll
            for (int m = 0; m < 4; ++m)
#pragma unroll
                for (int bj = 0; bj < 2; ++bj)
                    *(u32x4*)(obase + (size_t)(ai * 128 + m * 16) * 1024 + bj * 128) = pk8(xv[m][bj][0] + gv[bj][0] * acc[ai][bj][m][0], xv[m][bj][1] + gv[bj][1] * acc[ai][bj][m][1]);
        }
    }
};

struct Epi1 {
    static constexpr bool PERM = true, AFTER_DRAIN = false;
    unsigned char* ws; float* out;
    __device__ __forceinline__ void operator()(const f32x4 (&acc)[2][2][4][2], const pg8::Unit& u, int wr, int wc, int fr, int fq) const {
        const int reg = u.pn >> 1, cb = (u.pn & 1) * 256 + wc * 32 + 8 * fq;
        const bool ctx = u.pm < 16;
        bf16_t* P0 = (bf16_t*)(ws + WS_P);
#pragma unroll
        for (int ai = 0; ai < 2; ++ai)
#pragma unroll
            for (int m = 0; m < 4; ++m) {
                const int row = u.pm * 256 + ai * 128 + wr * 64 + m * 16 + fr;
                const int lt = row - NCTX, b = ctx ? (row >> 8) : (lt >> 10), t = ctx ? (row & 255) : (lt & 1023);
#pragma unroll
                for (int bj = 0; bj < 2; ++bj) {
                    const int c = cb + bj * 128; const f32x4 v0 = acc[ai][bj][m][0], v1 = acc[ai][bj][m][1];
                    if (reg == 0) *(u32x4*)(P0 + (size_t)row * 2048 + c) = pk8(v0 * QSCALE, v1 * QSCALE);
                    else if (reg >= 3) *(u32x4*)(P0 + (size_t)row * 2048 + (reg - 2) * 512 + c) = pk8(v0, v1);
                    else if (reg == 1) {
                        if (ctx) { float* o = out + O_NAK + (size_t)row * 512 + c; *(f32x4*)o = v0; *(f32x4*)(o + 4) = v1;
                            *(u32x4*)((bf16_t*)(ws + WS_K0C) + (size_t)row * 512 + c) = pk8(v0, v1); }
                        else *(u32x4*)((bf16_t*)(ws + WS_K0L) + ((size_t)b * 1280 + 256 + t) * 512 + c) = pk8(v0, v1);
                    } else {
                        if (ctx) { float* o = out + O_NAV + (size_t)row * 512 + c; *(f32x4*)o = v0; *(f32x4*)(o + 4) = v1;
                            *(u32x4*)((bf16_t*)(ws + WS_V0C) + (size_t)row * 512 + c) = pk8(v0, v1); }
                        else *(u32x4*)((bf16_t*)(ws + WS_V0L) + ((size_t)b * 1280 + 256 + t) * 512 + c) = pk8(v0, v1);
                    }
                }
            }
    }
};

struct Epi3 {
    static constexpr bool PERM = true, AFTER_DRAIN = false;
    unsigned char* ws; float* out;
    __device__ __forceinline__ void operator()(const f32x4 (&acc)[2][2][4][2], const pg8::Unit& u, int wr, int wc, int fr, int fq) const {
        const int reg = u.pn >> 2, cb = (u.pn & 3) * 256 + wc * 32 + 8 * fq;
        const bool ctx = u.pm < 16;
        bf16_t* P1 = (bf16_t*)(ws + WS_P);
        const float* rc = (const float*)(ws + WS_ROPE);
        const bool rope = !ctx && reg < 2;
        const float sgn = fq >= 2 ? 1.0f : -1.0f;
#pragma unroll
        for (int ai = 0; ai < 2; ++ai) {
            f32x4 csv[4][2], snv[4][2];
            if (rope) {
#pragma unroll
                for (int m = 0; m < 4; ++m) { const int t = (u.pm * 256 + ai * 128 + wr * 64 + m * 16 + fr - NCTX) & 1023; const int pos = (wc & 1) ? (t & 63) : (t >> 6);
#pragma unroll
                    for (int n = 0; n < 2; ++n) { const int idx = pos * 16 + 8 * (fq & 1) + 4 * n; csv[m][n] = *(const f32x4*)(rc + idx); snv[m][n] = *(const f32x4*)(rc + 1024 + idx); } }
            }
#pragma unroll
            for (int m = 0; m < 4; ++m) {
                const int row = u.pm * 256 + ai * 128 + wr * 64 + m * 16 + fr;
                const int lt = row - NCTX, b = ctx ? (row >> 8) : (lt >> 10), t = ctx ? (row & 255) : (lt & 1023);
#pragma unroll
                for (int bj = 0; bj < 2; ++bj) {
                    f32x4 v0 = acc[ai][bj][m][0], v1 = acc[ai][bj][m][1];
                    if (rope) {
                        f32x4 p0, p1;
#pragma unroll
                        for (int j = 0; j < 4; ++j) { p0[j] = __shfl_xor(v0[j], 32); p1[j] = __shfl_xor(v1[j], 32); }
                        v0 = v0 * csv[m][0] + (p0 * snv[m][0]) * sgn; v1 = v1 * csv[m][1] + (p1 * snv[m][1]) * sgn;
                    }
                    const int c = cb + bj * 128;
                    if (reg == 0) *(u32x4*)(P1 + (size_t)row * 2048 + c) = pk8(v0 * QSCALE, v1 * QSCALE);
                    else if (reg == 3) *(u32x4*)(P1 + (size_t)row * 2048 + 1024 + c) = pk8(v0, v1);
                    else if (reg == 1) {
                        if (ctx) { float* o = out + O_DK + (size_t)row * 1024 + c; *(f32x4*)o = v0; *(f32x4*)(o + 4) = v1;
                            *(u32x4*)((bf16_t*)(ws + WS_K1C) + (size_t)row * 1024 + c) = pk8(v0, v1); }
                        else *(u32x4*)((bf16_t*)(ws + WS_K1L) + ((size_t)b * 1280 + 256 + t) * 1024 + c) = pk8(v0, v1);
                    } else {
                        if (ctx) { float* o = out + O_DV + (size_t)row * 1024 + c; *(f32x4*)o = v0; *(f32x4*)(o + 4) = v1;
                            *(u32x4*)((bf16_t*)(ws + WS_V1C) + (size_t)row * 1024 + c) = pk8(v0, v1); }
                        else *(u32x4*)((bf16_t*)(ws + WS_V1L) + ((size_t)b * 1280 + 256 + t) * 1024 + c) = pk8(v0, v1);
                    }
                }
            }
        }
    }
};
#define MFMA16(a, b, c) __builtin_amdgcn_mfma_f32_16x16x32_bf16(a, b, c, 0, 0, 0)
constexpr float SC_LOG2 = 0.125f * 1.4426950408889634f;
constexpr float LOG2E = 1.4426950408889634f;
constexpr float RS_TAU = 8.0f;
__device__ __forceinline__ float ex2(float x) { return __builtin_amdgcn_exp2f(x); }
__device__ __forceinline__ bf16x8 pack8(const float (&v)[8]) {
    u32x4 w; w.x = pg8::cvt_pk_bf16(v[0], v[1]); w.y = pg8::cvt_pk_bf16(v[2], v[3]); w.z = pg8::cvt_pk_bf16(v[4], v[5]); w.w = pg8::cvt_pk_bf16(v[6], v[7]);
    return __builtin_bit_cast(bf16x8, w);
}
__device__ __forceinline__ bf16x8 cat2(u32x2 a, u32x2 b) { u32x4 w; w.x = a.x; w.y = a.y; w.z = b.x; w.w = b.y; return __builtin_bit_cast(bf16x8, w); }

template <int DK, int DV> struct ACfg {
    static constexpr int KP = DK * 2 + 16, VP = 136;
    static constexpr int KBYTES = 64 * KP, VBYTES = DV * VP, STAGE = KBYTES + VBYTES;
    static constexpr int NK = DK / 64, NV = DV / 64;
};
template <int DK, int DV>
__device__ __forceinline__ void stage_load(const bf16_t* Ksrc, size_t ldk, const bf16_t* Vsrc, size_t ldv, u32x4 (&kr)[DK / 64], u32x4 (&vr)[DV / 64], int tid) {
#pragma unroll
    for (int i = 0; i < DK / 64; ++i) { const int idx = tid + i * 512, row = idx / (DK / 8), pc = idx % (DK / 8); kr[i] = *(const u32x4*)(Ksrc + (size_t)row * ldk + pc * 8); }
#pragma unroll
    for (int i = 0; i < DV / 64; ++i) { const int idx = tid + i * 512, key = idx & 63, pc = idx >> 6; vr[i] = *(const u32x4*)(Vsrc + (size_t)key * ldv + pc * 8); }
}
template <int DK, int DV>
__device__ __forceinline__ void stage_store(LAS unsigned char* base, const u32x4 (&kr)[DK / 64], const u32x4 (&vr)[DV / 64], int tid) {
    typedef ACfg<DK, DV> C;
#pragma unroll
    for (int i = 0; i < DK / 64; ++i) { const int idx = tid + i * 512, row = idx / (DK / 8), pc = idx % (DK / 8); *(LAS u32x4*)(base + row * C::KP + pc * 16) = kr[i]; }
#pragma unroll
    for (int i = 0; i < DV / 64; ++i) { const int idx = tid + i * 512, key = idx & 63, pc = idx >> 6;
        LAS unsigned char* d = base + C::KBYTES + (pc * 8) * C::VP + key * 2;
        *(LAS unsigned short*)(d + 0 * C::VP) = (unsigned short)(vr[i].x & 0xffffu); *(LAS unsigned short*)(d + 1 * C::VP) = (unsigned short)(vr[i].x >> 16);
        *(LAS unsigned short*)(d + 2 * C::VP) = (unsigned short)(vr[i].y & 0xffffu); *(LAS unsigned short*)(d + 3 * C::VP) = (unsigned short)(vr[i].y >> 16);
        *(LAS unsigned short*)(d + 4 * C::VP) = (unsigned short)(vr[i].z & 0xffffu); *(LAS unsigned short*)(d + 5 * C::VP) = (unsigned short)(vr[i].z >> 16);
        *(LAS unsigned short*)(d + 6 * C::VP) = (unsigned short)(vr[i].w & 0xffffu); *(LAS unsigned short*)(d + 7 * C::VP) = (unsigned short)(vr[i].w >> 16); }
}

struct St1 { f32x4 O[4]; float m, l; };
template <bool BIAS>
__device__ __forceinline__ void chunk1(const LAS unsigned char* kt, const LAS unsigned char* vt, int fr, int fq, const bf16x8 (&qf)[2], St1& st, const float (&bias)[8]) {
    typedef ACfg<64, 64> C;
    const LAS unsigned char* kl = kt + fr * C::KP + fq * 16;
    const LAS unsigned char* vl = vt + fr * C::VP + fq * 8;
    const bf16x8 k00 = *(const LAS bf16x8*)(kl), k01 = *(const LAS bf16x8*)(kl + 64), k10 = *(const LAS bf16x8*)(kl + 16 * C::KP), k11 = *(const LAS bf16x8*)(kl + 16 * C::KP + 64);
    u32x2 va[4], vb[4];
#pragma unroll
    for (int db = 0; db < 4; ++db) { va[db] = *(const LAS u32x2*)(vl + db * 16 * C::VP); vb[db] = *(const LAS u32x2*)(vl + db * 16 * C::VP + 32); }
    f32x4 s0 = {0.f, 0.f, 0.f, 0.f}, s1 = {0.f, 0.f, 0.f, 0.f};
    s0 = MFMA16(k00, qf[0], s0); s0 = MFMA16(k01, qf[1], s0); s1 = MFMA16(k10, qf[0], s1); s1 = MFMA16(k11, qf[1], s1);
    float sv[8];
#pragma unroll
    for (int j = 0; j < 4; ++j) { sv[j] = s0[j]; sv[4 + j] = s1[j]; }
    if (BIAS) {
#pragma unroll
        for (int i = 0; i < 8; ++i) sv[i] += bias[i];
    }
    float cm = fmaxf(fmaxf(fmaxf(sv[0], sv[1]), fmaxf(sv[2], sv[3])), fmaxf(fmaxf(sv[4], sv[5]), fmaxf(sv[6], sv[7])));
    cm = fmaxf(cm, __shfl_xor(cm, 16)); cm = fmaxf(cm, __shfl_xor(cm, 32));
    float mn = st.m;
    if (__builtin_amdgcn_ballot_w64(cm > st.m + RS_TAU)) {
        mn = fmaxf(st.m, cm);
        const float al = ex2(st.m - mn);
        st.l *= al;
#pragma unroll
        for (int db = 0; db < 4; ++db) st.O[db] *= al;
        st.m = mn;
    }
    float ps = 0.f;
#pragma unroll
    for (int i = 0; i < 8; ++i) { sv[i] = ex2(sv[i] - mn); ps += sv[i]; }
    st.l += ps;
    const bf16x8 pf = pack8(sv);
#pragma unroll
    for (int db = 0; db < 4; ++db) st.O[db] = MFMA16(cat2(va[db], vb[db]), pf, st.O[db]);
}

struct St2 { f32x4 O1[8], O2[8]; float m1, l1, m2, l2; };
__device__ __forceinline__ void qk_sm2(const LAS unsigned char* kt, int fr, int fq, const bf16x8 (&qf)[4], St2& st, bf16x8 (&pf1)[2], bf16x8 (&pf2)[2]) {
    typedef ACfg<128, 128> C;
    const LAS unsigned char* kl = kt + fr * C::KP + fq * 16;
    f32x4 a[4], b[4];
#pragma unroll
    for (int kh = 0; kh < 2; ++kh) {
        bf16x8 kf[2][4];
#pragma unroll
        for (int k2 = 0; k2 < 2; ++k2)
#pragma unroll
            for (int i = 0; i < 4; ++i) kf[k2][i] = *(const LAS bf16x8*)(kl + (kh * 2 + k2) * 16 * C::KP + i * 64);
        __builtin_amdgcn_sched_barrier(0);
#pragma unroll
        for (int k2 = 0; k2 < 2; ++k2) { const int kb = kh * 2 + k2;
            a[kb] = (f32x4){0.f, 0.f, 0.f, 0.f}; b[kb] = (f32x4){0.f, 0.f, 0.f, 0.f};
            a[kb] = MFMA16(kf[k2][0], qf[0], a[kb]); a[kb] = MFMA16(kf[k2][1], qf[1], a[kb]);
            b[kb] = MFMA16(kf[k2][2], qf[2], b[kb]); b[kb] = MFMA16(kf[k2][3], qf[3], b[kb]); }
    }
    float c1 = fmaxf(fmaxf(a[0][0], a[0][1]), fmaxf(a[0][2], a[0][3])), c2 = fmaxf(fmaxf(b[0][0], b[0][1]), fmaxf(b[0][2], b[0][3]));
#pragma unroll
    for (int kb = 1; kb < 4; ++kb) { c1 = fmaxf(c1, fmaxf(fmaxf(a[kb][0], a[kb][1]), fmaxf(a[kb][2], a[kb][3]))); c2 = fmaxf(c2, fmaxf(fmaxf(b[kb][0], b[kb][1]), fmaxf(b[kb][2], b[kb][3]))); }
    c1 = fmaxf(c1, __shfl_xor(c1, 16)); c1 = fmaxf(c1, __shfl_xor(c1, 32));
    c2 = fmaxf(c2, __shfl_xor(c2, 16)); c2 = fmaxf(c2, __shfl_xor(c2, 32));
    float n1 = st.m1, n2 = st.m2;
    const bool grow = (c1 > st.m1 + RS_TAU) || (c2 > st.m2 + RS_TAU);
    if (__builtin_amdgcn_ballot_w64(grow)) {
        n1 = fmaxf(st.m1, c1); n2 = fmaxf(st.m2, c2);
        const float al1 = ex2(st.m1 - n1), al2 = ex2(st.m2 - n2);
        st.l1 *= al1; st.l2 *= al2;
#pragma unroll
        for (int db = 0; db < 8; ++db) { st.O1[db] *= al1; st.O2[db] *= al2; }
        st.m1 = n1; st.m2 = n2;
    }
    float p1 = 0.f, p2 = 0.f;
#pragma unroll
    for (int hf = 0; hf < 2; ++hf) {
        float e1[8], e2[8];
#pragma unroll
        for (int j = 0; j < 4; ++j) { e1[j] = ex2(a[2 * hf][j] - n1); e1[4 + j] = ex2(a[2 * hf + 1][j] - n1); e2[j] = ex2(b[2 * hf][j] - n2); e2[4 + j] = ex2(b[2 * hf + 1][j] - n2); }
#pragma unroll
        for (int i = 0; i < 8; ++i) { p1 += e1[i]; p2 += e2[i]; }
        pf1[hf] = pack8(e1); pf2[hf] = pack8(e2);
    }
    st.l1 += p1; st.l2 += p2;
}
__device__ __forceinline__ void pv2(const LAS unsigned char* vt, int fr, int fq, const bf16x8 (&pf1)[2], const bf16x8 (&pf2)[2], St2& st) {
    typedef ACfg<128, 128> C;
    const LAS unsigned char* vl = vt + fr * C::VP + fq * 8;
#pragma unroll
    for (int dg = 0; dg < 2; ++dg) {
        u32x2 va[4][2], vb[4][2];
#pragma unroll
        for (int d4 = 0; d4 < 4; ++d4)
#pragma unroll
            for (int hf = 0; hf < 2; ++hf) { va[d4][hf] = *(const LAS u32x2*)(vl + (dg * 4 + d4) * 16 * C::VP + hf * 64); vb[d4][hf] = *(const LAS u32x2*)(vl + (dg * 4 + d4) * 16 * C::VP + hf * 64 + 32); }
        __builtin_amdgcn_sched_barrier(0);
#pragma unroll
        for (int d4 = 0; d4 < 4; ++d4)
#pragma unroll
            for (int hf = 0; hf < 2; ++hf) { const int db = dg * 4 + d4; const bf16x8 vf = cat2(va[d4][hf], vb[d4][hf]);
                st.O1[db] = MFMA16(vf, pf1[hf], st.O1[db]);
                st.O2[db] = MFMA16(vf, pf2[hf], st.O2[db]); }
    }
}

__device__ __forceinline__ void step1(const LAS unsigned char* kt, const LAS unsigned char* vt, int fr, int fq, const bf16x8 (&qf)[2], St1& st) {
    typedef ACfg<64, 64> C;
    const LAS unsigned char* kl = kt + fr * C::KP + fq * 16;
    const LAS unsigned char* vl = vt + fr * C::VP + fq * 8;
    f32x4 a[4];
    {
        bf16x8 kf[4][2];
#pragma unroll
        for (int kb = 0; kb < 4; ++kb) { kf[kb][0] = *(const LAS bf16x8*)(kl + kb * 16 * C::KP); kf[kb][1] = *(const LAS bf16x8*)(kl + kb * 16 * C::KP + 64); }
        __builtin_amdgcn_sched_barrier(0);
#pragma unroll
        for (int kb = 0; kb < 4; ++kb) { a[kb] = (f32x4){0.f, 0.f, 0.f, 0.f}; a[kb] = MFMA16(kf[kb][0], qf[0], a[kb]); a[kb] = MFMA16(kf[kb][1], qf[1], a[kb]); }
    }
    float c1 = fmaxf(fmaxf(a[0][0], a[0][1]), fmaxf(a[0][2], a[0][3]));
#pragma unroll
    for (int kb = 1; kb < 4; ++kb) c1 = fmaxf(c1, fmaxf(fmaxf(a[kb][0], a[kb][1]), fmaxf(a[kb][2], a[kb][3])));
    c1 = fmaxf(c1, __shfl_xor(c1, 16)); c1 = fmaxf(c1, __shfl_xor(c1, 32));
    float n1 = st.m;
    if (__builtin_amdgcn_ballot_w64(c1 > st.m + RS_TAU)) {
        n1 = fmaxf(st.m, c1);
        const float al = ex2(st.m - n1);
        st.l *= al;
#pragma unroll
        for (int db = 0; db < 4; ++db) st.O[db] *= al;
        st.m = n1;
    }
    float p1 = 0.f;
    bf16x8 pf[2];
#pragma unroll
    for (int hf = 0; hf < 2; ++hf) {
        float e1[8];
#pragma unroll
        for (int j = 0; j < 4; ++j) { e1[j] = ex2(a[2 * hf][j] - n1); e1[4 + j] = ex2(a[2 * hf + 1][j] - n1); }
#pragma unroll
        for (int i = 0; i < 8; ++i) p1 += e1[i];
        pf[hf] = pack8(e1);
    }
    st.l += p1;
    {
        u32x2 va[4][2], vb[4][2];
#pragma unroll
        for (int db = 0; db < 4; ++db)
#pragma unroll
            for (int hf = 0; hf < 2; ++hf) { va[db][hf] = *(const LAS u32x2*)(vl + db * 16 * C::VP + hf * 64); vb[db][hf] = *(const LAS u32x2*)(vl + db * 16 * C::VP + hf * 64 + 32); }
        __builtin_amdgcn_sched_barrier(0);
#pragma unroll
        for (int db = 0; db < 4; ++db)
#pragma unroll
            for (int hf = 0; hf < 2; ++hf) st.O[db] = MFMA16(cat2(va[db][hf], vb[db][hf]), pf[hf], st.O[db]);
    }
}

constexpr int A0_RPB_OFF = 36864;
__device__ __forceinline__ void attn0_item(const Params& p, int item, LAS unsigned char* lds) {
    typedef ACfg<64, 64> C;
    const int tid = tidx(), lane = tid & 63, w = tid >> 6, fr = lane & 15, fq = lane >> 4;
    const bf16_t* P0 = (const bf16_t*)(p.ws + WS_P);
    bf16_t* Y = (bf16_t*)(p.ws + WS_Y);
    St1 st;
#pragma unroll
    for (int db = 0; db < 4; ++db) st.O[db] = (f32x4){0.f, 0.f, 0.f, 0.f};
    st.m = -1e30f; st.l = 0.f;
    bf16x8 qf[2]; int tok, h;
    float bias[8];
#pragma unroll
    for (int i = 0; i < 8; ++i) bias[i] = 0.f;
    const bf16_t* K; const bf16_t* V; size_t ldv; int nsteps, nwin, rs0, r = 0, rs = 0, span0 = 0, qc = 0, cs = 0;
    LAS float* rpbs = (LAS float*)(lds + A0_RPB_OFF);
    __syncthreads();
    if (item < 512) {
        const int b = item >> 6; h = (item >> 3) & 7; const int rp = item & 7;
        r = 2 * rp + (w >> 2); const int cq = w & 3, c0 = cq * 16;
        tok = NCTX + b * 1024 + r * 64 + c0 + fr;
        span0 = cq == 0 ? 0 : (cq == 1 ? 8 : (cq == 2 ? 24 : 32));
        rs = min(max(r - 4, 0), 8); qc = c0 + fr; cs = min(max(qc - 8, 0), 48);
        rs0 = min(max(2 * rp - 4, 0), 8); const int rs1 = min(max(2 * rp - 3, 0), 8); nwin = 8 + rs1 - rs0; nsteps = nwin + 4;
        K = (const bf16_t*)(p.ws + WS_K0L) + (size_t)b * 1280 * 512 + h * 64;
        V = (const bf16_t*)(p.ws + WS_V0L) + (size_t)b * 1280 * 512 + h * 64; ldv = 512;
        if (tid < 465) rpbs[tid] = p.in[13][h * 465 + tid] * LOG2E;
    } else {
        const int it = item - 512; const int b = it >> 4; h = (it >> 1) & 7; const int qb = it & 1;
        tok = b * 256 + qb * 128 + w * 16 + fr;
        nwin = 0; nsteps = 4; rs0 = 0;
        K = (const bf16_t*)(p.ws + WS_K0C) + (size_t)b * 256 * 512 + h * 64;
        V = (const bf16_t*)(p.ws + WS_V0C) + (size_t)b * 256 * 512 + h * 64; ldv = 512;
    }
    qf[0] = *(const bf16x8*)(P0 + (size_t)tok * 2048 + h * 64 + fq * 8); qf[1] = *(const bf16x8*)(P0 + (size_t)tok * 2048 + h * 64 + 32 + fq * 8);
    u32x2 gwv[4];
#pragma unroll
    for (int db = 0; db < 4; ++db) gwv[db] = *(const u32x2*)(P0 + (size_t)tok * 2048 + 512 + h * 64 + db * 16 + fq * 4);
#define A0_KEY0(s) ((s) < nwin ? 256 + (rs0 + (s)) * 64 : ((s) - nwin) * 64)
#define A0_LOAD(s, KR, VR) do { const int _k0 = A0_KEY0(s); stage_load<64, 64>(K + (size_t)_k0 * 512, 512, V + (size_t)_k0 * 512, ldv, KR, VR, tid); } while (0)
#define A0_COMPUTE(s, cur) do { \
        if ((s) < nwin) { const int krow = rs0 + (s); \
            if (krow >= rs && krow < rs + 8) { const LAS float* rb = rpbs + (krow - r + 7) * 31; \
                _Pragma("unroll") for (int i = 0; i < 8; ++i) { const int kc = span0 + (i >> 2) * 16 + fq * 4 + (i & 3); \
                    const bool ok = kc >= cs && kc < cs + 16; const int dc = min(max(kc - qc + 15, 0), 30); bias[i] = ok ? rb[dc] : -1e30f; } \
                chunk1<true>((cur) + span0 * C::KP, (cur) + C::KBYTES + span0 * 2, fr, fq, qf, st, bias); } \
        } else step1((cur), (cur) + C::KBYTES, fr, fq, qf, st); } while (0)
    u32x4 krA[1], vrA[1], krB[1], vrB[1];
    A0_LOAD(0, krA, vrA);
    A0_LOAD(1, krB, vrB);
    stage_store<64, 64>(lds, krA, vrA, tid);
    __syncthreads();
    for (int s = 0; s < nsteps; s += 2) {
        if (s + 2 < nsteps) A0_LOAD(s + 2, krA, vrA);
        A0_COMPUTE(s, lds);
        if (s + 1 < nsteps) stage_store<64, 64>(lds + C::STAGE, krB, vrB, tid);
        __syncthreads();
        if (s + 1 >= nsteps) break;
        if (s + 3 < nsteps) A0_LOAD(s + 3, krB, vrB);
        A0_COMPUTE(s + 1, lds + C::STAGE);
        if (s + 2 < nsteps) stage_store<64, 64>(lds, krA, vrA, tid);
        __syncthreads();
    }
#undef A0_KEY0
#undef A0_LOAD
#undef A0_COMPUTE
    float l = st.l; l += __shfl_xor(l, 16); l += __shfl_xor(l, 32);
    const float il = 1.0f / l;
#pragma unroll
    for (int db = 0; db < 4; ++db) {
        const int d = db * 16 + fq * 4;
        const u32x2 gw = gwv[db];
        f32x4 o;
        o[0] = st.O[db][0] * il * silu_f(__uint_as_float(gw.x << 16)); o[1] = st.O[db][1] * il * silu_f(__uint_as_float(gw.x & 0xffff0000u));
        o[2] = st.O[db][2] * il * silu_f(__uint_as_float(gw.y << 16)); o[3] = st.O[db][3] * il * silu_f(__uint_as_float(gw.y & 0xffff0000u));
        *(u32x2*)(Y + (size_t)tok * 1024 + h * 64 + d) = pk4(o);
    }
}

__device__ __forceinline__ void attn1_item(const Params& p, int item, float lam, LAS unsigned char* lds) {
    typedef ACfg<128, 128> C;
    const int tid = tidx(), lane = tid & 63, w = tid >> 6, fr = lane & 15, fq = lane >> 4;
    const bf16_t* P1 = (const bf16_t*)(p.ws + WS_P);
    bf16_t* Y = (bf16_t*)(p.ws + WS_Y);
    St2 st;
#pragma unroll
    for (int db = 0; db < 8; ++db) { st.O1[db] = (f32x4){0.f, 0.f, 0.f, 0.f}; st.O2[db] = (f32x4){0.f, 0.f, 0.f, 0.f}; }
    st.m1 = -1e30f; st.l1 = 0.f; st.m2 = -1e30f; st.l2 = 0.f;
    int tok, h, nst; const bf16_t* K; const bf16_t* V; size_t ldv;
    if (item < 512) {
        const int b = item >> 6; h = (item >> 3) & 7; const int qb = item & 7;
        tok = NCTX + b * 1024 + qb * 128 + w * 16 + fr; nst = 20;
        K = (const bf16_t*)(p.ws + WS_K1L) + (size_t)b * 1280 * 1024 + h * 128;
        V = (const bf16_t*)(p.ws + WS_V1L) + (size_t)b * 1280 * 1024 + h * 128; ldv = 1024;
    } else {
        const int it = item - 512; const int b = it >> 4; h = (it >> 1) & 7; const int qb = it & 1;
        tok = b * 256 + qb * 128 + w * 16 + fr; nst = 4;
        K = (const bf16_t*)(p.ws + WS_K1C) + (size_t)b * 256 * 1024 + h * 128;
        V = (const bf16_t*)(p.ws + WS_V1C) + (size_t)b * 256 * 1024 + h * 128; ldv = 1024;
    }
    bf16x8 qf[4];
#pragma unroll
    for (int i = 0; i < 4; ++i) qf[i] = *(const bf16x8*)(P1 + (size_t)tok * 2048 + h * 128 + i * 32 + fq * 8);
    u32x2 gwv[8];
#pragma unroll
    for (int db = 0; db < 8; ++db) gwv[db] = *(const u32x2*)(P1 + (size_t)tok * 2048 + 1024 + h * 128 + db * 16 + fq * 4);
    u32x4 kr[2], vr[2];
    bf16x8 pf1[2], pf2[2];
    const bool late = w >= 4;
    __syncthreads();
    stage_load<128, 128>(K, 1024, V, ldv, kr, vr, tid); stage_store<128, 128>(lds, kr, vr, tid);
    __syncthreads();
    int bc = 0, bp = 2;
    if (late) __builtin_amdgcn_s_setprio(1);
    for (int s = 0; s < nst; ++s) {
        LAS unsigned char* cur = lds + bc * C::STAGE;
        const int bn = bc == 2 ? 0 : bc + 1;
        if (s + 1 < nst) stage_load<128, 128>(K + (size_t)(s + 1) * 64 * 1024, 1024, V + (size_t)(s + 1) * 64 * 1024, ldv, kr, vr, tid);
        if (late) {
            if (s > 0) pv2(lds + bp * C::STAGE + C::KBYTES, fr, fq, pf1, pf2, st);
            qk_sm2(cur, fr, fq, qf, st, pf1, pf2);
        } else {
            qk_sm2(cur, fr, fq, qf, st, pf1, pf2);
            pv2(cur + C::KBYTES, fr, fq, pf1, pf2, st);
        }
        if (s + 1 < nst) stage_store<128, 128>(lds + bn * C::STAGE, kr, vr, tid);
        __syncthreads();
        bp = bc; bc = bn;
    }
    if (late) pv2(lds + bp * C::STAGE + C::KBYTES, fr, fq, pf1, pf2, st);
    __builtin_amdgcn_s_setprio(0);
    float l1 = st.l1; l1 += __shfl_xor(l1, 16); l1 += __shfl_xor(l1, 32);
    float l2 = st.l2; l2 += __shfl_xor(l2, 16); l2 += __shfl_xor(l2, 32);
    const float i1 = 1.0f / l1, i2 = lam / l2;
    float ss = 0.f;
#pragma unroll
    for (int db = 0; db < 8; ++db) { st.O1[db] = st.O1[db] * i1 - st.O2[db] * i2;
        ss += st.O1[db][0] * st.O1[db][0] + st.O1[db][1] * st.O1[db][1] + st.O1[db][2] * st.O1[db][2] + st.O1[db][3] * st.O1[db][3]; }
    ss += __shfl_xor(ss, 16); ss += __shfl_xor(ss, 32);
    const float rstd = rsqrtf(ss * (1.0f / 128.0f) + 1e-6f) * (1.0f - LAM_INIT);
    f32x4 sgv[8];
#pragma unroll
    for (int db = 0; db < 8; ++db) sgv[db] = *(const f32x4*)(p.in[30] + db * 16 + fq * 4);
    __builtin_amdgcn_sched_barrier(0);
#pragma unroll
    for (int db = 0; db < 8; ++db) {
        const int d = db * 16 + fq * 4;
        const u32x2 gw = gwv[db];
        const f32x4 sg = sgv[db];
        f32x4 o;
        o[0] = st.O1[db][0] * rstd * sg[0] * silu_f(__uint_as_float(gw.x << 16)); o[1] = st.O1[db][1] * rstd * sg[1] * silu_f(__uint_as_float(gw.x & 0xffff0000u));
        o[2] = st.O1[db][2] * rstd * sg[2] * silu_f(__uint_as_float(gw.y << 16)); o[3] = st.O1[db][3] * rstd * sg[3] * silu_f(__uint_as_float(gw.y & 0xffff0000u));
        *(u32x2*)(Y + (size_t)tok * 1024 + h * 128 + d) = pk4(o);
    }
}
__device__ __forceinline__ float sigm(float x) { return __builtin_amdgcn_rcpf(1.0f + ex2(-LOG2E * x)); }
__device__ __forceinline__ void lru_item(const Params& p, int item, float* sm) {
    const int tid = tidx(), lane = tid & 63, w = tid >> 6, fr = lane & 15, fq = lane >> 4;
    int s, n; if (item < 64) { s = 16 + (item >> 3); n = item & 7; } else { s = (item - 64) >> 3; n = (item - 64) & 7; }
    const bool lat = s >= 16;
    const int T = lat ? 1024 : 256, tok0 = lat ? NCTX + (s - 16) * 1024 : s * 256, nchunk = T >> 8;
    const bf16_t* P0 = (const bf16_t*)(p.ws + WS_P); bf16_t* Y = (bf16_t*)(p.ws + WS_Y); float* Hf = (float*)(p.ws + WS_HF);
    const bf16_t* Wg = (const bf16_t*)(p.ws + WS_WG);
    float* xcs = sm; float* seg = sm + 256 * 68;
    const int cg8 = (tid & 7) * 8, q0 = tid >> 3;
    for (int dir = 0; dir < 2; ++dir) {
        float ba[4], bx[4], nl[4], carry[4];
#pragma unroll
        for (int dt = 0; dt < 4; ++dt) { const int ch = n * 64 + dt * 16 + fr;
            ba[dt] = p.in[17][dir * 512 + ch]; bx[dt] = p.in[19][dir * 512 + ch]; nl[dt] = -8.0f * LOG2E * log1pf(__expf(-p.in[20][dir * 512 + ch]));
            carry[dt] = lat ? p.in[5][((s - 16) * 2 + dir) * 512 + ch] : 0.f;
        }
        for (int ck = 0; ck < nchunk; ++ck) {
            __syncthreads();
            {
                float cw[4][8], cbv[8];
#pragma unroll
                for (int j = 0; j < 4; ++j) { const f32x4 a = *(const f32x4*)(p.in[14] + j * 512 + n * 64 + cg8), b = *(const f32x4*)(p.in[14] + j * 512 + n * 64 + cg8 + 4);
#pragma unroll
                    for (int k = 0; k < 4; ++k) { cw[j][k] = a[k]; cw[j][4 + k] = b[k]; } }
                { const f32x4 a = *(const f32x4*)(p.in[15] + n * 64 + cg8), b = *(const f32x4*)(p.in[15] + n * 64 + cg8 + 4);
#pragma unroll
                    for (int k = 0; k < 4; ++k) { cbv[k] = a[k]; cbv[4 + k] = b[k]; } }
                u32x4 wv[4][4];
#pragma unroll
                for (int i = 0; i < 4; ++i) {
                    const int q = q0 + 64 * i, pp = ck * 256 + q, t = dir ? T - 1 - pp : pp;
#pragma unroll
                    for (int j = 0; j < 4; ++j) { const int tt = min(max(t - 2 + j, 0), T - 1);
                        wv[i][j] = *(const u32x4*)(P0 + (size_t)(tok0 + tt) * 2048 + 1024 + n * 64 + cg8); }
                }
#pragma unroll
                for (int i = 0; i < 4; ++i) {
                    const int q = q0 + 64 * i, pp = ck * 256 + q, t = dir ? T - 1 - pp : pp;
                    float xc[8];
#pragma unroll
                    for (int k = 0; k < 8; ++k) xc[k] = cbv[k];
#pragma unroll
                    for (int j = 0; j < 4; ++j) { const int tt = t - 2 + j; const float ok = (tt >= 0 && tt < T) ? 1.0f : 0.0f; const u32x4 w4 = wv[i][j];
                        xc[0] += ok * cw[j][0] * __uint_as_float(w4.x << 16); xc[1] += ok * cw[j][1] * __uint_as_float(w4.x & 0xffff0000u);
                        xc[2] += ok * cw[j][2] * __uint_as_float(w4.y << 16); xc[3] += ok * cw[j][3] * __uint_as_float(w4.y & 0xffff0000u);
                        xc[4] += ok * cw[j][4] * __uint_as_float(w4.z << 16); xc[5] += ok * cw[j][5] * __uint_as_float(w4.z & 0xffff0000u);
                        xc[6] += ok * cw[j][6] * __uint_as_float(w4.w << 16); xc[7] += ok * cw[j][7] * __uint_as_float(w4.w & 0xffff0000u); }
                    *(f32x4*)(xcs + q * 68 + cg8) = (f32x4){xc[0], xc[1], xc[2], xc[3]};
                    *(f32x4*)(xcs + q * 68 + cg8 + 4) = (f32x4){xc[4], xc[5], xc[6], xc[7]};
                }
            }
            bf16x8 wfa[2][2], wfx[2][2];
#define LRU_WF(dt_, sl_) do { _Pragma("unroll") for (int ks = 0; ks < 2; ++ks) { \
                wfa[sl_][ks] = *(const bf16x8*)(Wg + (size_t)((((dir * 2 + 0) * 8 + n) * 64) + (dt_) * 16 + fr) * 64 + ks * 32 + fq * 8); \
                wfx[sl_][ks] = *(const bf16x8*)(Wg + (size_t)((((dir * 2 + 1) * 8 + n) * 64) + (dt_) * 16 + fr) * 64 + ks * 32 + fq * 8); } } while (0)
            LRU_WF(0, 0);
            __syncthreads();
            bf16x8 af[2][2];
#pragma unroll
            for (int tt = 0; tt < 2; ++tt)
#pragma unroll
                for (int ks = 0; ks < 2; ++ks) { const float* src = xcs + (w * 32 + tt * 16 + fr) * 68 + ks * 32 + fq * 8;
                    const f32x4 x0 = *(const f32x4*)src, x1 = *(const f32x4*)(src + 4);
                    const float v[8] = {x0[0], x0[1], x0[2], x0[3], x1[0], x1[1], x1[2], x1[3]};
                    af[tt][ks] = pack8(v); }
            float hl[2][4][4], ap[2][4][4], Aex[2][4], Hex[2][4];
#pragma unroll
            for (int dt = 0; dt < 4; ++dt) {
                float At0 = 1.f, Ht0 = 0.f;
                if (dt < 3) LRU_WF(dt + 1, (dt + 1) & 1);
#pragma unroll
                for (int tt = 0; tt < 2; ++tt) {
                    f32x4 ca = {0.f, 0.f, 0.f, 0.f}, cx = {0.f, 0.f, 0.f, 0.f};
#pragma unroll
                    for (int ks = 0; ks < 2; ++ks) { ca = MFMA16(af[tt][ks], wfa[dt & 1][ks], ca); cx = MFMA16(af[tt][ks], wfx[dt & 1][ks], cx); }
                    float h = 0.f, A = 1.f;
#pragma unroll
                    for (int j = 0; j < 4; ++j) {
                        const float xcv = xcs[(w * 32 + tt * 16 + fq * 4 + j) * 68 + dt * 16 + fr];
                        const float rr = sigm(ca[j] + ba[dt]), ii = sigm(cx[j] + bx[dt]);
                        const float a = ex2(rr * nl[dt]), uu = __builtin_amdgcn_sqrtf(fmaxf(1.0f - a * a, 0.f)) * (ii * xcv);
                        h = a * h + uu; A *= a; hl[tt][dt][j] = h; ap[tt][dt][j] = A;
                    }
                    { const float A1 = __shfl_up(A, 16), H1 = __shfl_up(h, 16); if (fq >= 1) { h = A * H1 + h; A = A * A1; } }
                    { const float A2 = __shfl_up(A, 32), H2 = __shfl_up(h, 32); if (fq >= 2) { h = A * H2 + h; A = A * A2; } }
                    float Ae = __shfl_up(A, 16), He = __shfl_up(h, 16); if (fq == 0) { Ae = 1.f; He = 0.f; }
                    const float At = __shfl(A, 48 + fr), Ht = __shfl(h, 48 + fr);
                    if (tt == 0) { Aex[0][dt] = Ae; Hex[0][dt] = He; At0 = At; Ht0 = Ht; }
                    else { Aex[1][dt] = At0 * Ae; Hex[1][dt] = Ae * Ht0 + He;
                        if (fq == 0) { seg[(w * 64 + dt * 16 + fr) * 2] = At0 * At; seg[(w * 64 + dt * 16 + fr) * 2 + 1] = At * Ht0 + Ht; } }
                }
            }
            __syncthreads();
#pragma unroll
            for (int dt = 0; dt < 4; ++dt) {
                float hc = carry[dt], hin = hc;
#pragma unroll
                for (int w2 = 0; w2 < 8; ++w2) { const float A = seg[(w2 * 64 + dt * 16 + fr) * 2], H = seg[(w2 * 64 + dt * 16 + fr) * 2 + 1];
                    hc = A * hc + H; if (w2 + 1 == w) hin = hc; }
                carry[dt] = hc;
#pragma unroll
                for (int tt = 0; tt < 2; ++tt) {
                    const float hs = Aex[tt][dt] * hin + Hex[tt][dt];
#pragma unroll
                    for (int j = 0; j < 4; ++j) xcs[(w * 32 + tt * 16 + fq * 4 + j) * 68 + dt * 16 + fr] = ap[tt][dt][j] * hs + hl[tt][dt][j];
                }
            }
            const int tid2 = tidx();
            f32x4 hfa[4][2]; u32x4 gba[4];
            if (dir == 1) {
#pragma unroll
                for (int i = 0; i < 4; ++i) { const int piece = tid2 + i * 512, q = piece >> 3, c8 = (piece & 7) * 8; const size_t tk = (size_t)(tok0 + T - 1 - (ck * 256 + q));
                    hfa[i][0] = *(const f32x4*)(Hf + tk * 512 + n * 64 + c8); hfa[i][1] = *(const f32x4*)(Hf + tk * 512 + n * 64 + c8 + 4);
                    gba[i] = *(const u32x4*)(P0 + tk * 2048 + 1536 + n * 64 + c8); }
            }
            __syncthreads();
#pragma unroll
            for (int i = 0; i < 4; ++i) {
                const int piece = tid2 + i * 512, q = piece >> 3, c8 = (piece & 7) * 8, pp = ck * 256 + q;
                const f32x4 h0 = *(const f32x4*)(xcs + q * 68 + c8), h1 = *(const f32x4*)(xcs + q * 68 + c8 + 4);
                if (dir == 0) { float* o = Hf + (size_t)(tok0 + pp) * 512 + n * 64 + c8; *(f32x4*)o = h0; *(f32x4*)(o + 4) = h1; }
                else {
                    const u32x4 gw = gba[i];
                    f32x4 g0 = {__uint_as_float(gw.x << 16), __uint_as_float(gw.x & 0xffff0000u), __uint_as_float(gw.y << 16), __uint_as_float(gw.y & 0xffff0000u)};
                    f32x4 g1 = {__uint_as_float(gw.z << 16), __uint_as_float(gw.z & 0xffff0000u), __uint_as_float(gw.w << 16), __uint_as_float(gw.w & 0xffff0000u)};
                    f32x4 y0, y1;
#pragma unroll
                    for (int e = 0; e < 4; ++e) { y0[e] = (hfa[i][0][e] + h0[e]) * g0[e] * sigm(g0[e]); y1[e] = (hfa[i][1][e] + h1[e]) * g1[e] * sigm(g1[e]); }
                    *(u32x4*)(Y + (size_t)(tok0 + T - 1 - pp) * 1024 + 512 + n * 64 + c8) = pk8(y0, y1);
                }
            }
        }
#undef LRU_WF
        if (!lat && w == 0 && fq == 0) {
#pragma unroll
            for (int dt = 0; dt < 4; ++dt) p.out[O_LRU + (s * 2 + dir) * 512 + n * 64 + dt * 16 + fr] = carry[dt];
        }
    }
}
__device__ __forceinline__ void gsync(const Params& p) {
    extern __shared__ __attribute__((aligned(16))) unsigned char smem_[];
    XcdBarrier b; b.bar = (unsigned*)(p.ws + WS_BAR); b.x = xb_xcc_id(); b.st = (volatile LAS unsigned*)((LAS unsigned char*)smem_ + 131072);
    xcd_barrier(b);
}
__global__ void __launch_bounds__(512) mega(Params p) {
    extern __shared__ __attribute__((aligned(16))) unsigned char smem[];
    cg::grid_group grid = cg::this_grid();
    PG8_LAS unsigned char* lds = (PG8_LAS unsigned char*)smem;
    const float* mod = (const float*)(p.ws + WS_MOD);
    pg8::StaticOrder S;
    volatile LAS unsigned* xst = (volatile LAS unsigned*)(lds + 131072);
    if (threadIdx.x == 0) { xst[0] = 0u; xst[1] = 0u; }
    __syncthreads();
    (void)xcd_barrier_post((unsigned*)(p.ws + WS_BAR), xst);
    phaseA(p, (float*)smem);
    grid.sync();
    phaseA1b(p, (float*)smem);
    phase_norm(p, 0, p.in[0], p.in[1]);
    gsync(p);
    { pg8::Gemm g{(const bf16_t*)(p.ws + WS_H), (const bf16_t*)(p.ws + WS_W1T), NTOK, 3072, 1024}; S.init(NTOK, 3072, (int)gridDim.x, (int)blockIdx.x);
      Epi1 E{p.ws, p.out};
      pg8::gemm_phase<Epi1, pg8::StaticOrder, false>(lds, g, S, E, nullptr); }
    if (blockIdx.x >= 64) phaseA2(p, (float*)smem, (int)blockIdx.x - 64, (int)gridDim.x - 64);
    gsync(p);
    {
        unsigned* qctr = (unsigned*)(p.ws + WS_BAR);
        volatile LAS int* slot = (volatile LAS int*)(lds + 131072 + 16);
        for (;;) {
            __syncthreads();
            if (threadIdx.x == 0) *slot = (int)__hip_atomic_fetch_add(qctr, 1u, __ATOMIC_RELAXED, __HIP_MEMORY_SCOPE_AGENT);
            __syncthreads();
            const int q = *slot;
            if (q >= 960) break;
            int kind, idx;
            if (q < 64) { kind = 0; idx = q; } else if (q < 576) { kind = 1; idx = q - 64; } else if (q < 704) { kind = 0; idx = 64 + q - 576; } else { kind = 1; idx = 512 + q - 704; }
            if (kind == 0) lru_item(p, idx, (float*)smem); else attn0_item(p, idx, lds);
        }
    }
    gsync(p);
    { pg8::Gemm g{(const bf16_t*)(p.ws + WS_Y), (const bf16_t*)(p.ws + WS_W2T), NTOK, 1024, 1024}; S.init(NTOK, 1024, (int)gridDim.x, (int)blockIdx.x);
      EpiRes<false> E{p.in[0], p.in[1], nullptr, (bf16_t*)(p.ws + WS_X1B), mod + 2048};
      pg8::gemm_phase<EpiRes<false>, pg8::StaticOrder, false>(lds, g, S, E, nullptr); }
    gsync(p);
    phase_norm16(p, (const bf16_t*)(p.ws + WS_X1B));
    gsync(p);
    { pg8::Gemm g{(const bf16_t*)(p.ws + WS_H), (const bf16_t*)(p.ws + WS_W3T), NTOK, 4096, 1024}; S.init(NTOK, 4096, (int)gridDim.x, (int)blockIdx.x);
      Epi3 E{p.ws, p.out};
      pg8::gemm_phase<Epi3, pg8::StaticOrder, false>(lds, g, S, E, nullptr); }
    gsync(p);
    { const int lane = threadIdx.x & 63;
      const float lam = __expf(wave_sum(p.in[26][lane] * p.in[27][lane])) - __expf(wave_sum(p.in[28][lane] * p.in[29][lane])) + LAM_INIT;
      for (int it = blockIdx.x; it < 768; it += gridDim.x) attn1_item(p, it, lam, lds); }
    gsync(p);
    { pg8::Gemm g{(const bf16_t*)(p.ws + WS_Y), (const bf16_t*)(p.ws + WS_W4T), NTOK, 1024, 1024}; S.init(NTOK, 1024, (int)gridDim.x, (int)blockIdx.x);
      EpiRes<true> E{nullptr, nullptr, (const bf16_t*)(p.ws + WS_X1B), (bf16_t*)(p.ws + WS_X2B), mod + 9 * 3072 + 2048};
      pg8::gemm_phase<EpiRes<true>, pg8::StaticOrder, false>(lds, g, S, E, nullptr); }
    gsync(p);
    phase_final16(p, (const bf16_t*)(p.ws + WS_X2B));
}

extern "C" void kernel_launch(void* const* d_in, const int* in_sizes, int n_in, void* d_out, int out_size, void* d_ws, size_t ws_size, hipStream_t stream) {
    static int grid_blocks = 0;
    if (!grid_blocks) {
        int dev = 0, cus = 0, per_cu = 0;
        (void)hipGetDevice(&dev);
        (void)hipDeviceGetAttribute(&cus, hipDeviceAttributeMultiprocessorCount, dev);
        (void)hipFuncSetAttribute((const void*)mega, hipFuncAttributeMaxDynamicSharedMemorySize, LDS_BYTES);
        (void)hipOccupancyMaxActiveBlocksPerMultiprocessor(&per_cu, (const void*)mega, 512, LDS_BYTES);
        if (per_cu < 1) { fprintf(stderr, "occupancy query says %d\n", per_cu); per_cu = 1; }
        grid_blocks = cus;
        if (ws_size < WS_END) fprintf(stderr, "workspace too small: %zu < %zu\n", ws_size, (size_t)WS_END);
    }
    (void)hipMemsetAsync((unsigned char*)d_ws + WS_BAR, 0, XCD_BAR_WORDS * 4, stream);
    Params p{};
    for (int i = 0; i < 33; ++i) p.in[i] = (const float*)d_in[i];
    p.out = (float*)d_out; p.ws = (unsigned char*)d_ws;
    void* args[] = {&p};
    hipError_t e = hipLaunchCooperativeKernel((void*)mega, dim3(grid_blocks), dim3(512), args, LDS_BYTES, stream);
    if (e != hipSuccess) fprintf(stderr, "cooperative launch failed: %s (grid %d)\n", hipGetErrorString(e), grid_blocks);
}
```

```cpp
#include <hip/hip_runtime.h>
#include <hip/hip_cooperative_groups.h>
#include <cstdio>
#include <cstdint>
namespace cg = cooperative_groups;
__device__ __forceinline__ int tidx() { int t = threadIdx.x; asm volatile("" : "+v"(t)); return t; }
namespace pg8 {
#define PG8_LAS __attribute__((address_space(3)))
typedef unsigned short bf16_t;
typedef short bf16x8 __attribute__((ext_vector_type(8)));
typedef float f32x4 __attribute__((ext_vector_type(4)));
typedef unsigned u32x4 __attribute__((ext_vector_type(4)));
constexpr int BM = 256, BK = 64, HALF = 128, HTB = HALF * BK * 2  , STAGE_BYTES = 8 * HTB, NXCD = 8, WGM = 8;

__host__ __device__ __forceinline__ int lds_byte(int r, int c) { const int st = (r >> 4) * 2 + (c >> 5), rr = r & 15, cc = c & 31, ob = rr * 64 + cc * 2; return st * 1024 + (ob ^ (((ob >> 9) & 1) << 5)); }
__host__ __device__ __forceinline__ void stage_rc(int b, int& R, int& C) { const int st = b / 1024, sb = b % 1024, swz = sb ^ (((sb >> 9) & 1) << 5); R = (st >> 1) * 16 + swz / 64; C = (st & 1) * 32 + (swz % 64) / 2; }
__host__ __device__ __forceinline__ int perm32(int rho) { const int n = rho >> 4, i = rho & 15; return 8 * (i >> 2) + 4 * n + (i & 3); }

struct Unit { int pm, pn; };
struct Gemm { const bf16_t* A; const bf16_t* Bt; int M, N, K; };

struct StaticOrder {
    int nM, nN, nwg, G, c;
    __host__ __device__ void init(int M, int N, int G_, int c_) { nM = M / BM; nN = N / BM; nwg = nM * nN; G = G_; c = c_; }
    __host__ __device__ bool next(int i, Unit& u) const {
        const long L = (long)i * G + c; if (L >= nwg) return false;
        int wgid = (int)L; { const int q = nwg / NXCD, r = nwg % NXCD, xcd = wgid % NXCD, off = wgid / NXCD; wgid = (xcd < r ? xcd * (q + 1) : r * (q + 1) + (xcd - r) * q) + off; }
        const int nig = WGM * nN, gid = wgid / nig, fm = gid * WGM, gsz = (nM - fm) < WGM ? (nM - fm) : WGM;
        u.pm = fm + ((wgid % nig) % gsz); u.pn = (wgid % nig) / gsz; return true;
    }
    __device__ __forceinline__ void a_ready(const Unit&) const {}
    __device__ __forceinline__ void done(const Unit&) const {}
};

__device__ __forceinline__ unsigned cvt_pk_bf16(float lo, float hi) { unsigned r; asm volatile("v_cvt_pk_bf16_f32 %0, %1, %2" : "=v"(r) : "v"(lo), "v"(hi)); return r; }
template <int ACT  > struct EpiBf16 {
    static constexpr bool PERM = true, AFTER_DRAIN = false;
    bf16_t* O; int ldc; const float* bias; int split_cols; size_t split_stride;
    __device__ __forceinline__ void operator()(const f32x4 (&acc)[2][2][4][2], const Unit& u, int wr, int wc, int fr, int fq) const {
        const int row0 = u.pm * BM + wr * 64 + fr; int colt = u.pn * BM; bf16_t* base = O;
        if (split_cols) { const int t = colt / split_cols; base += (size_t)t * split_stride; colt -= t * split_cols; }
        const int col0 = colt + wc * 32 + 8 * fq, bcol0 = u.pn * BM + wc * 32 + 8 * fq;
        f32x4 bv[2][2];
#pragma unroll
        for (int bj = 0; bj < 2; ++bj)
#pragma unroll
            for (int n = 0; n < 2; ++n) bv[bj][n] = bias ? *(const f32x4*)(bias + bcol0 + bj * HALF + 4 * n) : (f32x4){0.f, 0.f, 0.f, 0.f};
#pragma unroll
        for (int ai = 0; ai < 2; ++ai)
#pragma unroll
            for (int m = 0; m < 4; ++m) { bf16_t* rowp = base + (size_t)(row0 + ai * HALF + m * 16) * ldc + col0;
#pragma unroll
                for (int bj = 0; bj < 2; ++bj) { f32x4 v0 = acc[ai][bj][m][0] + bv[bj][0], v1 = acc[ai][bj][m][1] + bv[bj][1];
                    u32x4 w; w.x = cvt_pk_bf16(v0[0], v0[1]); w.y = cvt_pk_bf16(v0[2], v0[3]); w.z = cvt_pk_bf16(v1[0], v1[1]); w.w = cvt_pk_bf16(v1[2], v1[3]);
                    *(u32x4*)(rowp + bj * HALF) = w; } }
    }
};

template <class Epi, class Sched, bool STAMP = false>
__device__ __forceinline__ void gemm_phase(PG8_LAS unsigned char* lds, const Gemm g, const Sched& S, const Epi& E, unsigned long long* stamps) {
    const int tid = tidx(), wid = __builtin_amdgcn_readfirstlane(tid >> 6), lane = tid & 63, wr = wid >> 2, wc = wid & 3, fr = lane & 15, fq = lane >> 4;
    const int K = g.K, nt = K / BK;
    int ts_lo = 0, ts_hi = 0, nts = 0; const unsigned long long rt_entry = STAMP ? (unsigned long long)wall_clock64() : 0ull;
#define PG8_STAMP() do { if (STAMP && wid == 0 && nts < 64) { const unsigned long long _c = (unsigned long long)clock64(); \
        ts_lo = (lane == nts) ? (int)(unsigned)_c : ts_lo; ts_hi = (lane == nts) ? (int)(unsigned)(_c >> 32) : ts_hi; ++nts; } } while (0)
    PG8_STAMP();
    unsigned voffA[2], voffB[2];
#pragma unroll
    for (int i = 0; i < 2; ++i) { int R, C; stage_rc(tid * 16 + i * 8192, R, C); const int Rb = Epi::PERM ? ((R & ~31) + perm32(R & 31)) : R;
        voffA[i] = (unsigned)(R * K + C) * 2u; voffB[i] = (unsigned)(Rb * K + C) * 2u; }
    const size_t kstep = (size_t)(BK * 2);
    const size_t hstep = (size_t)HALF * K * 2;
    const size_t tstep = 2 * hstep;
    const unsigned ldsw = (unsigned)wid * 1024u;
    const int aoff = lds_byte(wr * 64 + fr, fq * 8), boff = lds_byte(wc * 32 + fr, fq * 8);
#define PG8_SA(b, h) (((b) * 2 + (h)) * HTB)
#define PG8_SB(b, h) ((4 + (b) * 2 + (h)) * HTB)
#define PG8_STAGE(bufoff, gbase, voff) do { _Pragma("unroll") for (int _i = 0; _i < 2; ++_i) \
        __builtin_amdgcn_global_load_lds((const unsigned*)((const char*)(gbase) + (voff)[_i]), (PG8_LAS unsigned*)(lds + (bufoff) + ldsw + _i * 8192), 16, 0, 0); } while (0)
#define PG8_LDA(dst, b, h) do { _Pragma("unroll") for (int m = 0; m < 4; ++m) _Pragma("unroll") for (int k = 0; k < 2; ++k) dst[m][k] = *(const PG8_LAS bf16x8*)(lds + PG8_SA(b, h) + aoff + m * 2048 + k * 1024); } while (0)
#define PG8_LDB(dst, b, h) do { _Pragma("unroll") for (int n = 0; n < 2; ++n) _Pragma("unroll") for (int k = 0; k < 2; ++k) dst[n][k] = *(const PG8_LAS bf16x8*)(lds + PG8_SB(b, h) + boff + n * 2048 + k * 1024); } while (0)
#define PG8_MMA(ai, bj, At, Bt) do { __builtin_amdgcn_s_setprio(1); _Pragma("unroll") for (int m = 0; m < 4; ++m) _Pragma("unroll") for (int n = 0; n < 2; ++n) _Pragma("unroll") for (int k = 0; k < 2; ++k) \
        acc[ai][bj][m][n] = __builtin_amdgcn_mfma_f32_16x16x32_bf16(Bt[n][k], At[m][k], acc[ai][bj][m][n], 0, 0, 0); __builtin_amdgcn_s_setprio(0); } while (0)
#define PG8_WAIT_V(n) asm volatile("s_waitcnt vmcnt(" #n ")" ::: "memory")
#define PG8_WAIT_L(n) asm volatile("s_waitcnt lgkmcnt(" #n ")" ::: "memory")
#define PG8_BAR __builtin_amdgcn_s_barrier()
#define PG8_SCHED __builtin_amdgcn_sched_barrier(0)
    Unit cur, nxt; int ui = 0;
    if (!S.next(0, cur)) return;
    f32x4 acc[2][2][4][2];
#pragma unroll
    for (int a = 0; a < 2; ++a)
#pragma unroll
        for (int b = 0; b < 2; ++b)
#pragma unroll
            for (int m = 0; m < 4; ++m)
#pragma unroll
                for (int n = 0; n < 2; ++n) acc[a][b][m][n] = (f32x4){0.f, 0.f, 0.f, 0.f};
    bf16x8 At[4][2], B0[2][2], B1[2][2];
    const char* cA = (const char*)g.A + (size_t)cur.pm * tstep; const char* cB = (const char*)g.Bt + (size_t)cur.pn * tstep;
    S.a_ready(cur);
    PG8_STAGE(PG8_SB(0, 0), cB, voffB); PG8_STAGE(PG8_SA(0, 0), cA, voffA); PG8_STAGE(PG8_SB(0, 1), cB + hstep, voffB); PG8_STAGE(PG8_SA(0, 1), cA + hstep, voffA);
    if (wr == 1) PG8_BAR;
    PG8_WAIT_V(4); PG8_BAR;
    PG8_STAGE(PG8_SB(1, 0), cB + kstep, voffB); PG8_STAGE(PG8_SA(1, 0), cA + kstep, voffA); PG8_STAGE(PG8_SB(1, 1), cB + hstep + kstep, voffB);
    PG8_WAIT_V(6); PG8_BAR;
    PG8_STAMP();
    for (;;) {
        const bool has_next = S.next(ui + 1, nxt);
        const char* nA = has_next ? (const char*)g.A + (size_t)nxt.pm * tstep : cA; const char* nB = has_next ? (const char*)g.Bt + (size_t)nxt.pn * tstep : cB;
        for (int t = 0; t < nt; t += 2) {
            const bool last = (t == nt - 2);
            const char* a1 = cA + (size_t)(t + 1) * kstep;
            const char* a2 = last ? nA : cA + (size_t)(t + 2) * kstep; const char* b2 = last ? nB : cB + (size_t)(t + 2) * kstep;
            const char* a3 = a2 + kstep; const char* b3 = b2 + kstep;
            if (last && has_next) S.a_ready(nxt);
            PG8_LDB(B0, 0, 0); PG8_SCHED; PG8_LDA(At, 0, 0); PG8_STAGE(PG8_SA(1, 1), a1 + hstep, voffA);
            PG8_WAIT_L(8); PG8_BAR; PG8_WAIT_L(0); PG8_MMA(0, 0, At, B0); PG8_BAR; PG8_SCHED;
            PG8_LDB(B1, 0, 1); PG8_STAGE(PG8_SB(0, 0), b2, voffB);
            PG8_BAR; PG8_WAIT_L(0); PG8_MMA(0, 1, At, B1); PG8_BAR;
            PG8_LDA(At, 0, 1); PG8_STAGE(PG8_SA(0, 0), a2, voffA);
            PG8_BAR; PG8_WAIT_L(0); PG8_MMA(1, 0, At, B0); PG8_BAR; PG8_SCHED;
            PG8_STAGE(PG8_SB(0, 1), b2 + hstep, voffB);
            PG8_WAIT_V(6); PG8_BAR; PG8_MMA(1, 1, At, B1); PG8_BAR;
            PG8_LDB(B0, 1, 0); PG8_SCHED; PG8_LDA(At, 1, 0); PG8_STAGE(PG8_SA(0, 1), a2 + hstep, voffA);
            PG8_WAIT_L(8); PG8_BAR; PG8_WAIT_L(0); PG8_MMA(0, 0, At, B0); PG8_BAR; PG8_SCHED;
            PG8_LDB(B1, 1, 1); PG8_STAGE(PG8_SB(1, 0), b3, voffB);
            PG8_BAR; PG8_WAIT_L(0); PG8_MMA(0, 1, At, B1); PG8_BAR;
            PG8_LDA(At, 1, 1); PG8_STAGE(PG8_SA(1, 0), a3, voffA);
            PG8_BAR; PG8_WAIT_L(0); PG8_MMA(1, 0, At, B0); PG8_BAR; PG8_SCHED;
            PG8_STAGE(PG8_SB(1, 1), b3 + hstep, voffB);
            PG8_WAIT_V(6); PG8_BAR; PG8_MMA(1, 1, At, B1); PG8_BAR;
        }
        PG8_STAMP();
        if constexpr (!Epi::AFTER_DRAIN) { E(acc, cur, wr, wc, fr, fq); S.done(cur); }
        PG8_STAMP();
        if (!has_next) break;
#pragma unroll
        for (int a = 0; a < 2; ++a)
#pragma unroll
            for (int b = 0; b < 2; ++b)
#pragma unroll
                for (int m = 0; m < 4; ++m)
#pragma unroll
                    for (int n = 0; n < 2; ++n) acc[a][b][m][n] = (f32x4){0.f, 0.f, 0.f, 0.f};
        cur = nxt; cA = nA; cB = nB; ++ui;
    }
    PG8_WAIT_V(0);
    if (wr == 0) PG8_BAR;
    PG8_BAR;
    if constexpr (Epi::AFTER_DRAIN) { E.fused(acc, cur, wr, wc, fr, fq, lds, wid, lane); S.done(cur); }
    PG8_STAMP();
    if (STAMP && wid == 0) { stamps[lane] = lane < nts ? (((unsigned long long)(unsigned)ts_hi << 32) | (unsigned)ts_lo) : 0ull;
        if (lane == 62) stamps[62] = rt_entry; if (lane == 63) stamps[63] = (unsigned long long)wall_clock64(); }
#undef PG8_STAMP
#undef PG8_SA
#undef PG8_SB
#undef PG8_STAGE
#undef PG8_LDA
#undef PG8_LDB
#undef PG8_MMA
#undef PG8_WAIT_V
#undef PG8_WAIT_L
#undef PG8_BAR
#undef PG8_SCHED
}
}
using pg8::bf16_t; using pg8::bf16x8; using pg8::f32x4; using pg8::u32x4;
#define LAS __attribute__((address_space(3)))
typedef unsigned u32x2 __attribute__((ext_vector_type(2)));

constexpr int NTOK = 12288, NCTX = 4096;
constexpr int LDS_BYTES = 131072 + 64;
constexpr float LAM_INIT = 0.35550906759f;
constexpr size_t O_YP = 0, O_YS = 4194304, O_NAK = 12582912, O_NAV = 14680064, O_LRU = 16777216, O_DK = 16793600, O_DV = 20987904;

struct Params { const float* in[33]; float* out; unsigned char* ws; };

__device__ __forceinline__ float bf2f(bf16_t v) { return __uint_as_float(((unsigned)v) << 16); }
__device__ __forceinline__ bf16_t f2bf(float f) { unsigned u = __float_as_uint(f); u += 0x7FFFu + ((u >> 16) & 1u); return (bf16_t)(u >> 16); }
__device__ __forceinline__ unsigned pk2(float lo, float hi) { return (unsigned)f2bf(lo) | ((unsigned)f2bf(hi) << 16); }
__device__ __forceinline__ float silu_f(float x) { return x / (1.0f + __expf(-x)); }
__device__ __forceinline__ float sigmoid_f(float x) { return 1.0f / (1.0f + __expf(-x)); }
__device__ __forceinline__ float wave_sum(float v) {
#pragma unroll
    for (int o = 32; o >= 1; o >>= 1) v += __shfl_xor(v, o);
    return v;
}
#define XB_TMO      128
#define XB_XCNT(j)  (256  + 64 * (j))
#define XB_XSUB(j)  (1280 + 64 * (j))
#define XB_XGEN(j)  (2304 + 64 * (j))
#define XB_TOP      3328
#define XB_TOPGEN   3392
#define XCD_BAR_WORDS 3456
#define XB_SPIN_CAP (1u << 18)
#define LAS __attribute__((address_space(3)))
__device__ __forceinline__ unsigned xb_ld(unsigned* p)              { return __hip_atomic_load(p, __ATOMIC_RELAXED, __HIP_MEMORY_SCOPE_AGENT); }
__device__ __forceinline__ unsigned xb_add(unsigned* p, unsigned v) { return __hip_atomic_fetch_add(p, v, __ATOMIC_RELAXED, __HIP_MEMORY_SCOPE_AGENT); }
__device__ __forceinline__ unsigned xb_xcc_id() { return (unsigned)__builtin_amdgcn_s_getreg((3 << 11) | 20) & 0xFu; }
#define XB_SPIN(cond, bar) do { unsigned _sp = 0; while (cond) { __builtin_amdgcn_s_sleep(1); \
    if ((++_sp & 255u) == 0u) { if (xb_ld(&(bar)[XB_TMO])) break; if (_sp > XB_SPIN_CAP) { atomicAdd(&(bar)[XB_TMO], 1u); break; } } } } while (0)

struct XcdBarrier {
    unsigned* bar; unsigned x;
    volatile LAS unsigned* st;
};

__device__ __forceinline__ XcdBarrier xcd_barrier_post(unsigned* bar, volatile LAS unsigned* st) {
    XcdBarrier b; b.bar = bar; b.x = xb_xcc_id(); b.st = st;
    if (threadIdx.x == 0) (void)xb_add(&bar[XB_XCNT(b.x)], 1u);
    return b;
}
__device__ __forceinline__ void xcd_barrier_complete(unsigned* bar, unsigned x, unsigned& nloc, unsigned& nx) {
    const unsigned G = gridDim.x * gridDim.y * gridDim.z;
    unsigned sum, cnt, mine, sp = 0u;
    for (;;) {
        sum = 0u; cnt = 0u; mine = 0u;
#pragma unroll
        for (unsigned j = 0; j < 16; ++j) { const unsigned c = xb_ld(&bar[XB_XCNT(j)]); sum += c; cnt += (c > 0u) ? 1u : 0u; mine = (j == x) ? c : mine; }
        if (sum == G) break;
        __builtin_amdgcn_s_sleep(1);
        if ((++sp & 255u) == 0u) { if (xb_ld(&bar[XB_TMO])) break; if (sp > XB_SPIN_CAP) { atomicAdd(&bar[XB_TMO], 1u); break; } }
    }
    nloc = mine > 0u ? mine : 1u; nx = cnt > 0u ? cnt : 1u;
}

__device__ __forceinline__ void xcd_barrier(const XcdBarrier& b) {
    asm volatile("s_waitcnt vmcnt(0)" ::: "memory");
    __syncthreads();
    if (threadIdx.x == 0) {
        unsigned* bar = b.bar;
        __builtin_amdgcn_s_waitcnt(0);
        unsigned nloc = b.st[0], nx = b.st[1];
        if (nloc == 0u) { xcd_barrier_complete(bar, b.x, nloc, nx); b.st[0] = nloc; b.st[1] = nx; }
        const unsigned old = xb_add(&bar[XB_XSUB(b.x)], 1u);
        const unsigned gen = old / nloc;
        if (old + 1u == (gen + 1u) * nloc) {
            __builtin_amdgcn_fence(__ATOMIC_RELEASE, "agent");
            asm volatile("s_waitcnt vmcnt(0)" ::: "memory");
            const unsigned og = xb_add(&bar[XB_TOP], 1u);
            const unsigned tg = og / nx;
            if (og + 1u == (tg + 1u) * nx) xb_add(&bar[XB_TOPGEN], 1u);
            else XB_SPIN(xb_ld(&bar[XB_TOPGEN]) == tg, bar);
            __builtin_amdgcn_fence(__ATOMIC_ACQUIRE, "agent");
            xb_add(&bar[XB_XGEN(b.x)], 1u);
            asm volatile("s_waitcnt vmcnt(0)" ::: "memory");
        } else {
            XB_SPIN(xb_ld(&bar[XB_XGEN(b.x)]) == gen, bar);
            __builtin_amdgcn_fence(__ATOMIC_ACQUIRE, "agent");
            asm volatile("s_waitcnt vmcnt(0)" ::: "memory");
        }
    }
    __syncthreads();
}
constexpr size_t WS_MOD = 0;
constexpr size_t WS_ROPE = 229376;
constexpr size_t WS_WG = 262144;
constexpr size_t WS_W1T = WS_WG + 262144;
constexpr size_t WS_W2T = WS_W1T + 6291456;
constexpr size_t WS_W3T = WS_W2T + 2097152;
constexpr size_t WS_W4T = WS_W3T + 8388608;
constexpr size_t WS_H = WS_W4T + 2097152;
constexpr size_t WS_HF = WS_H;
constexpr size_t WS_P = WS_H + 25165824;
constexpr size_t WS_Y = WS_P + 50331648;
constexpr size_t WS_K0L = WS_Y + 25165824;
constexpr size_t WS_V0L = WS_K0L + 10485760;
constexpr size_t WS_K0C = WS_V0L + 10485760;
constexpr size_t WS_V0C = WS_K0C + 4194304;
constexpr size_t WS_K1L = WS_V0C + 4194304;
constexpr size_t WS_V1L = WS_K1L + 20971520;
constexpr size_t WS_K1C = WS_V1L + 20971520;
constexpr size_t WS_V1C = WS_K1C + 8388608;
constexpr size_t WS_X1B = WS_K0L;
constexpr size_t WS_X2B = WS_P;
constexpr size_t WS_BAR = WS_V1C + 8388608;
constexpr size_t WS_END = WS_BAR + 16384;

__device__ __forceinline__ void transpose_tile(const float* __restrict__ src, int lds_, bf16_t* __restrict__ dst, int ldd, int r0, int c0, float* sm) {
    const int tid = tidx();
    __syncthreads();
#pragma unroll
    for (int i = 0; i < 2; ++i) {
        const int r = (tid >> 4) + i * 32, c4 = (tid & 15) * 4;
        const float4 v = *(const float4*)(src + (size_t)(r0 + r) * lds_ + c0 + c4);
        sm[r * 65 + c4 + 0] = v.x; sm[r * 65 + c4 + 1] = v.y; sm[r * 65 + c4 + 2] = v.z; sm[r * 65 + c4 + 3] = v.w;
    }
    __syncthreads();
    const int c = tid >> 3, r8 = (tid & 7) * 8;
    u32x4 w;
    w.x = pk2(sm[(r8 + 0) * 65 + c], sm[(r8 + 1) * 65 + c]); w.y = pk2(sm[(r8 + 2) * 65 + c], sm[(r8 + 3) * 65 + c]);
    w.z = pk2(sm[(r8 + 4) * 65 + c], sm[(r8 + 5) * 65 + c]); w.w = pk2(sm[(r8 + 6) * 65 + c], sm[(r8 + 7) * 65 + c]);
    *(u32x4*)(dst + (size_t)(c0 + c) * ldd + r0 + r8) = w;
}

__device__ __forceinline__ void transpose_4tile(const float* __restrict__ src, int lds_, bf16_t* __restrict__ dst, int ldd, int r0, int c0, float* sm) {
    const int tid = tidx();
    float4 v[8];
#pragma unroll
    for (int i = 0; i < 8; ++i) { const int idx = tid + 512 * i, r = idx >> 6, c4 = (idx & 63) * 4; { const f32x4 t4 = __builtin_nontemporal_load((const f32x4*)(src + (size_t)(r0 + r) * lds_ + c0 + c4)); v[i] = make_float4(t4[0], t4[1], t4[2], t4[3]); }     }
    __syncthreads();
#pragma unroll
    for (int i = 0; i < 8; ++i) { const int idx = tid + 512 * i, r = idx >> 6, c4 = (idx & 63) * 4;
        sm[r * 257 + c4 + 0] = v[i].x; sm[r * 257 + c4 + 1] = v[i].y; sm[r * 257 + c4 + 2] = v[i].z; sm[r * 257 + c4 + 3] = v[i].w; }
    __syncthreads();
    const int c = tid >> 1, rh = (tid & 1) * 32;
#pragma unroll
    for (int q = 0; q < 4; ++q) { const int rb = rh + q * 8; u32x4 w;
        w.x = pk2(sm[(rb + 0) * 257 + c], sm[(rb + 1) * 257 + c]); w.y = pk2(sm[(rb + 2) * 257 + c], sm[(rb + 3) * 257 + c]);
        w.z = pk2(sm[(rb + 4) * 257 + c], sm[(rb + 5) * 257 + c]); w.w = pk2(sm[(rb + 6) * 257 + c], sm[(rb + 7) * 257 + c]);
        *(u32x4*)(dst + (size_t)(c0 + c) * ldd + r0 + rb) = w; }
}

constexpr int A1_TOTAL = 192 + 32 + 1;
__device__ __forceinline__ void phaseA(const Params& p, float* sm) {
    const int tid = tidx();
    float* mod = (float*)(p.ws + WS_MOD);
    for (int it = blockIdx.x; it < 192; it += gridDim.x) {
        {
            const int layer = it / 96, col0 = (it % 96) * 32;
            const float* W = p.in[layer ? 23 : 10]; const float* Bv = p.in[layer ? 24 : 11];
            const int col = tid & 31, kp = tid >> 5;
            float wv[32];
#pragma unroll
            for (int u = 0; u < 32; ++u) wv[u] = __builtin_nontemporal_load((const float*)((const char*)W + (unsigned)(((kp * 64 + u) * 3072 + col0 + col) * 4)));
            __syncthreads();
            for (int e = tid; e < 9 * 1024; e += 512) { const float cvv = e < 1024 ? p.in[8][e] : p.in[2][e - 1024]; sm[e] = silu_f(cvv); }
            __syncthreads();
            float acc[9];
#pragma unroll
            for (int v = 0; v < 9; ++v) acc[v] = 0.f;
#pragma unroll
            for (int hb = 0; hb < 2; ++hb) {
                float wn[32];
                if (hb == 0) {
#pragma unroll
                    for (int u = 0; u < 32; ++u) wn[u] = __builtin_nontemporal_load((const float*)((const char*)W + (unsigned)(((kp * 64 + 32 + u) * 3072 + col0 + col) * 4)));
                }
#pragma unroll
                for (int u = 0; u < 32; ++u)
#pragma unroll
                    for (int v = 0; v < 9; ++v) acc[v] += sm[v * 1024 + kp * 64 + hb * 32 + u] * wv[u];
                if (hb == 0) {
#pragma unroll
                    for (int u = 0; u < 32; ++u) wv[u] = wn[u];
                }
            }
            __syncthreads();
#pragma unroll
            for (int v = 0; v < 9; ++v) sm[9216 + (kp * 9 + v) * 32 + col] = acc[v];
            __syncthreads();
            if (tid < 288) { const int v = tid >> 5, c = tid & 31; float s = Bv[col0 + c];
                for (int k2 = 0; k2 < 16; ++k2) s += sm[9216 + (k2 * 9 + v) * 32 + c];
                mod[(layer * 9 + v) * 3072 + col0 + c] = s; }
        }
    }
}
__device__ __forceinline__ void phaseA1b(const Params& p, float* sm) {
    const int tid = tidx();
    for (int it = blockIdx.x; it < A1_TOTAL; it += gridDim.x) {
        int t = it;
        if (t < 192) { transpose_4tile(p.in[12], 3072, (bf16_t*)(p.ws + WS_W1T), 1024, (t / 12) * 64, (t % 12) * 256, sm); continue; }
        t -= 192;
        if (t < 32) {
            const int gate = t >> 4, dn = t & 15;
            transpose_tile(p.in[gate ? 18 : 16] + (size_t)dn * 4096, 64, (bf16_t*)(p.ws + WS_WG) + (size_t)(((dn >> 3) * 2 + gate) * 8 + (dn & 7)) * 4096, 64, 0, 0, sm);
            continue;
        }
        {
            float* rc = (float*)(p.ws + WS_ROPE);
            for (int e = tid; e < 1024; e += 512) { const int pos = e >> 4, i = e & 15; const float inv = powf(10000.0f, -(float)i / 16.0f); const float ang = (float)pos * inv;
                rc[e] = cosf(ang); rc[1024 + e] = sinf(ang); }
        }
    }
}

constexpr int A2_TOTAL = 64 + 64 + 128 + 128 + 64 + 256 + 64;
__device__ __forceinline__ void phaseA2(const Params& p, float* sm, int first, int stride) {
    const int tid = tidx();
    for (int it = first; it < A2_TOTAL; it += stride) {
        int t = it;
        if (t < 384) {
            int which; if (t < 64) which = 0; else if (t < 128) { which = 1; t -= 64; } else if (t < 256) { which = 2; t -= 128; } else { which = 3; t -= 256; }
            const float* src = p.in[which == 0 ? 3 : which == 1 ? 4 : which == 2 ? 6 : 7];
            bf16_t* dst = (bf16_t*)(p.ws + (which == 0 ? WS_K0L : which == 1 ? WS_V0L : which == 2 ? WS_K1L : WS_V1L));
            const int W = which < 2 ? 512 : 1024;
            float4 v[8];
#pragma unroll
            for (int i = 0; i < 8; ++i) { const f32x4 t4 = __builtin_nontemporal_load((const f32x4*)(src + (size_t)t * 16384 + i * 2048 + tid * 4)); v[i] = make_float4(t4[0], t4[1], t4[2], t4[3]); }
            __builtin_amdgcn_sched_barrier(0);
#pragma unroll
            for (int i = 0; i < 8; ++i) { const size_t e = (size_t)t * 16384 + i * 2048 + tid * 4;
                const size_t row = e / W; const int c = (int)(e % W); const size_t b = row >> 8, j = row & 255;
                u32x2 w; w.x = pk2(v[i].x, v[i].y); w.y = pk2(v[i].z, v[i].w);
                *(u32x2*)(dst + (b * 1280 + j) * W + c) = w; }
            continue; }
        t -= 384;
        if (t < 64) { transpose_4tile(p.in[21], 1024, (bf16_t*)(p.ws + WS_W2T), 1024, (t / 4) * 64, (t % 4) * 256, sm); continue; }
        t -= 64;
        if (t < 256) { transpose_4tile(p.in[25], 4096, (bf16_t*)(p.ws + WS_W3T), 1024, (t / 16) * 64, (t % 16) * 256, sm); continue; }
        t -= 256;
        transpose_4tile(p.in[31], 1024, (bf16_t*)(p.ws + WS_W4T), 1024, (t / 4) * 64, (t % 4) * 256, sm);
    }
}

__device__ __forceinline__ void phase_norm(const Params& p, int layer, const float* xa, const float* xb_) {
    const int lane = tidx() & 63, wave = tidx() >> 6;
    const float* g = p.in[layer ? 22 : 9];
    const float* mod = (const float*)(p.ws + WS_MOD) + layer * 9 * 3072;
    bf16_t* H = (bf16_t*)(p.ws + WS_H);
    float4 gg[4];
#pragma unroll
    for (int i = 0; i < 4; ++i) gg[i] = *(const float4*)(g + i * 256 + lane * 4);
    const int stride = gridDim.x * 8;
    for (int row0 = blockIdx.x * 8 + wave; row0 < NTOK; row0 += 3 * stride) {
        float4 v[3][4], sh[3][4], sc[3][4];
#pragma unroll
        for (int k = 0; k < 3; ++k) { const int row = min(row0 + k * stride, NTOK - 1);
            const float* xr = row < NCTX ? xa + (size_t)row * 1024 : xb_ + (size_t)(row - NCTX) * 1024;
            const float* mv = mod + (row < NCTX ? 0 : 1 + ((row - NCTX) >> 10)) * 3072;
#pragma unroll
            for (int i = 0; i < 4; ++i) { { const f32x4 t4 = __builtin_nontemporal_load((const f32x4*)(xr + i * 256 + lane * 4)); v[k][i] = make_float4(t4[0], t4[1], t4[2], t4[3]); } sh[k][i] = *(const float4*)(mv + i * 256 + lane * 4); sc[k][i] = *(const float4*)(mv + 1024 + i * 256 + lane * 4); } }
#pragma unroll
        for (int k = 0; k < 3; ++k) { const int row = row0 + k * stride;
            if (row < NTOK) {
                float ss = 0.f;
#pragma unroll
                for (int i = 0; i < 4; ++i) ss += v[k][i].x * v[k][i].x + v[k][i].y * v[k][i].y + v[k][i].z * v[k][i].z + v[k][i].w * v[k][i].w;
                ss = wave_sum(ss);
                const float rstd = rsqrtf(ss * (1.0f / 1024.0f) + 1e-6f);
#pragma unroll
                for (int i = 0; i < 4; ++i) { u32x2 w;
                    w.x = pk2(v[k][i].x * rstd * gg[i].x * (1.f + sc[k][i].x) + sh[k][i].x, v[k][i].y * rstd * gg[i].y * (1.f + sc[k][i].y) + sh[k][i].y);
                    w.y = pk2(v[k][i].z * rstd * gg[i].z * (1.f + sc[k][i].z) + sh[k][i].z, v[k][i].w * rstd * gg[i].w * (1.f + sc[k][i].w) + sh[k][i].w);
                    *(u32x2*)(H + (size_t)row * 1024 + i * 256 + lane * 4) = w; }
            } }
    }
}

__device__ __forceinline__ void phase_final(const Params& p) {
    const int lane = tidx() & 63, wave = tidx() >> 6;
    const float* g = p.in[32];
    float4 gg[4];
#pragma unroll
    for (int i = 0; i < 4; ++i) gg[i] = *(const float4*)(g + i * 256 + lane * 4);
    const int stride = gridDim.x * 8;
    for (int row0 = blockIdx.x * 8 + wave; row0 < NTOK; row0 += 3 * stride) {
        float4 v[3][4];
#pragma unroll
        for (int k = 0; k < 3; ++k) { const int row = min(row0 + k * stride, NTOK - 1);
#pragma unroll
            for (int i = 0; i < 4; ++i) v[k][i] = *(const float4*)(p.out + (size_t)row * 1024 + i * 256 + lane * 4); }
#pragma unroll
        for (int k = 0; k < 3; ++k) { const int row = row0 + k * stride;
            if (row < NTOK) {
                float ss = 0.f;
#pragma unroll
                for (int i = 0; i < 4; ++i) ss += v[k][i].x * v[k][i].x + v[k][i].y * v[k][i].y + v[k][i].z * v[k][i].z + v[k][i].w * v[k][i].w;
                ss = wave_sum(ss);
                const float rstd = rsqrtf(ss * (1.0f / 1024.0f) + 1e-6f);
#pragma unroll
                for (int i = 0; i < 4; ++i) { float4 o; o.x = v[k][i].x * rstd * gg[i].x; o.y = v[k][i].y * rstd * gg[i].y; o.z = v[k][i].z * rstd * gg[i].z; o.w = v[k][i].w * rstd * gg[i].w;
                    *(float4*)(p.out + (size_t)row * 1024 + i * 256 + lane * 4) = o; }
            } }
    }
}

__device__ __forceinline__ void ld_row16(const bf16_t* r, int lane, float (&x)[16]) {
#pragma unroll
    for (int i = 0; i < 2; ++i) { const u32x4 w = *(const u32x4*)(r + i * 512 + lane * 8);
        x[i * 8 + 0] = __uint_as_float(w.x << 16); x[i * 8 + 1] = __uint_as_float(w.x & 0xffff0000u); x[i * 8 + 2] = __uint_as_float(w.y << 16); x[i * 8 + 3] = __uint_as_float(w.y & 0xffff0000u);
        x[i * 8 + 4] = __uint_as_float(w.z << 16); x[i * 8 + 5] = __uint_as_float(w.z & 0xffff0000u); x[i * 8 + 6] = __uint_as_float(w.w << 16); x[i * 8 + 7] = __uint_as_float(w.w & 0xffff0000u); }
}
__device__ __forceinline__ void ld_vec16(const float* v, int lane, float (&x)[16]) {
#pragma unroll
    for (int i = 0; i < 2; ++i) { const float4 a = *(const float4*)(v + i * 512 + lane * 8), c = *(const float4*)(v + i * 512 + lane * 8 + 4);
        x[i * 8 + 0] = a.x; x[i * 8 + 1] = a.y; x[i * 8 + 2] = a.z; x[i * 8 + 3] = a.w; x[i * 8 + 4] = c.x; x[i * 8 + 5] = c.y; x[i * 8 + 6] = c.z; x[i * 8 + 7] = c.w; }
}
__device__ __forceinline__ void phase_norm16(const Params& p, const bf16_t* X) {
    const int lane = tidx() & 63, wave = tidx() >> 6;
    const float* mod = (const float*)(p.ws + WS_MOD) + 9 * 3072;
    bf16_t* H = (bf16_t*)(p.ws + WS_H);
    float gg[16]; ld_vec16(p.in[22], lane, gg);
    const int stride = gridDim.x * 8;
    for (int row0 = blockIdx.x * 8 + wave; row0 < NTOK; row0 += 3 * stride) {
        u32x4 raw[3][2];
#pragma unroll
        for (int k = 0; k < 3; ++k) { const int row = min(row0 + k * stride, NTOK - 1);
#pragma unroll
            for (int i = 0; i < 2; ++i) raw[k][i] = *(const u32x4*)(X + (size_t)row * 1024 + i * 512 + lane * 8); }
#pragma unroll
        for (int k = 0; k < 3; ++k) { const int row = row0 + k * stride;
            if (row < NTOK) {
                const float* mv = mod + (row < NCTX ? 0 : 1 + ((row - NCTX) >> 10)) * 3072;
                float sh[16], sc[16]; ld_vec16(mv, lane, sh); ld_vec16(mv + 1024, lane, sc);
                float x[16];
#pragma unroll
                for (int i = 0; i < 2; ++i) { const u32x4 w = raw[k][i];
                    x[i * 8 + 0] = __uint_as_float(w.x << 16); x[i * 8 + 1] = __uint_as_float(w.x & 0xffff0000u); x[i * 8 + 2] = __uint_as_float(w.y << 16); x[i * 8 + 3] = __uint_as_float(w.y & 0xffff0000u);
                    x[i * 8 + 4] = __uint_as_float(w.z << 16); x[i * 8 + 5] = __uint_as_float(w.z & 0xffff0000u); x[i * 8 + 6] = __uint_as_float(w.w << 16); x[i * 8 + 7] = __uint_as_float(w.w & 0xffff0000u); }
                float ss = 0.f;
#pragma unroll
                for (int e = 0; e < 16; ++e) ss += x[e] * x[e];
                ss = wave_sum(ss);
                const float rstd = rsqrtf(ss * (1.0f / 1024.0f) + 1e-6f);
#pragma unroll
                for (int i = 0; i < 2; ++i) { u32x4 w; float y[8];
#pragma unroll
                    for (int e = 0; e < 8; ++e) y[e] = x[i * 8 + e] * rstd * gg[i * 8 + e] * (1.f + sc[i * 8 + e]) + sh[i * 8 + e];
                    w.x = pk2(y[0], y[1]); w.y = pk2(y[2], y[3]); w.z = pk2(y[4], y[5]); w.w = pk2(y[6], y[7]);
                    *(u32x4*)(H + (size_t)row * 1024 + i * 512 + lane * 8) = w; }
            } }
    }
}
__device__ __forceinline__ void phase_final16(const Params& p, const bf16_t* X) {
    const int lane = tidx() & 63, wave = tidx() >> 6;
    float gg[16]; ld_vec16(p.in[32], lane, gg);
    const int stride = gridDim.x * 8;
    for (int row0 = blockIdx.x * 8 + wave; row0 < NTOK; row0 += 3 * stride) {
        u32x4 raw[3][2];
#pragma unroll
        for (int k = 0; k < 3; ++k) { const int row = min(row0 + k * stride, NTOK - 1);
#pragma unroll
            for (int i = 0; i < 2; ++i) raw[k][i] = *(const u32x4*)(X + (size_t)row * 1024 + i * 512 + lane * 8); }
#pragma unroll
        for (int k = 0; k < 3; ++k) { const int row = row0 + k * stride;
            if (row < NTOK) {
                float x[16];
#pragma unroll
                for (int i = 0; i < 2; ++i) { const u32x4 w = raw[k][i];
                    x[i * 8 + 0] = __uint_as_float(w.x << 16); x[i * 8 + 1] = __uint_as_float(w.x & 0xffff0000u); x[i * 8 + 2] = __uint_as_float(w.y << 16); x[i * 8 + 3] = __uint_as_float(w.y & 0xffff0000u);
                    x[i * 8 + 4] = __uint_as_float(w.z << 16); x[i * 8 + 5] = __uint_as_float(w.z & 0xffff0000u); x[i * 8 + 6] = __uint_as_float(w.w << 16); x[i * 8 + 7] = __uint_as_float(w.w & 0xffff0000u); }
                float ss = 0.f;
#pragma unroll
                for (int e = 0; e < 16; ++e) ss += x[e] * x[e];
                ss = wave_sum(ss);
                const float rstd = rsqrtf(ss * (1.0f / 1024.0f) + 1e-6f);
                float* yr = p.out + (size_t)row * 1024;
#pragma unroll
                for (int i = 0; i < 2; ++i) {
                    float4 o0, o1;
                    o0.x = x[i * 8 + 0] * rstd * gg[i * 8 + 0]; o0.y = x[i * 8 + 1] * rstd * gg[i * 8 + 1]; o0.z = x[i * 8 + 2] * rstd * gg[i * 8 + 2]; o0.w = x[i * 8 + 3] * rstd * gg[i * 8 + 3];
                    o1.x = x[i * 8 + 4] * rstd * gg[i * 8 + 4]; o1.y = x[i * 8 + 5] * rstd * gg[i * 8 + 5]; o1.z = x[i * 8 + 6] * rstd * gg[i * 8 + 6]; o1.w = x[i * 8 + 7] * rstd * gg[i * 8 + 7];
                    *(float4*)(yr + i * 512 + lane * 8) = o0; *(float4*)(yr + i * 512 + lane * 8 + 4) = o1; }
            } }
    }
}

constexpr float QSCALE = 0.125f * 1.4426950408889634f;
__device__ __forceinline__ u32x2 pk4(const f32x4& v) { u32x2 w; w.x = pg8::cvt_pk_bf16(v[0], v[1]); w.y = pg8::cvt_pk_bf16(v[2], v[3]); return w; }
__device__ __forceinline__ u32x4 pk8(const f32x4& a, const f32x4& b) { u32x4 w; w.x = pg8::cvt_pk_bf16(a[0], a[1]); w.y = pg8::cvt_pk_bf16(a[2], a[3]); w.z = pg8::cvt_pk_bf16(b[0], b[1]); w.w = pg8::cvt_pk_bf16(b[2], b[3]); return w; }

template <bool IN16>
struct EpiRes {
    static constexpr bool PERM = true, AFTER_DRAIN = false;
    const float* xa; const float* xb; const bf16_t* x16; bf16_t* xo; const float* gate;
    __device__ __forceinline__ void operator()(const f32x4 (&acc)[2][2][4][2], const pg8::Unit& u, int wr, int wc, int fr, int fq) const {
        const int row0 = u.pm * 256 + wr * 64 + fr, col0 = u.pn * 256 + wc * 32 + 8 * fq;
        const bool ctx = u.pm < 16;
        const int mi = ctx ? 0 : 1 + ((u.pm - 16) >> 2);
        const float* xbase = (ctx ? xa + (size_t)row0 * 1024 : xb + (size_t)(row0 - NCTX) * 1024) + col0;
        const bf16_t* x16b = x16 + (size_t)row0 * 1024 + col0;
        bf16_t* obase = xo + (size_t)row0 * 1024 + col0;
        f32x4 gv[2][2];
#pragma unroll
        for (int bj = 0; bj < 2; ++bj)
#pragma unroll
            for (int n = 0; n < 2; ++n) gv[bj][n] = *(const f32x4*)(gate + mi * 3072 + col0 + bj * 128 + 4 * n);
#pragma unroll
        for (int ai = 0; ai < 2; ++ai) {
            f32x4 xv[4][2][2];
#pragma unroll
            for (int m = 0; m < 4; ++m)
#pragma unroll
                for (int bj = 0; bj < 2; ++bj) {
                    const size_t off = (size_t)(ai * 128 + m * 16) * 1024 + bj * 128;
                    if (IN16) { const u32x4 w = *(const u32x4*)(x16b + off);
                        xv[m][bj][0] = (f32x4){__uint_as_float(w.x << 16), __uint_as_float(w.x & 0xffff0000u), __uint_as_float(w.y << 16), __uint_as_float(w.y & 0xffff0000u)};
                        xv[m][bj][1] = (f32x4){__uint_as_float(w.z << 16), __uint_as_float(w.z & 0xffff0000u), __uint_as_float(w.w << 16), __uint_as_float(w.w & 0xffff0000u)}; }
                    else { xv[m][bj][0] = __builtin_nontemporal_load((const f32x4*)(xbase + off)); xv[m][bj][1] = __builtin_nontemporal_load((const f32x4*)(xbase + off + 4)); }
                }
            __builtin_amdgcn_sched_barrier(0);
#pragma unroll
            for (int m = 0; m < 4; ++m)
#pragma unroll
                for (int bj = 0; bj < 2; ++bj)
                    *(u32x4*)(obase + (size_t)(ai * 128 + m * 16) * 1024 + bj * 128) = pk8(xv[m][bj][0] + gv[bj][0] * acc[ai][bj][m][0], xv[m][bj][1] + gv[bj][1] * acc[ai][bj][m][1]);
        }
    }
};

struct Epi1 {
    static constexpr bool PERM = true, AFTER_DRAIN = false;
    unsigned char* ws; float* out;
    __device__ __forceinline__ void operator()(const f32x4 (&acc)[2][2][4][2], const pg8::Unit& u, int wr, int wc, int fr, int fq) const {
        const int reg = u.pn >> 1, cb = (u.pn & 1) * 256 + wc * 32 + 8 * fq;
        const bool ctx = u.pm < 16;
        bf16_t* P0 = (bf16_t*)(ws + WS_P);
#pragma unroll
        for (int ai = 0; ai < 2; ++ai)
#pragma unroll
            for (int m = 0; m < 4; ++m) {
                const int row = u.pm * 256 + ai * 128 + wr * 64 + m * 16 + fr;
                const int lt = row - NCTX, b = ctx ? (row >> 8) : (lt >> 10), t = ctx ? (row & 255) : (lt & 1023);
#pragma unroll
                for (int bj = 0; bj < 2; ++bj) {
                    const int c = cb + bj * 128; const f32x4 v0 = acc[ai][bj][m][0], v1 = acc[ai][bj][m][1];
                    if (reg == 0) *(u32x4*)(P0 + (size_t)row * 2048 + c) = pk8(v0 * QSCALE, v1 * QSCALE);
                    else if (reg >= 3) *(u32x4*)(P0 + (size_t)row * 2048 + (reg - 2) * 512 + c) = pk8(v0, v1);
                    else if (reg == 1) {
                        if (ctx) { float* o = out + O_NAK + (size_t)row * 512 + c; *(f32x4*)o = v0; *(f32x4*)(o + 4) = v1;
                            *(u32x4*)((bf16_t*)(ws + WS_K0C) + (size_t)row * 512 + c) = pk8(v0, v1); }
                        else *(u32x4*)((bf16_t*)(ws + WS_K0L) + ((size_t)b * 1280 + 256 + t) * 512 + c) = pk8(v0, v1);
                    } else {
                        if (ctx) { float* o = out + O_NAV + (size_t)row * 512 + c; *(f32x4*)o = v0; *(f32x4*)(o + 4) = v1;
                            *(u32x4*)((bf16_t*)(ws + WS_V0C) + (size_t)row * 512 + c) = pk8(v0, v1); }
                        else *(u32x4*)((bf16_t*)(ws + WS_V0L) + ((size_t)b * 1280 + 256 + t) * 512 + c) = pk8(v0, v1);
                    }
                }
            }
    }
};

struct Epi3 {
    static constexpr bool PERM = true, AFTER_DRAIN = false;
    unsigned char* ws; float* out;
    __device__ __forceinline__ void operator()(const f32x4 (&acc)[2][2][4][2], const pg8::Unit& u, int wr, int wc, int fr, int fq) const {
        const int reg = u.pn >> 2, cb = (u.pn & 3) * 256 + wc * 32 + 8 * fq;
        const bool ctx = u.pm < 16;
        bf16_t* P1 = (bf16_t*)(ws + WS_P);
        const float* rc = (const float*)(ws + WS_ROPE);
        const bool rope = !ctx && reg < 2;
        const float sgn = fq >= 2 ? 1.0f : -1.0f;
#pragma unroll
        for (int ai = 0; ai < 2; ++ai) {
            f32x4 csv[4][2], snv[4][2];
            if (rope) {
#pragma unroll
                for (int m = 0; m < 4; ++m) { const int t = (u.pm * 256 + ai * 128 + wr * 64 + m * 16 + fr - NCTX) & 1023; const int pos = (wc & 1) ? (t & 63) : (t >> 6);
#pragma unroll
                    for (int n = 0; n < 2; ++n) { const int idx = pos * 16 + 8 * (fq & 1) + 4 * n; csv[m][n] = *(const f32x4*)(rc + idx); snv[m][n] = *(const f32x4*)(rc + 1024 + idx); } }
            }
#pragma unroll
            for (int m = 0; m < 4; ++m) {
                const int row = u.pm * 256 + ai * 128 + wr * 64 + m * 16 + fr;
                const int lt = row - NCTX, b = ctx ? (row >> 8) : (lt >> 10), t = ctx ? (row & 255) : (lt & 1023);
#pragma unroll
                for (int bj = 0; bj < 2; ++bj) {
                    f32x4 v0 = acc[ai][bj][m][0], v1 = acc[ai][bj][m][1];
                    if (rope) {
                        f32x4 p0, p1;
#pragma unroll
                        for (int j = 0; j < 4; ++j) { p0[j] = __shfl_xor(v0[j], 32); p1[j] = __shfl_xor(v1[j], 32); }
                        v0 = v0 * csv[m][0] + (p0 * snv[m][0]) * sgn; v1 = v1 * csv[m][1] + (p1 * snv[m][1]) * sgn;
                    }
                    const int c = cb + bj * 128;
                    if (reg == 0) *(u32x4*)(P1 + (size_t)row * 2048 + c) = pk8(v0 * QSCALE, v1 * QSCALE);
                    else if (reg == 3) *(u32x4*)(P1 + (size_t)row * 2048 + 1024 + c) = pk8(v0, v1);
                    else if (reg == 1) {
                        if (ctx) { float* o = out + O_DK + (size_t)row * 1024 + c; *(f32x4*)o = v0; *(f32x4*)(o + 4) = v1;
                            *(u32x4*)((bf16_t*)(ws + WS_K1C) + (size_t)row * 1024 + c) = pk8(v0, v1); }
                        else *(u32x4*)((bf16_t*)(ws + WS_K1L) + ((size_t)b * 1280 + 256 + t) * 1024 + c) = pk8(v0, v1);
                    } else {
                        if (ctx) { float* o = out + O_DV + (size_t)row * 1024 + c; *(f32x4*)o = v0; *(f32x4*)(o + 4) = v1;
                            *(u32x4*)((bf16_t*)(ws + WS_V1C) + (size_t)row * 1024 + c) = pk8(v0, v1); }
                        else *(u32x4*)((bf16_t*)(ws + WS_V1L) + ((size_t)b * 1280 + 256 + t) * 1024 + c) = pk8(v0, v1);
                    }
                }
            }
        }
    }
};
#define MFMA16(a, b, c) __builtin_amdgcn_mfma_f32_16x16x32_bf16(a, b, c, 0, 0, 0)
constexpr float SC_LOG2 = 0.125f * 1.4426950408889634f;
constexpr float LOG2E = 1.4426950408889634f;
constexpr float RS_TAU = 8.0f;
__device__ __forceinline__ float ex2(float x) { return __builtin_amdgcn_exp2f(x); }
__device__ __forceinline__ bf16x8 pack8(const float (&v)[8]) {
    u32x4 w; w.x = pg8::cvt_pk_bf16(v[0], v[1]); w.y = pg8::cvt_pk_bf16(v[2], v[3]); w.z = pg8::cvt_pk_bf16(v[4], v[5]); w.w = pg8::cvt_pk_bf16(v[6], v[7]);
    return __builtin_bit_cast(bf16x8, w);
}
__device__ __forceinline__ bf16x8 cat2(u32x2 a, u32x2 b) { u32x4 w; w.x = a.x; w.y = a.y; w.z = b.x; w.w = b.y; return __builtin_bit_cast(bf16x8, w); }

template <int DK, int DV> struct ACfg {
    static constexpr int KP = DK * 2 + 16, VP = 136;
    static constexpr int KBYTES = 64 * KP, VBYTES = DV * VP, STAGE = KBYTES + VBYTES;
    static constexpr int NK = DK / 64, NV = DV / 64;
};
template <int DK, int DV>
__device__ __forceinline__ void stage_load(const bf16_t* Ksrc, size_t ldk, const bf16_t* Vsrc, size_t ldv, u32x4 (&kr)[DK / 64], u32x4 (&vr)[DV / 64], int tid) {
#pragma unroll
    for (int i = 0; i < DK / 64; ++i) { const int idx = tid + i * 512, row = idx / (DK / 8), pc = idx % (DK / 8); kr[i] = *(const u32x4*)(Ksrc + (size_t)row * ldk + pc * 8); }
#pragma unroll
    for (int i = 0; i < DV / 64; ++i) { const int idx = tid + i * 512, key = idx & 63, pc = idx >> 6; vr[i] = *(const u32x4*)(Vsrc + (size_t)key * ldv + pc * 8); }
}
template <int DK, int DV>
__device__ __forceinline__ void stage_store(LAS unsigned char* base, const u32x4 (&kr)[DK / 64], const u32x4 (&vr)[DV / 64], int tid) {
    typedef ACfg<DK, DV> C;
#pragma unroll
    for (int i = 0; i < DK / 64; ++i) { const int idx = tid + i * 512, row = idx / (DK / 8), pc = idx % (DK / 8); *(LAS u32x4*)(base + row * C::KP + pc * 16) = kr[i]; }
#pragma unroll
    for (int i = 0; i < DV / 64; ++i) { const int idx = tid + i * 512, key = idx & 63, pc = idx >> 6;
        LAS unsigned char* d = base + C::KBYTES + (pc * 8) * C::VP + key * 2;
        *(LAS unsigned short*)(d + 0 * C::VP) = (unsigned short)(vr[i].x & 0xffffu); *(LAS unsigned short*)(d + 1 * C::VP) = (unsigned short)(vr[i].x >> 16);
        *(LAS unsigned short*)(d + 2 * C::VP) = (unsigned short)(vr[i].y & 0xffffu); *(LAS unsigned short*)(d + 3 * C::VP) = (unsigned short)(vr[i].y >> 16);
        *(LAS unsigned short*)(d + 4 * C::VP) = (unsigned short)(vr[i].z & 0xffffu); *(LAS unsigned short*)(d + 5 * C::VP) = (unsigned short)(vr[i].z >> 16);
        *(LAS unsigned short*)(d + 6 * C::VP) = (unsigned short)(vr[i].w & 0xffffu); *(LAS unsigned short*)(d + 7 * C::VP) = (unsigned short)(vr[i].w >> 16); }
}

struct St1 { f32x4 O[4]; float m, l; };
template <bool BIAS>
__device__ __forceinline__ void chunk1(const LAS unsigned char* kt, const LAS unsigned char* vt, int fr, int fq, const bf16x8 (&qf)[2], St1& st, const float (&bias)[8]) {
    typedef ACfg<64, 64> C;
    const LAS unsigned char* kl = kt + fr * C::KP + fq * 16;
    const LAS unsigned char* vl = vt + fr * C::VP + fq * 8;
    const bf16x8 k00 = *(const LAS bf16x8*)(kl), k01 = *(const LAS bf16x8*)(kl + 64), k10 = *(const LAS bf16x8*)(kl + 16 * C::KP), k11 = *(const LAS bf16x8*)(kl + 16 * C::KP + 64);
    u32x2 va[4], vb[4];
#pragma unroll
    for (int db = 0; db < 4; ++db) { va[db] = *(const LAS u32x2*)(vl + db * 16 * C::VP); vb[db] = *(const LAS u32x2*)(vl + db * 16 * C::VP + 32); }
    f32x4 s0 = {0.f, 0.f, 0.f, 0.f}, s1 = {0.f, 0.f, 0.f, 0.f};
    s0 = MFMA16(k00, qf[0], s0); s0 = MFMA16(k01, qf[1], s0); s1 = MFMA16(k10, qf[0], s1); s1 = MFMA16(k11, qf[1], s1);
    float sv[8];
#pragma unroll
    for (int j = 0; j < 4; ++j) { sv[j] = s0[j]; sv[4 + j] = s1[j]; }
    if (BIAS) {
#pragma unroll
        for (int i = 0; i < 8; ++i) sv[i] += bias[i];
    }
    float cm = fmaxf(fmaxf(fmaxf(sv[0], sv[1]), fmaxf(sv[2], sv[3])), fmaxf(fmaxf(sv[4], sv[5]), fmaxf(sv[6], sv[7])));
    cm = fmaxf(cm, __shfl_xor(cm, 16)); cm = fmaxf(cm, __shfl_xor(cm, 32));
    float mn = st.m;
    if (__builtin_amdgcn_ballot_w64(cm > st.m + RS_TAU)) {
        mn = fmaxf(st.m, cm);
        const float al = ex2(st.m - mn);
        st.l *= al;
#pragma unroll
        for (int db = 0; db < 4; ++db) st.O[db] *= al;
        st.m = mn;
    }
    float ps = 0.f;
#pragma unroll
    for (int i = 0; i < 8; ++i) { sv[i] = ex2(sv[i] - mn); ps += sv[i]; }
    st.l += ps;
    const bf16x8 pf = pack8(sv);
#pragma unroll
    for (int db = 0; db < 4; ++db) st.O[db] = MFMA16(cat2(va[db], vb[db]), pf, st.O[db]);
}

struct St2 { f32x4 O1[8], O2[8]; float m1, l1, m2, l2; };
__device__ __forceinline__ void qk_sm2(const LAS unsigned char* kt, int fr, int fq, const bf16x8 (&qf)[4], St2& st, bf16x8 (&pf1)[2], bf16x8 (&pf2)[2]) {
    typedef ACfg<128, 128> C;
    const LAS unsigned char* kl = kt + fr * C::KP + fq * 16;
    f32x4 a[4], b[4];
#pragma unroll
    for (int kh = 0; kh < 2; ++kh) {
        bf16x8 kf[2][4];
#pragma unroll
        for (int k2 = 0; k2 < 2; ++k2)
#pragma unroll
            for (int i = 0; i < 4; ++i) kf[k2][i] = *(const LAS bf16x8*)(kl + (kh * 2 + k2) * 16 * C::KP + i * 64);
        __builtin_amdgcn_sched_barrier(0);
#pragma unroll
        for (int k2 = 0; k2 < 2; ++k2) { const int kb = kh * 2 + k2;
            a[kb] = (f32x4){0.f, 0.f, 0.f, 0.f}; b[kb] = (f32x4){0.f, 0.f, 0.f, 0.f};
            a[kb] = MFMA16(kf[k2][0], qf[0], a[kb]); a[kb] = MFMA16(kf[k2][1], qf[1], a[kb]);
            b[kb] = MFMA16(kf[k2][2], qf[2], b[kb]); b[kb] = MFMA16(kf[k2][3], qf[3], b[kb]); }
    }
    float c1 = fmaxf(fmaxf(a[0][0], a[0][1]), fmaxf(a[0][2], a[0][3])), c2 = fmaxf(fmaxf(b[0][0], b[0][1]), fmaxf(b[0][2], b[0][3]));
#pragma unroll
    for (int kb = 1; kb < 4; ++kb) { c1 = fmaxf(c1, fmaxf(fmaxf(a[kb][0], a[kb][1]), fmaxf(a[kb][2], a[kb][3]))); c2 = fmaxf(c2, fmaxf(fmaxf(b[kb][0], b[kb][1]), fmaxf(b[kb][2], b[kb][3]))); }
    c1 = fmaxf(c1, __shfl_xor(c1, 16)); c1 = fmaxf(c1, __shfl_xor(c1, 32));
    c2 = fmaxf(c2, __shfl_xor(c2, 16)); c2 = fmaxf(c2, __shfl_xor(c2, 32));
    float n1 = st.m1, n2 = st.m2;
    const bool grow = (c1 > st.m1 + RS_TAU) || (c2 > st.m2 + RS_TAU);
    if (__builtin_amdgcn_ballot_w64(grow)) {
        n1 = fmaxf(st.m1, c1); n2 = fmaxf(st.m2, c2);
        const float al1 = ex2(st.m1 - n1), al2 = ex2(st.m2 - n2);
        st.l1 *= al1; st.l2 *= al2;
#pragma unroll
        for (int db = 0; db < 8; ++db) { st.O1[db] *= al1; st.O2[db] *= al2; }
        st.m1 = n1; st.m2 = n2;
    }
    float p1 = 0.f, p2 = 0.f;
#pragma unroll
    for (int hf = 0; hf < 2; ++hf) {
        float e1[8], e2[8];
#pragma unroll
        for (int j = 0; j < 4; ++j) { e1[j] = ex2(a[2 * hf][j] - n1); e1[4 + j] = ex2(a[2 * hf + 1][j] - n1); e2[j] = ex2(b[2 * hf][j] - n2); e2[4 + j] = ex2(b[2 * hf + 1][j] - n2); }
#pragma unroll
        for (int i = 0; i < 8; ++i) { p1 += e1[i]; p2 += e2[i]; }
        pf1[hf] = pack8(e1); pf2[hf] = pack8(e2);
    }
    st.l1 += p1; st.l2 += p2;
}
__device__ __forceinline__ void pv2(const LAS unsigned char* vt, int fr, int fq, const bf16x8 (&pf1)[2], const bf16x8 (&pf2)[2], St2& st) {
    typedef ACfg<128, 128> C;
    const LAS unsigned char* vl = vt + fr * C::VP + fq * 8;
#pragma unroll
    for (int dg = 0; dg < 2; ++dg) {
        u32x2 va[4][2], vb[4][2];
#pragma unroll
        for (int d4 = 0; d4 < 4; ++d4)
#pragma unroll
            for (int hf = 0; hf < 2; ++hf) { va[d4][hf] = *(const LAS u32x2*)(vl + (dg * 4 + d4) * 16 * C::VP + hf * 64); vb[d4][hf] = *(const LAS u32x2*)(vl + (dg * 4 + d4) * 16 * C::VP + hf * 64 + 32); }
        __builtin_amdgcn_sched_barrier(0);
#pragma unroll
        for (int d4 = 0; d4 < 4; ++d4)
#pragma unroll
            for (int hf = 0; hf < 2; ++hf) { const int db = dg * 4 + d4; const bf16x8 vf = cat2(va[d4][hf], vb[d4][hf]);
                st.O1[db] = MFMA16(vf, pf1[hf], st.O1[db]);
                st.O2[db] = MFMA16(vf, pf2[hf], st.O2[db]); }
    }
}

__device__ __forceinline__ void step1(const LAS unsigned char* kt, const LAS unsigned char* vt, int fr, int fq, const bf16x8 (&qf)[2], St1& st) {
    typedef ACfg<64, 64> C;
    const LAS unsigned char* kl = kt + fr * C::KP + fq * 16;
    const LAS unsigned char* vl = vt + fr * C::VP + fq * 8;
    f32x4 a[4];
    {
        bf16x8 kf[4][2];
#pragma unroll
        for (int kb = 0; kb < 4; ++kb) { kf[kb][0] = *(const LAS bf16x8*)(kl + kb * 16 * C::KP); kf[kb][1] = *(const LAS bf16x8*)(kl + kb * 16 * C::KP + 64); }
        __builtin_amdgcn_sched_barrier(0);
#pragma unroll
        for (int kb = 0; kb < 4; ++kb) { a[kb] = (f32x4){0.f, 0.f, 0.f, 0.f}; a[kb] = MFMA16(kf[kb][0], qf[0], a[kb]); a[kb] = MFMA16(kf[kb][1], qf[1], a[kb]); }
    }
    float c1 = fmaxf(fmaxf(a[0][0], a[0][1]), fmaxf(a[0][2], a[0][3]));
#pragma unroll
    for (int kb = 1; kb < 4; ++kb) c1 = fmaxf(c1, fmaxf(fmaxf(a[kb][0], a[kb][1]), fmaxf(a[kb][2], a[kb][3])));
    c1 = fmaxf(c1, __shfl_xor(c1, 16)); c1 = fmaxf(c1, __shfl_xor(c1, 32));
    float n1 = st.m;
    if (__builtin_amdgcn_ballot_w64(c1 > st.m + RS_TAU)) {
        n1 = fmaxf(st.m, c1);
        const float al = ex2(st.m - n1);
        st.l *= al;
#pragma unroll
        for (int db = 0; db < 4; ++db) st.O[db] *= al;
        st.m = n1;
    }
    float p1 = 0.f;
    bf16x8 pf[2];
#pragma unroll
    for (int hf = 0; hf < 2; ++hf) {
        float e1[8];
#pragma unroll
        for (int j = 0; j < 4; ++j) { e1[j] = ex2(a[2 * hf][j] - n1); e1[4 + j] = ex2(a[2 * hf + 1][j] - n1); }
#pragma unroll
        for (int i = 0; i < 8; ++i) p1 += e1[i];
        pf[hf] = pack8(e1);
    }
    st.l += p1;
    {
        u32x2 va[4][2], vb[4][2];
#pragma unroll
        for (int db = 0; db < 4; ++db)
#pragma unroll
            for (int hf = 0; hf < 2; ++hf) { va[db][hf] = *(const LAS u32x2*)(vl + db * 16 * C::VP + hf * 64); vb[db][hf] = *(const LAS u32x2*)(vl + db * 16 * C::VP + hf * 64 + 32); }
        __builtin_amdgcn_sched_barrier(0);
#pragma unroll
        for (int db = 0; db < 4; ++db)
#pragma unroll
            for (int hf = 0; hf < 2; ++hf) st.O[db] = MFMA16(cat2(va[db][hf], vb[db][hf]), pf[hf], st.O[db]);
    }
}

constexpr int A0_RPB_OFF = 36864;
__device__ __forceinline__ void attn0_item(const Params& p, int item, LAS unsigned char* lds) {
    typedef ACfg<64, 64> C;
    const int tid = tidx(), lane = tid & 63, w = tid >> 6, fr = lane & 15, fq = lane >> 4;
    const bf16_t* P0 = (const bf16_t*)(p.ws + WS_P);
    bf16_t* Y = (bf16_t*)(p.ws + WS_Y);
    St1 st;
#pragma unroll
    for (int db = 0; db < 4; ++db) st.O[db] = (f32x4){0.f, 0.f, 0.f, 0.f};
    st.m = -1e30f; st.l = 0.f;
    bf16x8 qf[2]; int tok, h;
    float bias[8];
#pragma unroll
    for (int i = 0; i < 8; ++i) bias[i] = 0.f;
    const bf16_t* K; const bf16_t* V; size_t ldv; int nsteps, nwin, rs0, r = 0, rs = 0, span0 = 0, qc = 0, cs = 0;
    LAS float* rpbs = (LAS float*)(lds + A0_RPB_OFF);
    __syncthreads();
    if (item < 512) {
        const int b = item >> 6; h = (item >> 3) & 7; const int rp = item & 7;
        r = 2 * rp + (w >> 2); const int cq = w & 3, c0 = cq * 16;
        tok = NCTX + b * 1024 + r * 64 + c0 + fr;
        span0 = cq == 0 ? 0 : (cq == 1 ? 8 : (cq == 2 ? 24 : 32));
        rs = min(max(r - 4, 0), 8); qc = c0 + fr; cs = min(max(qc - 8, 0), 48);
        rs0 = min(max(2 * rp - 4, 0), 8); const int rs1 = min(max(2 * rp - 3, 0), 8); nwin = 8 + rs1 - rs0; nsteps = nwin + 4;
        K = (const bf16_t*)(p.ws + WS_K0L) + (size_t)b * 1280 * 512 + h * 64;
        V = (const bf16_t*)(p.ws + WS_V0L) + (size_t)b * 1280 * 512 + h * 64; ldv = 512;
        if (tid < 465) rpbs[tid] = p.in[13][h * 465 + tid] * LOG2E;
    } else {
        const int it = item - 512; const int b = it >> 4; h = (it >> 1) & 7; const int qb = it & 1;
        tok = b * 256 + qb * 128 + w * 16 + fr;
        nwin = 0; nsteps = 4; rs0 = 0;
        K = (const bf16_t*)(p.ws + WS_K0C) + (size_t)b * 256 * 512 + h * 64;
        V = (const bf16_t*)(p.ws + WS_V0C) + (size_t)b * 256 * 512 + h * 64; ldv = 512;
    }
    qf[0] = *(const bf16x8*)(P0 + (size_t)tok * 2048 + h * 64 + fq * 8); qf[1] = *(const bf16x8*)(P0 + (size_t)tok * 2048 + h * 64 + 32 + fq * 8);
    u32x2 gwv[4];
#pragma unroll
    for (int db = 0; db < 4; ++db) gwv[db] = *(const u32x2*)(P0 + (size_t)tok * 2048 + 512 + h * 64 + db * 16 + fq * 4);
#define A0_KEY0(s) ((s) < nwin ? 256 + (rs0 + (s)) * 64 : ((s) - nwin) * 64)
#define A0_LOAD(s, KR, VR) do { const int _k0 = A0_KEY0(s); stage_load<64, 64>(K + (size_t)_k0 * 512, 512, V + (size_t)_k0 * 512, ldv, KR, VR, tid); } while (0)
#define A0_COMPUTE(s, cur) do { \
        if ((s) < nwin) { const int krow = rs0 + (s); \
            if (krow >= rs && krow < rs + 8) { const LAS float* rb = rpbs + (krow - r + 7) * 31; \
                _Pragma("unroll") for (int i = 0; i < 8; ++i) { const int kc = span0 + (i >> 2) * 16 + fq * 4 + (i & 3); \
                    const bool ok = kc >= cs && kc < cs + 16; const int dc = min(max(kc - qc + 15, 0), 30); bias[i] = ok ? rb[dc] : -1e30f; } \
                chunk1<true>((cur) + span0 * C::KP, (cur) + C::KBYTES + span0 * 2, fr, fq, qf, st, bias); } \
        } else step1((cur), (cur) + C::KBYTES, fr, fq, qf, st); } while (0)
    u32x4 krA[1], vrA[1], krB[1], vrB[1];
    A0_LOAD(0, krA, vrA);
    A0_LOAD(1, krB, vrB);
    stage_store<64, 64>(lds, krA, vrA, tid);
    __syncthreads();
    for (int s = 0; s < nsteps; s += 2) {
        if (s + 2 < nsteps) A0_LOAD(s + 2, krA, vrA);
        A0_COMPUTE(s, lds);
        if (s + 1 < nsteps) stage_store<64, 64>(lds + C::STAGE, krB, vrB, tid);
        __syncthreads();
        if (s + 1 >= nsteps) break;
        if (s + 3 < nsteps) A0_LOAD(s + 3, krB, vrB);
        A0_COMPUTE(s + 1, lds + C::STAGE);
        if (s + 2 < nsteps) stage_store<64, 64>(lds, krA, vrA, tid);
        __syncthreads();
    }
#undef A0_KEY0
#undef A0_LOAD
#undef A0_COMPUTE
    float l = st.l; l += __shfl_xor(l, 16); l += __shfl_xor(l, 32);
    const float il = 1.0f / l;
#pragma unroll
    for (int db = 0; db < 4; ++db) {
        const int d = db * 16 + fq * 4;
        const u32x2 gw = gwv[db];
        f32x4 o;
        o[0] = st.O[db][0] * il * silu_f(__uint_as_float(gw.x << 16)); o[1] = st.O[db][1] * il * silu_f(__uint_as_float(gw.x & 0xffff0000u));
        o[2] = st.O[db][2] * il * silu_f(__uint_as_float(gw.y << 16)); o[3] = st.O[db][3] * il * silu_f(__uint_as_float(gw.y & 0xffff0000u));
        *(u32x2*)(Y + (size_t)tok * 1024 + h * 64 + d) = pk4(o);
    }
}

__device__ __forceinline__ void attn1_item(const Params& p, int item, float lam, LAS unsigned char* lds) {
    typedef ACfg<128, 128> C;
    const int tid = tidx(), lane = tid & 63, w = tid >> 6, fr = lane & 15, fq = lane >> 4;
    const bf16_t* P1 = (const bf16_t*)(p.ws + WS_P);
    bf16_t* Y = (bf16_t*)(p.ws + WS_Y);
    St2 st;
#pragma unroll
    for (int db = 0; db < 8; ++db) { st.O1[db] = (f32x4){0.f, 0.f, 0.f, 0.f}; st.O2[db] = (f32x4){0.f, 0.f, 0.f, 0.f}; }
    st.m1 = -1e30f; st.l1 = 0.f; st.m2 = -1e30f; st.l2 = 0.f;
    int tok, h, nst; const bf16_t* K; const bf16_t* V; size_t ldv;
    if (item < 512) {
        const int b = item >> 6; h = (item >> 3) & 7; const int qb = item & 7;
        tok = NCTX + b * 1024 + qb * 128 + w * 16 + fr; nst = 20;
        K = (const bf16_t*)(p.ws + WS_K1L) + (size_t)b * 1280 * 1024 + h * 128;
        V = (const bf16_t*)(p.ws + WS_V1L) + (size_t)b * 1280 * 1024 + h * 128; ldv = 1024;
    } else {
        const int it = item - 512; const int b = it >> 4; h = (it >> 1) & 7; const int qb = it & 1;
        tok = b * 256 + qb * 128 + w * 16 + fr; nst = 4;
        K = (const bf16_t*)(p.ws + WS_K1C) + (size_t)b * 256 * 1024 + h * 128;
        V = (const bf16_t*)(p.ws + WS_V1C) + (size_t)b * 256 * 1024 + h * 128; ldv = 1024;
    }
    bf16x8 qf[4];
#pragma unroll
    for (int i = 0; i < 4; ++i) qf[i] = *(const bf16x8*)(P1 + (size_t)tok * 2048 + h * 128 + i * 32 + fq * 8);
    u32x2 gwv[8];
#pragma unroll
    for (int db = 0; db < 8; ++db) gwv[db] = *(const u32x2*)(P1 + (size_t)tok * 2048 + 1024 + h * 128 + db * 16 + fq * 4);
    u32x4 kr[2], vr[2];
    bf16x8 pf1[2], pf2[2];
    const bool late = w >= 4;
    __syncthreads();
    stage_load<128, 128>(K, 1024, V, ldv, kr, vr, tid); stage_store<128, 128>(lds, kr, vr, tid);
    __syncthreads();
    int bc = 0, bp = 2;
    if (late) __builtin_amdgcn_s_setprio(1);
    for (int s = 0; s < nst; ++s) {
        LAS unsigned char* cur = lds + bc * C::STAGE;
        const int bn = bc == 2 ? 0 : bc + 1;
        if (s + 1 < nst) stage_load<128, 128>(K + (size_t)(s + 1) * 64 * 1024, 1024, V + (size_t)(s + 1) * 64 * 1024, ldv, kr, vr, tid);
        if (late) {
            if (s > 0) pv2(lds + bp * C::STAGE + C::KBYTES, fr, fq, pf1, pf2, st);
            qk_sm2(cur, fr, fq, qf, st, pf1, pf2);
        } else {
            qk_sm2(cur, fr, fq, qf, st, pf1, pf2);
            pv2(cur + C::KBYTES, fr, fq, pf1, pf2, st);
        }
        if (s + 1 < nst) stage_store<128, 128>(lds + bn * C::STAGE, kr, vr, tid);
        __syncthreads();
        bp = bc; bc = bn;
    }
    if (late) pv2(lds + bp * C::STAGE + C::KBYTES, fr, fq, pf1, pf2, st);
    __builtin_amdgcn_s_setprio(0);
    float l1 = st.l1; l1 += __shfl_xor(l1, 16); l1 += __shfl_xor(l1, 32);
    float l2 = st.l2; l2 += __shfl_xor(l2, 16); l2 += __shfl_xor(l2, 32);
    const float i1 = 1.0f / l1, i2 = lam / l2;
    float ss = 0.f;
#pragma unroll
    for (int db = 0; db < 8; ++db) { st.O1[db] = st.O1[db] * i1 - st.O2[db] * i2;
        ss += st.O1[db][0] * st.O1[db][0] + st.O1[db][1] * st.O1[db][1] + st.O1[db][2] * st.O1[db][2] + st.O1[db][3] * st.O1[db][3]; }
    ss += __shfl_xor(ss, 16); ss += __shfl_xor(ss, 32);
    const float rstd = rsqrtf(ss * (1.0f / 128.0f) + 1e-6f) * (1.0f - LAM_INIT);
    f32x4 sgv[8];
#pragma unroll
    for (int db = 0; db < 8; ++db) sgv[db] = *(const f32x4*)(p.in[30] + db * 16 + fq * 4);
    __builtin_amdgcn_sched_barrier(0);
#pragma unroll
    for (int db = 0; db < 8; ++db) {
        const int d = db * 16 + fq * 4;
        const u32x2 gw = gwv[db];
        const f32x4 sg = sgv[db];
        f32x4 o;
        o[0] = st.O1[db][0] * rstd * sg[0] * silu_f(__uint_as_float(gw.x << 16)); o[1] = st.O1[db][1] * rstd * sg[1] * silu_f(__uint_as_float(gw.x & 0xffff0000u));
        o[2] = st.O1[db][2] * rstd * sg[2] * silu_f(__uint_as_float(gw.y << 16)); o[3] = st.O1[db][3] * rstd * sg[3] * silu_f(__uint_as_float(gw.y & 0xffff0000u));
        *(u32x2*)(Y + (size_t)tok * 1024 + h * 128 + d) = pk4(o);
    }
}
__device__ __forceinline__ float sigm(float x) { return __builtin_amdgcn_rcpf(1.0f + ex2(-LOG2E * x)); }
__device__ __forceinline__ void lru_item(const Params& p, int item, float* sm) {
    const int tid = tidx(), lane = tid & 63, w = tid >> 6, fr = lane & 15, fq = lane >> 4;
    int s, n; if (item < 64) { s = 16 + (item >> 3); n = item & 7; } else { s = (item - 64) >> 3; n = (item - 64) & 7; }
    const bool lat = s >= 16;
    const int T = lat ? 1024 : 256, tok0 = lat ? NCTX + (s - 16) * 1024 : s * 256, nchunk = T >> 8;
    const bf16_t* P0 = (const bf16_t*)(p.ws + WS_P); bf16_t* Y = (bf16_t*)(p.ws + WS_Y); float* Hf = (float*)(p.ws + WS_HF);
    const bf16_t* Wg = (const bf16_t*)(p.ws + WS_WG);
    float* xcs = sm; float* seg = sm + 256 * 68;
    const int cg8 = (tid & 7) * 8, q0 = tid >> 3;
    for (int dir = 0; dir < 2; ++dir) {
        float ba[4], bx[4], nl[4], carry[4];
#pragma unroll
        for (int dt = 0; dt < 4; ++dt) { const int ch = n * 64 + dt * 16 + fr;
            ba[dt] = p.in[17][dir * 512 + ch]; bx[dt] = p.in[19][dir * 512 + ch]; nl[dt] = -8.0f * LOG2E * log1pf(__expf(-p.in[20][dir * 512 + ch]));
            carry[dt] = lat ? p.in[5][((s - 16) * 2 + dir) * 512 + ch] : 0.f;
        }
        for (int ck = 0; ck < nchunk; ++ck) {
            __syncthreads();
            {
                float cw[4][8], cbv[8];
#pragma unroll
                for (int j = 0; j < 4; ++j) { const f32x4 a = *(const f32x4*)(p.in[14] + j * 512 + n * 64 + cg8), b = *(const f32x4*)(p.in[14] + j * 512 + n * 64 + cg8 + 4);
#pragma unroll
                    for (int k = 0; k < 4; ++k) { cw[j][k] = a[k]; cw[j][4 + k] = b[k]; } }
                { const f32x4 a = *(const f32x4*)(p.in[15] + n * 64 + cg8), b = *(const f32x4*)(p.in[15] + n * 64 + cg8 + 4);
#pragma unroll
                    for (int k = 0; k < 4; ++k) { cbv[k] = a[k]; cbv[4 + k] = b[k]; } }
                u32x4 wv[4][4];
#pragma unroll
                for (int i = 0; i < 4; ++i) {
                    const int q = q0 + 64 * i, pp = ck * 256 + q, t = dir ? T - 1 - pp : pp;
#pragma unroll
                    for (int j = 0; j < 4; ++j) { const int tt = min(max(t - 2 + j, 0), T - 1);
                        wv[i][j] = *(const u32x4*)(P0 + (size_t)(tok0 + tt) * 2048 + 1024 + n * 64 + cg8); }
                }
#pragma unroll
                for (int i = 0; i < 4; ++i) {
                    const int q = q0 + 64 * i, pp = ck * 256 + q, t = dir ? T - 1 - pp : pp;
                    float xc[8];
#pragma unroll
                    for (int k = 0; k < 8; ++k) xc[k] = cbv[k];
#pragma unroll
                    for (int j = 0; j < 4; ++j) { const int tt = t - 2 + j; const float ok = (tt >= 0 && tt < T) ? 1.0f : 0.0f; const u32x4 w4 = wv[i][j];
                        xc[0] += ok * cw[j][0] * __uint_as_float(w4.x << 16); xc[1] += ok * cw[j][1] * __uint_as_float(w4.x & 0xffff0000u);
                        xc[2] += ok * cw[j][2] * __uint_as_float(w4.y << 16); xc[3] += ok * cw[j][3] * __uint_as_float(w4.y & 0xffff0000u);
                        xc[4] += ok * cw[j][4] * __uint_as_float(w4.z << 16); xc[5] += ok * cw[j][5] * __uint_as_float(w4.z & 0xffff0000u);
                        xc[6] += ok * cw[j][6] * __uint_as_float(w4.w << 16); xc[7] += ok * cw[j][7] * __uint_as_float(w4.w & 0xffff0000u); }
                    *(f32x4*)(xcs + q * 68 + cg8) = (f32x4){xc[0], xc[1], xc[2], xc[3]};
                    *(f32x4*)(xcs + q * 68 + cg8 + 4) = (f32x4){xc[4], xc[5], xc[6], xc[7]};
                }
            }
            bf16x8 wfa[2][2], wfx[2][2];
#define LRU_WF(dt_, sl_) do { _Pragma("unroll") for (int ks = 0; ks < 2; ++ks) { \
                wfa[sl_][ks] = *(const bf16x8*)(Wg + (size_t)((((dir * 2 + 0) * 8 + n) * 64) + (dt_) * 16 + fr) * 64 + ks * 32 + fq * 8); \
                wfx[sl_][ks] = *(const bf16x8*)(Wg + (size_t)((((dir * 2 + 1) * 8 + n) * 64) + (dt_) * 16 + fr) * 64 + ks * 32 + fq * 8); } } while (0)
            LRU_WF(0, 0);
            __syncthreads();
            bf16x8 af[2][2];
#pragma unroll
            for (int tt = 0; tt < 2; ++tt)
#pragma unroll
                for (int ks = 0; ks < 2; ++ks) { const float* src = xcs + (w * 32 + tt * 16 + fr) * 68 + ks * 32 + fq * 8;
                    const f32x4 x0 = *(const f32x4*)src, x1 = *(const f32x4*)(src + 4);
                    const float v[8] = {x0[0], x0[1], x0[2], x0[3], x1[0], x1[1], x1[2], x1[3]};
                    af[tt][ks] = pack8(v); }
            float hl[2][4][4], ap[2][4][4], Aex[2][4], Hex[2][4];
#pragma unroll
            for (int dt = 0; dt < 4; ++dt) {
                float At0 = 1.f, Ht0 = 0.f;
                if (dt < 3) LRU_WF(dt + 1, (dt + 1) & 1);
#pragma unroll
                for (int tt = 0; tt < 2; ++tt) {
                    f32x4 ca = {0.f, 0.f, 0.f, 0.f}, cx = {0.f, 0.f, 0.f, 0.f};
#pragma unroll
                    for (int ks = 0; ks < 2; ++ks) { ca = MFMA16(af[tt][ks], wfa[dt & 1][ks], ca); cx = MFMA16(af[tt][ks], wfx[dt & 1][ks], cx); }
                    float h = 0.f, A = 1.f;
#pragma unroll
                    for (int j = 0; j < 4; ++j) {
                        const float xcv = xcs[(w * 32 + tt * 16 + fq * 4 + j) * 68 + dt * 16 + fr];
                        const float rr = sigm(ca[j] + ba[dt]), ii = sigm(cx[j] + bx[dt]);
                        const float a = ex2(rr * nl[dt]), uu = __builtin_amdgcn_sqrtf(fmaxf(1.0f - a * a, 0.f)) * (ii * xcv);
                        h = a * h + uu; A *= a; hl[tt][dt][j] = h; ap[tt][dt][j] = A;
                    }
                    { const float A1 = __shfl_up(A, 16), H1 = __shfl_up(h, 16); if (fq >= 1) { h = A * H1 + h; A = A * A1; } }
                    { const float A2 = __shfl_up(A, 32), H2 = __shfl_up(h, 32); if (fq >= 2) { h = A * H2 + h; A = A * A2; } }
                    float Ae = __shfl_up(A, 16), He = __shfl_up(h, 16); if (fq == 0) { Ae = 1.f; He = 0.f; }
                    const float At = __shfl(A, 48 + fr), Ht = __shfl(h, 48 + fr);
                    if (tt == 0) { Aex[0][dt] = Ae; Hex[0][dt] = He; At0 = At; Ht0 = Ht; }
                    else { Aex[1][dt] = At0 * Ae; Hex[1][dt] = Ae * Ht0 + He;
                        if (fq == 0) { seg[(w * 64 + dt * 16 + fr) * 2] = At0 * At; seg[(w * 64 + dt * 16 + fr) * 2 + 1] = At * Ht0 + Ht; } }
                }
            }
            __syncthreads();
#pragma unroll
            for (int dt = 0; dt < 4; ++dt) {
                float hc = carry[dt], hin = hc;
#pragma unroll
                for (int w2 = 0; w2 < 8; ++w2) { const float A = seg[(w2 * 64 + dt * 16 + fr) * 2], H = seg[(w2 * 64 + dt * 16 + fr) * 2 + 1];
                    hc = A * hc + H; if (w2 + 1 == w) hin = hc; }
                carry[dt] = hc;
#pragma unroll
                for (int tt = 0; tt < 2; ++tt) {
                    const float hs = Aex[tt][dt] * hin + Hex[tt][dt];
#pragma unroll
                    for (int j = 0; j < 4; ++j) xcs[(w * 32 + tt * 16 + fq * 4 + j) * 68 + dt * 16 + fr] = ap[tt][dt][j] * hs + hl[tt][dt][j];
                }
            }
            const int tid2 = tidx();
            f32x4 hfa[4][2]; u32x4 gba[4];
            if (dir == 1) {
#pragma unroll
                for (int i = 0; i < 4; ++i) { const int piece = tid2 + i * 512, q = piece >> 3, c8 = (piece & 7) * 8; const size_t tk = (size_t)(tok0 + T - 1 - (ck * 256 + q));
                    hfa[i][0] = *(const f32x4*)(Hf + tk * 512 + n * 64 + c8); hfa[i][1] = *(const f32x4*)(Hf + tk * 512 + n * 64 + c8 + 4);
                    gba[i] = *(const u32x4*)(P0 + tk * 2048 + 1536 + n * 64 + c8); }
            }
            __syncthreads();
#pragma unroll
            for (int i = 0; i < 4; ++i) {
                const int piece = tid2 + i * 512, q = piece >> 3, c8 = (piece & 7) * 8, pp = ck * 256 + q;
                const f32x4 h0 = *(const f32x4*)(xcs + q * 68 + c8), h1 = *(const f32x4*)(xcs + q * 68 + c8 + 4);
                if (dir == 0) { float* o = Hf + (size_t)(tok0 + pp) * 512 + n * 64 + c8; *(f32x4*)o = h0; *(f32x4*)(o + 4) = h1; }
                else {
                    const u32x4 gw = gba[i];
                    f32x4 g0 = {__uint_as_float(gw.x << 16), __uint_as_float(gw.x & 0xffff0000u), __uint_as_float(gw.y << 16), __uint_as_float(gw.y & 0xffff0000u)};
                    f32x4 g1 = {__uint_as_float(gw.z << 16), __uint_as_float(gw.z & 0xffff0000u), __uint_as_float(gw.w << 16), __uint_as_float(gw.w & 0xffff0000u)};
                    f32x4 y0, y1;
#pragma unroll
                    for (int e = 0; e < 4; ++e) { y0[e] = (hfa[i][0][e] + h0[e]) * g0[e] * sigm(g0[e]); y1[e] = (hfa[i][1][e] + h1[e]) * g1[e] * sigm(g1[e]); }
                    *(u32x4*)(Y + (size_t)(tok0 + T - 1 - pp) * 1024 + 512 + n * 64 + c8) = pk8(y0, y1);
                }
            }
        }
#undef LRU_WF
        if (!lat && w == 0 && fq == 0) {
#pragma unroll
            for (int dt = 0; dt < 4; ++dt) p.out[O_LRU + (s * 2 + dir) * 512 + n * 64 + dt * 16 + fr] = carry[dt];
        }
    }
}
__device__ __forceinline__ void gsync(const Params& p) {
    extern __shared__ __attribute__((aligned(16))) unsigned char smem_[];
    XcdBarrier b; b.bar = (unsigned*)(p.ws + WS_BAR); b.x = xb_xcc_id(); b.st = (volatile LAS unsigned*)((LAS unsigned char*)smem_ + 131072);
    xcd_barrier(b);
}
__global__ void __launch_bounds__(512) mega(Params p) {
    extern __shared__ __attribute__((aligned(16))) unsigned char smem[];
    cg::grid_group grid = cg::this_grid();
    PG8_LAS unsigned char* lds = (PG8_LAS unsigned char*)smem;
    const float* mod = (const float*)(p.ws + WS_MOD);
    pg8::StaticOrder S;
    volatile LAS unsigned* xst = (volatile LAS unsigned*)(lds + 131072);
    if (threadIdx.x == 0) { xst[0] = 0u; xst[1] = 0u; }
    __syncthreads();
    if (blockIdx.x == 0) {
        unsigned* bw = (unsigned*)(p.ws + WS_BAR);
        for (int i = (int)threadIdx.x; i < XCD_BAR_WORDS; i += 512) bw[i] = 0u;
    }
    phaseA(p, (float*)smem);
    grid.sync();
    (void)xcd_barrier_post((unsigned*)(p.ws + WS_BAR), xst);
    phaseA1b(p, (float*)smem);
    phase_norm(p, 0, p.in[0], p.in[1]);
    gsync(p);
    { pg8::Gemm g{(const bf16_t*)(p.ws + WS_H), (const bf16_t*)(p.ws + WS_W1T), NTOK, 3072, 1024}; S.init(NTOK, 3072, (int)gridDim.x, (int)blockIdx.x);
      Epi1 E{p.ws, p.out};
      pg8::gemm_phase<Epi1, pg8::StaticOrder, false>(lds, g, S, E, nullptr); }
    if (blockIdx.x >= 64) phaseA2(p, (float*)smem, (int)blockIdx.x - 64, (int)gridDim.x - 64);
    gsync(p);
    {
        unsigned* qctr = (unsigned*)(p.ws + WS_BAR);
        volatile LAS int* slot = (volatile LAS int*)(lds + 131072 + 16);
        for (;;) {
            __syncthreads();
            if (threadIdx.x == 0) *slot = (int)__hip_atomic_fetch_add(qctr, 1u, __ATOMIC_RELAXED, __HIP_MEMORY_SCOPE_AGENT);
            __syncthreads();
            const int q = *slot;
            if (q >= 960) break;
            int kind, idx;
            if (q < 64) { kind = 0; idx = q; } else if (q < 576) { kind = 1; idx = q - 64; } else if (q < 704) { kind = 0; idx = 64 + q - 576; } else { kind = 1; idx = 512 + q - 704; }
            if (kind == 0) lru_item(p, idx, (float*)smem); else attn0_item(p, idx, lds);
        }
    }
    gsync(p);
    { pg8::Gemm g{(const bf16_t*)(p.ws + WS_Y), (const bf16_t*)(p.ws + WS_W2T), NTOK, 1024, 1024}; S.init(NTOK, 1024, (int)gridDim.x, (int)blockIdx.x);
      EpiRes<false> E{p.in[0], p.in[1], nullptr, (bf16_t*)(p.ws + WS_X1B), mod + 2048};
      pg8::gemm_phase<EpiRes<false>, pg8::StaticOrder, false>(lds, g, S, E, nullptr); }
    gsync(p);
    phase_norm16(p, (const bf16_t*)(p.ws + WS_X1B));
    gsync(p);
    { pg8::Gemm g{(const bf16_t*)(p.ws + WS_H), (const bf16_t*)(p.ws + WS_W3T), NTOK, 4096, 1024}; S.init(NTOK, 4096, (int)gridDim.x, (int)blockIdx.x);
      Epi3 E{p.ws, p.out};
      pg8::gemm_phase<Epi3, pg8::StaticOrder, false>(lds, g, S, E, nullptr); }
    gsync(p);
    { const int lane = threadIdx.x & 63;
      const float lam = __expf(wave_sum(p.in[26][lane] * p.in[27][lane])) - __expf(wave_sum(p.in[28][lane] * p.in[29][lane])) + LAM_INIT;
      for (int it = blockIdx.x; it < 768; it += gridDim.x) attn1_item(p, it, lam, lds); }
    gsync(p);
    { pg8::Gemm g{(const bf16_t*)(p.ws + WS_Y), (const bf16_t*)(p.ws + WS_W4T), NTOK, 1024, 1024}; S.init(NTOK, 1024, (int)gridDim.x, (int)blockIdx.x);
      EpiRes<true> E{nullptr, nullptr, (const bf16_t*)(p.ws + WS_X1B), (bf16_t*)(p.ws + WS_X2B), mod + 9 * 3072 + 2048};
      pg8::gemm_phase<EpiRes<true>, pg8::StaticOrder, false>(lds, g, S, E, nullptr); }
    gsync(p);
    phase_final16(p, (const bf16_t*)(p.ws + WS_X2B));
}

extern "C" void kernel_launch(void* const* d_in, const int* in_sizes, int n_in, void* d_out, int out_size, void* d_ws, size_t ws_size, hipStream_t stream) {
    static int grid_blocks = 0;
    if (!grid_blocks) {
        int dev = 0, cus = 0, per_cu = 0;
        (void)hipGetDevice(&dev);
        (void)hipDeviceGetAttribute(&cus, hipDeviceAttributeMultiprocessorCount, dev);
        (void)hipFuncSetAttribute((const void*)mega, hipFuncAttributeMaxDynamicSharedMemorySize, LDS_BYTES);
        (void)hipOccupancyMaxActiveBlocksPerMultiprocessor(&per_cu, (const void*)mega, 512, LDS_BYTES);
        if (per_cu < 1) { fprintf(stderr, "occupancy query says %d\n", per_cu); per_cu = 1; }
        grid_blocks = cus;
        if (ws_size < WS_END) fprintf(stderr, "workspace too small: %zu < %zu\n", ws_size, (size_t)WS_END);
    }
    Params p{};
    for (int i = 0; i < 33; ++i) p.in[i] = (const float*)d_in[i];
    p.out = (float*)d_out; p.ws = (unsigned char*)d_ws;
    void* args[] = {&p};
    hipError_t e = hipLaunchCooperativeKernel((void*)mega, dim3(grid_blocks), dim3(512), args, LDS_BYTES, stream);
    if (e != hipSuccess) fprintf(stderr, "cooperative launch failed: %s (grid %d)\n", hipGetErrorString(e), grid_blocks);
}
```

```cpp
#include <hip/hip_runtime.h>
#include <hip/hip_cooperative_groups.h>
#include <cstdio>
#include <cstdint>
namespace cg = cooperative_groups;
__device__ __forceinline__ int tidx() { int t = threadIdx.x; asm volatile("" : "+v"(t)); return t; }
namespace pg8 {
#define PG8_LAS __attribute__((address_space(3)))
typedef unsigned short bf16_t;
typedef short bf16x8 __attribute__((ext_vector_type(8)));
typedef float f32x4 __attribute__((ext_vector_type(4)));
typedef unsigned u32x4 __attribute__((ext_vector_type(4)));
constexpr int BM = 256, BK = 64, HALF = 128, HTB = HALF * BK * 2  , STAGE_BYTES = 8 * HTB, NXCD = 8, WGM = 8;

__host__ __device__ __forceinline__ int lds_byte(int r, int c) { const int st = (r >> 4) * 2 + (c >> 5), rr = r & 15, cc = c & 31, ob = rr * 64 + cc * 2; return st * 1024 + (ob ^ (((ob >> 9) & 1) << 5)); }
__host__ __device__ __forceinline__ void stage_rc(int b, int& R, int& C) { const int st = b / 1024, sb = b % 1024, swz = sb ^ (((sb >> 9) & 1) << 5); R = (st >> 1) * 16 + swz / 64; C = (st & 1) * 32 + (swz % 64) / 2; }
__host__ __device__ __forceinline__ int perm32(int rho) { const int n = rho >> 4, i = rho & 15; return 8 * (i >> 2) + 4 * n + (i & 3); }

struct Unit { int pm, pn; };
struct Gemm { const bf16_t* A; const bf16_t* Bt; int M, N, K; };

struct StaticOrder {
    int nM, nN, nwg, G, c;
    __host__ __device__ void init(int M, int N, int G_, int c_) { nM = M / BM; nN = N / BM; nwg = nM * nN; G = G_; c = c_; }
    __host__ __device__ bool next(int i, Unit& u) const {
        const long L = (long)i * G + c; if (L >= nwg) return false;
        int wgid = (int)L; { const int q = nwg / NXCD, r = nwg % NXCD, xcd = wgid % NXCD, off = wgid / NXCD; wgid = (xcd < r ? xcd * (q + 1) : r * (q + 1) + (xcd - r) * q) + off; }
        const int nig = WGM * nN, gid = wgid / nig, fm = gid * WGM, gsz = (nM - fm) < WGM ? (nM - fm) : WGM;
        u.pm = fm + ((wgid % nig) % gsz); u.pn = (wgid % nig) / gsz; return true;
    }
    __device__ __forceinline__ void a_ready(const Unit&) const {}
    __device__ __forceinline__ void done(const Unit&) const {}
};

__device__ __forceinline__ unsigned cvt_pk_bf16(float lo, float hi) { unsigned r; asm volatile("v_cvt_pk_bf16_f32 %0, %1, %2" : "=v"(r) : "v"(lo), "v"(hi)); return r; }
template <int ACT  > struct EpiBf16 {
    static constexpr bool PERM = true, AFTER_DRAIN = false;
    bf16_t* O; int ldc; const float* bias; int split_cols; size_t split_stride;
    __device__ __forceinline__ void operator()(const f32x4 (&acc)[2][2][4][2], const Unit& u, int wr, int wc, int fr, int fq) const {
        const int row0 = u.pm * BM + wr * 64 + fr; int colt = u.pn * BM; bf16_t* base = O;
        if (split_cols) { const int t = colt / split_cols; base += (size_t)t * split_stride; colt -= t * split_cols; }
        const int col0 = colt + wc * 32 + 8 * fq, bcol0 = u.pn * BM + wc * 32 + 8 * fq;
        f32x4 bv[2][2];
#pragma unroll
        for (int bj = 0; bj < 2; ++bj)
#pragma unroll
            for (int n = 0; n < 2; ++n) bv[bj][n] = bias ? *(const f32x4*)(bias + bcol0 + bj * HALF + 4 * n) : (f32x4){0.f, 0.f, 0.f, 0.f};
#pragma unroll
        for (int ai = 0; ai < 2; ++ai)
#pragma unroll
            for (int m = 0; m < 4; ++m) { bf16_t* rowp = base + (size_t)(row0 + ai * HALF + m * 16) * ldc + col0;
#pragma unroll
                for (int bj = 0; bj < 2; ++bj) { f32x4 v0 = acc[ai][bj][m][0] + bv[bj][0], v1 = acc[ai][bj][m][1] + bv[bj][1];
                    u32x4 w; w.x = cvt_pk_bf16(v0[0], v0[1]); w.y = cvt_pk_bf16(v0[2], v0[3]); w.z = cvt_pk_bf16(v1[0], v1[1]); w.w = cvt_pk_bf16(v1[2], v1[3]);
                    *(u32x4*)(rowp + bj * HALF) = w; } }
    }
};

template <class Epi, class Sched, bool STAMP = false>
__device__ __forceinline__ void gemm_phase(PG8_LAS unsigned char* lds, const Gemm g, const Sched& S, const Epi& E, unsigned long long* stamps) {
    const int tid = tidx(), wid = __builtin_amdgcn_readfirstlane(tid >> 6), lane = tid & 63, wr = wid >> 2, wc = wid & 3, fr = lane & 15, fq = lane >> 4;
    const int K = g.K, nt = K / BK;
    int ts_lo = 0, ts_hi = 0, nts = 0; const unsigned long long rt_entry = STAMP ? (unsigned long long)wall_clock64() : 0ull;
#define PG8_STAMP() do { if (STAMP && wid == 0 && nts < 64) { const unsigned long long _c = (unsigned long long)clock64(); \
        ts_lo = (lane == nts) ? (int)(unsigned)_c : ts_lo; ts_hi = (lane == nts) ? (int)(unsigned)(_c >> 32) : ts_hi; ++nts; } } while (0)
    PG8_STAMP();
    unsigned voffA[2], voffB[2];
#pragma unroll
    for (int i = 0; i < 2; ++i) { int R, C; stage_rc(tid * 16 + i * 8192, R, C); const int Rb = Epi::PERM ? ((R & ~31) + perm32(R & 31)) : R;
        voffA[i] = (unsigned)(R * K + C) * 2u; voffB[i] = (unsigned)(Rb * K + C) * 2u; }
    const size_t kstep = (size_t)(BK * 2);
    const size_t hstep = (size_t)HALF * K * 2;
    const size_t tstep = 2 * hstep;
    const unsigned ldsw = (unsigned)wid * 1024u;
    const int aoff = lds_byte(wr * 64 + fr, fq * 8), boff = lds_byte(wc * 32 + fr, fq * 8);
#define PG8_SA(b, h) (((b) * 2 + (h)) * HTB)
#define PG8_SB(b, h) ((4 + (b) * 2 + (h)) * HTB)
#define PG8_STAGE(bufoff, gbase, voff) do { _Pragma("unroll") for (int _i = 0; _i < 2; ++_i) \
        __builtin_amdgcn_global_load_lds((const unsigned*)((const char*)(gbase) + (voff)[_i]), (PG8_LAS unsigned*)(lds + (bufoff) + ldsw + _i * 8192), 16, 0, 0); } while (0)
#define PG8_LDA(dst, b, h) do { _Pragma("unroll") for (int m = 0; m < 4; ++m) _Pragma("unroll") for (int k = 0; k < 2; ++k) dst[m][k] = *(const PG8_LAS bf16x8*)(lds + PG8_SA(b, h) + aoff + m * 2048 + k * 1024); } while (0)
#define PG8_LDB(dst, b, h) do { _Pragma("unroll") for (int n = 0; n < 2; ++n) _Pragma("unroll") for (int k = 0; k < 2; ++k) dst[n][k] = *(const PG8_LAS bf16x8*)(lds + PG8_SB(b, h) + boff + n * 2048 + k * 1024); } while (0)
#define PG8_MMA(ai, bj, At, Bt) do { __builtin_amdgcn_s_setprio(1); _Pragma("unroll") for (int m = 0; m < 4; ++m) _Pragma("unroll") for (int n = 0; n < 2; ++n) _Pragma("unroll") for (int k = 0; k < 2; ++k) \
        acc[ai][bj][m][n] = __builtin_amdgcn_mfma_f32_16x16x32_bf16(Bt[n][k], At[m][k], acc[ai][bj][m][n], 0, 0, 0); __builtin_amdgcn_s_setprio(0); } while (0)
#define PG8_WAIT_V(n) asm volatile("s_waitcnt vmcnt(" #n ")" ::: "memory")
#define PG8_WAIT_L(n) asm volatile("s_waitcnt lgkmcnt(" #n ")" ::: "memory")
#define PG8_BAR __builtin_amdgcn_s_barrier()
#define PG8_SCHED __builtin_amdgcn_sched_barrier(0)
    Unit cur, nxt; int ui = 0;
    if (!S.next(0, cur)) return;
    f32x4 acc[2][2][4][2];
#pragma unroll
    for (int a = 0; a < 2; ++a)
#pragma unroll
        for (int b = 0; b < 2; ++b)
#pragma unroll
            for (int m = 0; m < 4; ++m)
#pragma unroll
                for (int n = 0; n < 2; ++n) acc[a][b][m][n] = (f32x4){0.f, 0.f, 0.f, 0.f};
    bf16x8 At[4][2], B0[2][2], B1[2][2];
    const char* cA = (const char*)g.A + (size_t)cur.pm * tstep; const char* cB = (const char*)g.Bt + (size_t)cur.pn * tstep;
    S.a_ready(cur);
    PG8_STAGE(PG8_SB(0, 0), cB, voffB); PG8_STAGE(PG8_SA(0, 0), cA, voffA); PG8_STAGE(PG8_SB(0, 1), cB + hstep, voffB); PG8_STAGE(PG8_SA(0, 1), cA + hstep, voffA);
    if (wr == 1) PG8_BAR;
    PG8_WAIT_V(4); PG8_BAR;
    PG8_STAGE(PG8_SB(1, 0), cB + kstep, voffB); PG8_STAGE(PG8_SA(1, 0), cA + kstep, voffA); PG8_STAGE(PG8_SB(1, 1), cB + hstep + kstep, voffB);
    PG8_WAIT_V(6); PG8_BAR;
    PG8_STAMP();
    for (;;) {
        const bool has_next = S.next(ui + 1, nxt);
        const char* nA = has_next ? (const char*)g.A + (size_t)nxt.pm * tstep : cA; const char* nB = has_next ? (const char*)g.Bt + (size_t)nxt.pn * tstep : cB;
        for (int t = 0; t < nt; t += 2) {
            const bool last = (t == nt - 2);
            const char* a1 = cA + (size_t)(t + 1) * kstep;
            const char* a2 = last ? nA : cA + (size_t)(t + 2) * kstep; const char* b2 = last ? nB : cB + (size_t)(t + 2) * kstep;
            const char* a3 = a2 + kstep; const char* b3 = b2 + kstep;
            if (last && has_next) S.a_ready(nxt);
            PG8_LDB(B0, 0, 0); PG8_SCHED; PG8_LDA(At, 0, 0); PG8_STAGE(PG8_SA(1, 1), a1 + hstep, voffA);
            PG8_WAIT_L(8); PG8_BAR; PG8_WAIT_L(0); PG8_MMA(0, 0, At, B0); PG8_BAR; PG8_SCHED;
            PG8_LDB(B1, 0, 1); PG8_STAGE(PG8_SB(0, 0), b2, voffB);
            PG8_BAR; PG8_WAIT_L(0); PG8_MMA(0, 1, At, B1); PG8_BAR;
            PG8_LDA(At, 0, 1); PG8_STAGE(PG8_SA(0, 0), a2, voffA);
            PG8_BAR; PG8_WAIT_L(0); PG8_MMA(1, 0, At, B0); PG8_BAR; PG8_SCHED;
            PG8_STAGE(PG8_SB(0, 1), b2 + hstep, voffB);
            PG8_WAIT_V(6); PG8_BAR; PG8_MMA(1, 1, At, B1); PG8_BAR;
            PG8_LDB(B0, 1, 0); PG8_SCHED; PG8_LDA(At, 1, 0); PG8_STAGE(PG8_SA(0, 1), a2 + hstep, voffA);
            PG8_WAIT_L(8); PG8_BAR; PG8_WAIT_L(0); PG8_MMA(0, 0, At, B0); PG8_BAR; PG8_SCHED;
            PG8_LDB(B1, 1, 1); PG8_STAGE(PG8_SB(1, 0), b3, voffB);
            PG8_BAR; PG8_WAIT_L(0); PG8_MMA(0, 1, At, B1); PG8_BAR;
            PG8_LDA(At, 1, 1); PG8_STAGE(PG8_SA(1, 0), a3, voffA);
            PG8_BAR; PG8_WAIT_L(0); PG8_MMA(1, 0, At, B0); PG8_BAR; PG8_SCHED;
            PG8_STAGE(PG8_SB(1, 1), b3 + hstep, voffB);
            PG8_WAIT_V(6); PG8_BAR; PG8_MMA(1, 1, At, B1); PG8_BAR;
        }
        PG8_STAMP();
        if constexpr (!Epi::AFTER_DRAIN) { E(acc, cur, wr, wc, fr, fq); S.done(cur); }
        PG8_STAMP();
        if (!has_next) break;
#pragma unroll
        for (int a = 0; a < 2; ++a)
#pragma unroll
            for (int b = 0; b < 2; ++b)
#pragma unroll
                for (int m = 0; m < 4; ++m)
#pragma unroll
                    for (int n = 0; n < 2; ++n) acc[a][b][m][n] = (f32x4){0.f, 0.f, 0.f, 0.f};
        cur = nxt; cA = nA; cB = nB; ++ui;
    }
    PG8_WAIT_V(0);
    if (wr == 0) PG8_BAR;
    PG8_BAR;
    if constexpr (Epi::AFTER_DRAIN) { E.fused(acc, cur, wr, wc, fr, fq, lds, wid, lane); S.done(cur); }
    PG8_STAMP();
    if (STAMP && wid == 0) { stamps[lane] = lane < nts ? (((unsigned long long)(unsigned)ts_hi << 32) | (unsigned)ts_lo) : 0ull;
        if (lane == 62) stamps[62] = rt_entry; if (lane == 63) stamps[63] = (unsigned long long)wall_clock64(); }
#undef PG8_STAMP
#undef PG8_SA
#undef PG8_SB
#undef PG8_STAGE
#undef PG8_LDA
#undef PG8_LDB
#undef PG8_MMA
#undef PG8_WAIT_V
#undef PG8_WAIT_L
#undef PG8_BAR
#undef PG8_SCHED
}
}
using pg8::bf16_t; using pg8::bf16x8; using pg8::f32x4; using pg8::u32x4;
#define LAS __attribute__((address_space(3)))
typedef unsigned u32x2 __attribute__((ext_vector_type(2)));

constexpr int NTOK = 12288, NCTX = 4096;
constexpr int LDS_BYTES = 131072 + 64;
constexpr float LAM_INIT = 0.35550906759f;
constexpr size_t O_YP = 0, O_YS = 4194304, O_NAK = 12582912, O_NAV = 14680064, O_LRU = 16777216, O_DK = 16793600, O_DV = 20987904;

struct Params { const float* in[33]; float* out; unsigned char* ws; };

__device__ __forceinline__ float bf2f(bf16_t v) { return __uint_as_float(((unsigned)v) << 16); }
__device__ __forceinline__ bf16_t f2bf(float f) { unsigned u = __float_as_uint(f); u += 0x7FFFu + ((u >> 16) & 1u); return (bf16_t)(u >> 16); }
__device__ __forceinline__ unsigned pk2(float lo, float hi) { return (unsigned)f2bf(lo) | ((unsigned)f2bf(hi) << 16); }
__device__ __forceinline__ float silu_f(float x) { return x / (1.0f + __expf(-x)); }
__device__ __forceinline__ float sigmoid_f(float x) { return 1.0f / (1.0f + __expf(-x)); }
__device__ __forceinline__ float wave_sum(float v) {
#pragma unroll
    for (int o = 32; o >= 1; o >>= 1) v += __shfl_xor(v, o);
    return v;
}
#define XB_TMO      128
#define XB_XCNT(j)  (256  + 64 * (j))
#define XB_XSUB(j)  (1280 + 64 * (j))
#define XB_XGEN(j)  (2304 + 64 * (j))
#define XB_TOP      3328
#define XB_TOPGEN   3392
#define XCD_BAR_WORDS 3456
#define XB_SPIN_CAP (1u << 18)
#define LAS __attribute__((address_space(3)))
__device__ __forceinline__ unsigned xb_ld(unsigned* p)              { return __hip_atomic_load(p, __ATOMIC_RELAXED, __HIP_MEMORY_SCOPE_AGENT); }
__device__ __forceinline__ unsigned xb_add(unsigned* p, unsigned v) { return __hip_atomic_fetch_add(p, v, __ATOMIC_RELAXED, __HIP_MEMORY_SCOPE_AGENT); }
__device__ __forceinline__ unsigned xb_xcc_id() { return (unsigned)__builtin_amdgcn_s_getreg((3 << 11) | 20) & 0xFu; }
#define XB_SPIN(cond, bar) do { unsigned _sp = 0; while (cond) { __builtin_amdgcn_s_sleep(4); \
    if ((++_sp & 255u) == 0u) { if (xb_ld(&(bar)[XB_TMO])) break; if (_sp > XB_SPIN_CAP) { atomicAdd(&(bar)[XB_TMO], 1u); break; } } } } while (0)

struct XcdBarrier {
    unsigned* bar; unsigned x;
    volatile LAS unsigned* st;
};

__device__ __forceinline__ XcdBarrier xcd_barrier_post(unsigned* bar, volatile LAS unsigned* st) {
    XcdBarrier b; b.bar = bar; b.x = xb_xcc_id(); b.st = st;
    if (threadIdx.x == 0) (void)xb_add(&bar[XB_XCNT(b.x)], 1u);
    return b;
}
__device__ __forceinline__ void xcd_barrier_complete(unsigned* bar, unsigned x, unsigned& nloc, unsigned& nx) {
    const unsigned G = gridDim.x * gridDim.y * gridDim.z;
    unsigned sum, cnt, mine, sp = 0u;
    for (;;) {
        sum = 0u; cnt = 0u; mine = 0u;
#pragma unroll
        for (unsigned j = 0; j < 16; ++j) { const unsigned c = xb_ld(&bar[XB_XCNT(j)]); sum += c; cnt += (c > 0u) ? 1u : 0u; mine = (j == x) ? c : mine; }
        if (sum == G) break;
        __builtin_amdgcn_s_sleep(1);
        if ((++sp & 255u) == 0u) { if (xb_ld(&bar[XB_TMO])) break; if (sp > XB_SPIN_CAP) { atomicAdd(&bar[XB_TMO], 1u); break; } }
    }
    nloc = mine > 0u ? mine : 1u; nx = cnt > 0u ? cnt : 1u;
}

__device__ __forceinline__ void xcd_barrier(const XcdBarrier& b) {
    asm volatile("s_waitcnt vmcnt(0)" ::: "memory");
    __syncthreads();
    if (threadIdx.x == 0) {
        unsigned* bar = b.bar;
        __builtin_amdgcn_s_waitcnt(0);
        unsigned nloc = b.st[0], nx = b.st[1];
        if (nloc == 0u) { xcd_barrier_complete(bar, b.x, nloc, nx); b.st[0] = nloc; b.st[1] = nx; }
        const unsigned old = xb_add(&bar[XB_XSUB(b.x)], 1u);
        const unsigned gen = old / nloc;
        if (old + 1u == (gen + 1u) * nloc) {
            __builtin_amdgcn_fence(__ATOMIC_RELEASE, "agent");
            asm volatile("s_waitcnt vmcnt(0)" ::: "memory");
            const unsigned og = xb_add(&bar[XB_TOP], 1u);
            const unsigned tg = og / nx;
            if (og + 1u == (tg + 1u) * nx) xb_add(&bar[XB_TOPGEN], 1u);
            else XB_SPIN(xb_ld(&bar[XB_TOPGEN]) == tg, bar);
            __builtin_amdgcn_fence(__ATOMIC_ACQUIRE, "agent");
            xb_add(&bar[XB_XGEN(b.x)], 1u);
            asm volatile("s_waitcnt vmcnt(0)" ::: "memory");
        } else {
            XB_SPIN(xb_ld(&bar[XB_XGEN(b.x)]) == gen, bar);
            __builtin_amdgcn_fence(__ATOMIC_ACQUIRE, "agent");
            asm volatile("s_waitcnt vmcnt(0)" ::: "memory");
        }
    }
    __syncthreads();
}
constexpr size_t WS_MOD = 0;
constexpr size_t WS_ROPE = 229376;
constexpr size_t WS_WG = 262144;
constexpr size_t WS_W1T = WS_WG + 262144;
constexpr size_t WS_W2T = WS_W1T + 6291456;
constexpr size_t WS_W3T = WS_W2T + 2097152;
constexpr size_t WS_W4T = WS_W3T + 8388608;
constexpr size_t WS_H = WS_W4T + 2097152;
constexpr size_t WS_HF = WS_H;
constexpr size_t WS_P = WS_H + 25165824;
constexpr size_t WS_Y = WS_P + 50331648;
constexpr size_t WS_K0L = WS_Y + 25165824;
constexpr size_t WS_V0L = WS_K0L + 10485760;
constexpr size_t WS_K0C = WS_V0L + 10485760;
constexpr size_t WS_V0C = WS_K0C + 4194304;
constexpr size_t WS_K1L = WS_V0C + 4194304;
constexpr size_t WS_V1L = WS_K1L + 20971520;
constexpr size_t WS_K1C = WS_V1L + 20971520;
constexpr size_t WS_V1C = WS_K1C + 8388608;
constexpr size_t WS_X1B = WS_K0L;
constexpr size_t WS_X2B = WS_P;
constexpr size_t WS_BAR = WS_V1C + 8388608;
constexpr size_t WS_END = WS_BAR + 16384;

__device__ __forceinline__ void transpose_tile(const float* __restrict__ src, int lds_, bf16_t* __restrict__ dst, int ldd, int r0, int c0, float* sm) {
    const int tid = tidx();
    __syncthreads();
#pragma unroll
    for (int i = 0; i < 2; ++i) {
        const int r = (tid >> 4) + i * 32, c4 = (tid & 15) * 4;
        const float4 v = *(const float4*)(src + (size_t)(r0 + r) * lds_ + c0 + c4);
        sm[r * 65 + c4 + 0] = v.x; sm[r * 65 + c4 + 1] = v.y; sm[r * 65 + c4 + 2] = v.z; sm[r * 65 + c4 + 3] = v.w;
    }
    __syncthreads();
    const int c = tid >> 3, r8 = (tid & 7) * 8;
    u32x4 w;
    w.x = pk2(sm[(r8 + 0) * 65 + c], sm[(r8 + 1) * 65 + c]); w.y = pk2(sm[(r8 + 2) * 65 + c], sm[(r8 + 3) * 65 + c]);
    w.z = pk2(sm[(r8 + 4) * 65 + c], sm[(r8 + 5) * 65 + c]); w.w = pk2(sm[(r8 + 6) * 65 + c], sm[(r8 + 7) * 65 + c]);
    *(u32x4*)(dst + (size_t)(c0 + c) * ldd + r0 + r8) = w;
}

__device__ __forceinline__ void transpose_4tile(const float* __restrict__ src, int lds_, bf16_t* __restrict__ dst, int ldd, int r0, int c0, float* sm) {
    const int tid = tidx();
    float4 v[8];
#pragma unroll
    for (int i = 0; i < 8; ++i) { const int idx = tid + 512 * i, r = idx >> 6, c4 = (idx & 63) * 4; { const f32x4 t4 = __builtin_nontemporal_load((const f32x4*)(src + (size_t)(r0 + r) * lds_ + c0 + c4)); v[i] = make_float4(t4[0], t4[1], t4[2], t4[3]); }     }
    __syncthreads();
#pragma unroll
    for (int i = 0; i < 8; ++i) { const int idx = tid + 512 * i, r = idx >> 6, c4 = (idx & 63) * 4;
        sm[r * 257 + c4 + 0] = v[i].x; sm[r * 257 + c4 + 1] = v[i].y; sm[r * 257 + c4 + 2] = v[i].z; sm[r * 257 + c4 + 3] = v[i].w; }
    __syncthreads();
    const int c = tid >> 1, rh = (tid & 1) * 32;
#pragma unroll
    for (int q = 0; q < 4; ++q) { const int rb = rh + q * 8; u32x4 w;
        w.x = pk2(sm[(rb + 0) * 257 + c], sm[(rb + 1) * 257 + c]); w.y = pk2(sm[(rb + 2) * 257 + c], sm[(rb + 3) * 257 + c]);
        w.z = pk2(sm[(rb + 4) * 257 + c], sm[(rb + 5) * 257 + c]); w.w = pk2(sm[(rb + 6) * 257 + c], sm[(rb + 7) * 257 + c]);
        *(u32x4*)(dst + (size_t)(c0 + c) * ldd + r0 + rb) = w; }
}

constexpr int A1_TOTAL = 192 + 32 + 1;
__device__ __forceinline__ void phaseA(const Params& p, float* sm) {
    const int tid = tidx();
    float* mod = (float*)(p.ws + WS_MOD);
    for (int it = blockIdx.x; it < 192; it += gridDim.x) {
        {
            const int layer = it / 96, col0 = (it % 96) * 32;
            const float* W = p.in[layer ? 23 : 10]; const float* Bv = p.in[layer ? 24 : 11];
            const int col = tid & 31, kp = tid >> 5;
            float wv[32];
#pragma unroll
            for (int u = 0; u < 32; ++u) wv[u] = __builtin_nontemporal_load((const float*)((const char*)W + (unsigned)(((kp * 64 + u) * 3072 + col0 + col) * 4)));
            __syncthreads();
            for (int e = tid; e < 9 * 1024; e += 512) { const float cvv = e < 1024 ? p.in[8][e] : p.in[2][e - 1024]; sm[e] = silu_f(cvv); }
            __syncthreads();
            float acc[9];
#pragma unroll
            for (int v = 0; v < 9; ++v) acc[v] = 0.f;
#pragma unroll
            for (int hb = 0; hb < 2; ++hb) {
                float wn[32];
                if (hb == 0) {
#pragma unroll
                    for (int u = 0; u < 32; ++u) wn[u] = __builtin_nontemporal_load((const float*)((const char*)W + (unsigned)(((kp * 64 + 32 + u) * 3072 + col0 + col) * 4)));
                }
#pragma unroll
                for (int u = 0; u < 32; ++u)
#pragma unroll
                    for (int v = 0; v < 9; ++v) acc[v] += sm[v * 1024 + kp * 64 + hb * 32 + u] * wv[u];
                if (hb == 0) {
#pragma unroll
                    for (int u = 0; u < 32; ++u) wv[u] = wn[u];
                }
            }
            __syncthreads();
#pragma unroll
            for (int v = 0; v < 9; ++v) sm[9216 + (kp * 9 + v) * 32 + col] = acc[v];
            __syncthreads();
            if (tid < 288) { const int v = tid >> 5, c = tid & 31; float s = Bv[col0 + c];
                for (int k2 = 0; k2 < 16; ++k2) s += sm[9216 + (k2 * 9 + v) * 32 + c];
                mod[(layer * 9 + v) * 3072 + col0 + c] = s; }
        }
    }
}
__device__ __forceinline__ void phaseA1b(const Params& p, float* sm) {
    const int tid = tidx();
    for (int it = blockIdx.x; it < A1_TOTAL; it += gridDim.x) {
        int t = it;
        if (t < 192) { transpose_4tile(p.in[12], 3072, (bf16_t*)(p.ws + WS_W1T), 1024, (t / 12) * 64, (t % 12) * 256, sm); continue; }
        t -= 192;
        if (t < 32) {
            const int gate = t >> 4, dn = t & 15;
            transpose_tile(p.in[gate ? 18 : 16] + (size_t)dn * 4096, 64, (bf16_t*)(p.ws + WS_WG) + (size_t)(((dn >> 3) * 2 + gate) * 8 + (dn & 7)) * 4096, 64, 0, 0, sm);
            continue;
        }
        {
            float* rc = (float*)(p.ws + WS_ROPE);
            for (int e = tid; e < 1024; e += 512) { const int pos = e >> 4, i = e & 15; const float inv = powf(10000.0f, -(float)i / 16.0f); const float ang = (float)pos * inv;
                rc[e] = cosf(ang); rc[1024 + e] = sinf(ang); }
        }
    }
}

constexpr int A2_TOTAL = 64 + 64 + 128 + 128 + 64 + 256 + 64;
__device__ __forceinline__ void phaseA2(const Params& p, float* sm, int first, int stride) {
    const int tid = tidx();
    for (int it = first; it < A2_TOTAL; it += stride) {
        int t = it;
        if (t < 384) {
            int which; if (t < 64) which = 0; else if (t < 128) { which = 1; t -= 64; } else if (t < 256) { which = 2; t -= 128; } else { which = 3; t -= 256; }
            const float* src = p.in[which == 0 ? 3 : which == 1 ? 4 : which == 2 ? 6 : 7];
            bf16_t* dst = (bf16_t*)(p.ws + (which == 0 ? WS_K0L : which == 1 ? WS_V0L : which == 2 ? WS_K1L : WS_V1L));
            const int W = which < 2 ? 512 : 1024;
            float4 v[8];
#pragma unroll
            for (int i = 0; i < 8; ++i) { const f32x4 t4 = __builtin_nontemporal_load((const f32x4*)(src + (size_t)t * 16384 + i * 2048 + tid * 4)); v[i] = make_float4(t4[0], t4[1], t4[2], t4[3]); }
            __builtin_amdgcn_sched_barrier(0);
#pragma unroll
            for (int i = 0; i < 8; ++i) { const size_t e = (size_t)t * 16384 + i * 2048 + tid * 4;
                const size_t row = e / W; const int c = (int)(e % W); const size_t b = row >> 8, j = row & 255;
                u32x2 w; w.x = pk2(v[i].x, v[i].y); w.y = pk2(v[i].z, v[i].w);
                *(u32x2*)(dst + (b * 1280 + j) * W + c) = w; }
            continue; }
        t -= 384;
        if (t < 64) { transpose_4tile(p.in[21], 1024, (bf16_t*)(p.ws + WS_W2T), 1024, (t / 4) * 64, (t % 4) * 256, sm); continue; }
        t -= 64;
        if (t < 256) { transpose_4tile(p.in[25], 4096, (bf16_t*)(p.ws + WS_W3T), 1024, (t / 16) * 64, (t % 16) * 256, sm); continue; }
        t -= 256;
        transpose_4tile(p.in[31], 1024, (bf16_t*)(p.ws + WS_W4T), 1024, (t / 4) * 64, (t % 4) * 256, sm);
    }
}

__device__ __forceinline__ void phase_norm(const Params& p, int layer, const float* xa, const float* xb_) {
    const int lane = tidx() & 63, wave = tidx() >> 6;
    const float* g = p.in[layer ? 22 : 9];
    const float* mod = (const float*)(p.ws + WS_MOD) + layer * 9 * 3072;
    bf16_t* H = (bf16_t*)(p.ws + WS_H);
    float4 gg[4];
#pragma unroll
    for (int i = 0; i < 4; ++i) gg[i] = *(const float4*)(g + i * 256 + lane * 4);
    const int stride = gridDim.x * 8;
    for (int row0 = blockIdx.x * 8 + wave; row0 < NTOK; row0 += 3 * stride) {
        float4 v[3][4], sh[3][4], sc[3][4];
#pragma unroll
        for (int k = 0; k < 3; ++k) { const int row = min(row0 + k * stride, NTOK - 1);
            const float* xr = row < NCTX ? xa + (size_t)row * 1024 : xb_ + (size_t)(row - NCTX) * 1024;
            const float* mv = mod + (row < NCTX ? 0 : 1 + ((row - NCTX) >> 10)) * 3072;
#pragma unroll
            for (int i = 0; i < 4; ++i) { { const f32x4 t4 = __builtin_nontemporal_load((const f32x4*)(xr + i * 256 + lane * 4)); v[k][i] = make_float4(t4[0], t4[1], t4[2], t4[3]); } sh[k][i] = *(const float4*)(mv + i * 256 + lane * 4); sc[k][i] = *(const float4*)(mv + 1024 + i * 256 + lane * 4); } }
#pragma unroll
        for (int k = 0; k < 3; ++k) { const int row = row0 + k * stride;
            if (row < NTOK) {
                float ss = 0.f;
#pragma unroll
                for (int i = 0; i < 4; ++i) ss += v[k][i].x * v[k][i].x + v[k][i].y * v[k][i].y + v[k][i].z * v[k][i].z + v[k][i].w * v[k][i].w;
                ss = wave_sum(ss);
                const float rstd = rsqrtf(ss * (1.0f / 1024.0f) + 1e-6f);
#pragma unroll
                for (int i = 0; i < 4; ++i) { u32x2 w;
                    w.x = pk2(v[k][i].x * rstd * gg[i].x * (1.f + sc[k][i].x) + sh[k][i].x, v[k][i].y * rstd * gg[i].y * (1.f + sc[k][i].y) + sh[k][i].y);
                    w.y = pk2(v[k][i].z * rstd * gg[i].z * (1.f + sc[k][i].z) + sh[k][i].z, v[k][i].w * rstd * gg[i].w * (1.f + sc[k][i].w) + sh[k][i].w);
                    *(u32x2*)(H + (size_t)row * 1024 + i * 256 + lane * 4) = w; }
            } }
    }
}

__device__ __forceinline__ void phase_final(const Params& p) {
    const int lane = tidx() & 63, wave = tidx() >> 6;
    const float* g = p.in[32];
    float4 gg[4];
#pragma unroll
    for (int i = 0; i < 4; ++i) gg[i] = *(const float4*)(g + i * 256 + lane * 4);
    const int stride = gridDim.x * 8;
    for (int row0 = blockIdx.x * 8 + wave; row0 < NTOK; row0 += 3 * stride) {
        float4 v[3][4];
#pragma unroll
        for (int k = 0; k < 3; ++k) { const int row = min(row0 + k * stride, NTOK - 1);
#pragma unroll
            for (int i = 0; i < 4; ++i) v[k][i] = *(const float4*)(p.out + (size_t)row * 1024 + i * 256 + lane * 4); }
#pragma unroll
        for (int k = 0; k < 3; ++k) { const int row = row0 + k * stride;
            if (row < NTOK) {
                float ss = 0.f;
#pragma unroll
                for (int i = 0; i < 4; ++i) ss += v[k][i].x * v[k][i].x + v[k][i].y * v[k][i].y + v[k][i].z * v[k][i].z + v[k][i].w * v[k][i].w;
                ss = wave_sum(ss);
                const float rstd = rsqrtf(ss * (1.0f / 1024.0f) + 1e-6f);
#pragma unroll
                for (int i = 0; i < 4; ++i) { float4 o; o.x = v[k][i].x * rstd * gg[i].x; o.y = v[k][i].y * rstd * gg[i].y; o.z = v[k][i].z * rstd * gg[i].z; o.w = v[k][i].w * rstd * gg[i].w;
                    *(float4*)(p.out + (size_t)row * 1024 + i * 256 + lane * 4) = o; }
            } }
    }
}

__device__ __forceinline__ void ld_row16(const bf16_t* r, int lane, float (&x)[16]) {
#pragma unroll
    for (int i = 0; i < 2; ++i) { const u32x4 w = *(const u32x4*)(r + i * 512 + lane * 8);
        x[i * 8 + 0] = __uint_as_float(w.x << 16); x[i * 8 + 1] = __uint_as_float(w.x & 0xffff0000u); x[i * 8 + 2] = __uint_as_float(w.y << 16); x[i * 8 + 3] = __uint_as_float(w.y & 0xffff0000u);
        x[i * 8 + 4] = __uint_as_float(w.z << 16); x[i * 8 + 5] = __uint_as_float(w.z & 0xffff0000u); x[i * 8 + 6] = __uint_as_float(w.w << 16); x[i * 8 + 7] = __uint_as_float(w.w & 0xffff0000u); }
}
__device__ __forceinline__ void ld_vec16(const float* v, int lane, float (&x)[16]) {
#pragma unroll
    for (int i = 0; i < 2; ++i) { const float4 a = *(const float4*)(v + i * 512 + lane * 8), c = *(const float4*)(v + i * 512 + lane * 8 + 4);
        x[i * 8 + 0] = a.x; x[i * 8 + 1] = a.y; x[i * 8 + 2] = a.z; x[i * 8 + 3] = a.w; x[i * 8 + 4] = c.x; x[i * 8 + 5] = c.y; x[i * 8 + 6] = c.z; x[i * 8 + 7] = c.w; }
}
__device__ __forceinline__ void phase_norm16(const Params& p, const bf16_t* X) {
    const int lane = tidx() & 63, wave = tidx() >> 6;
    const float* mod = (const float*)(p.ws + WS_MOD) + 9 * 3072;
    bf16_t* H = (bf16_t*)(p.ws + WS_H);
    float gg[16]; ld_vec16(p.in[22], lane, gg);
    const int stride = gridDim.x * 8;
    for (int row0 = blockIdx.x * 8 + wave; row0 < NTOK; row0 += 3 * stride) {
        u32x4 raw[3][2];
#pragma unroll
        for (int k = 0; k < 3; ++k) { const int row = min(row0 + k * stride, NTOK - 1);
#pragma unroll
            for (int i = 0; i < 2; ++i) raw[k][i] = *(const u32x4*)(X + (size_t)row * 1024 + i * 512 + lane * 8); }
#pragma unroll
        for (int k = 0; k < 3; ++k) { const int row = row0 + k * stride;
            if (row < NTOK) {
                const float* mv = mod + (row < NCTX ? 0 : 1 + ((row - NCTX) >> 10)) * 3072;
                float sh[16], sc[16]; ld_vec16(mv, lane, sh); ld_vec16(mv + 1024, lane, sc);
                float x[16];
#pragma unroll
                for (int i = 0; i < 2; ++i) { const u32x4 w = raw[k][i];
                    x[i * 8 + 0] = __uint_as_float(w.x << 16); x[i * 8 + 1] = __uint_as_float(w.x & 0xffff0000u); x[i * 8 + 2] = __uint_as_float(w.y << 16); x[i * 8 + 3] = __uint_as_float(w.y & 0xffff0000u);
                    x[i * 8 + 4] = __uint_as_float(w.z << 16); x[i * 8 + 5] = __uint_as_float(w.z & 0xffff0000u); x[i * 8 + 6] = __uint_as_float(w.w << 16); x[i * 8 + 7] = __uint_as_float(w.w & 0xffff0000u); }
                float ss = 0.f;
#pragma unroll
                for (int e = 0; e < 16; ++e) ss += x[e] * x[e];
                ss = wave_sum(ss);
                const float rstd = rsqrtf(ss * (1.0f / 1024.0f) + 1e-6f);
#pragma unroll
                for (int i = 0; i < 2; ++i) { u32x4 w; float y[8];
#pragma unroll
                    for (int e = 0; e < 8; ++e) y[e] = x[i * 8 + e] * rstd * gg[i * 8 + e] * (1.f + sc[i * 8 + e]) + sh[i * 8 + e];
                    w.x = pk2(y[0], y[1]); w.y = pk2(y[2], y[3]); w.z = pk2(y[4], y[5]); w.w = pk2(y[6], y[7]);
                    *(u32x4*)(H + (size_t)row * 1024 + i * 512 + lane * 8) = w; }
            } }
    }
}
__device__ __forceinline__ void phase_final16(const Params& p, const bf16_t* X) {
    const int lane = tidx() & 63, wave = tidx() >> 6;
    float gg[16]; ld_vec16(p.in[32], lane, gg);
    const int stride = gridDim.x * 8;
    for (int row0 = blockIdx.x * 8 + wave; row0 < NTOK; row0 += 3 * stride) {
        u32x4 raw[3][2];
#pragma unroll
        for (int k = 0; k < 3; ++k) { const int row = min(row0 + k * stride, NTOK - 1);
#pragma unroll
            for (int i = 0; i < 2; ++i) raw[k][i] = *(const u32x4*)(X + (size_t)row * 1024 + i * 512 + lane * 8); }
#pragma unroll
        for (int k = 0; k < 3; ++k) { const int row = row0 + k * stride;
            if (row < NTOK) {
                float x[16];
#pragma unroll
                for (int i = 0; i < 2; ++i) { const u32x4 w = raw[k][i];
                    x[i * 8 + 0] = __uint_as_float(w.x << 16); x[i * 8 + 1] = __uint_as_float(w.x & 0xffff0000u); x[i * 8 + 2] = __uint_as_float(w.y << 16); x[i * 8 + 3] = __uint_as_float(w.y & 0xffff0000u);
                    x[i * 8 + 4] = __uint_as_float(w.z << 16); x[i * 8 + 5] = __uint_as_float(w.z & 0xffff0000u); x[i * 8 + 6] = __uint_as_float(w.w << 16); x[i * 8 + 7] = __uint_as_float(w.w & 0xffff0000u); }
                float ss = 0.f;
#pragma unroll
                for (int e = 0; e < 16; ++e) ss += x[e] * x[e];
                ss = wave_sum(ss);
                const float rstd = rsqrtf(ss * (1.0f / 1024.0f) + 1e-6f);
                float* yr = p.out + (size_t)row * 1024;
#pragma unroll
                for (int i = 0; i < 2; ++i) {
                    float4 o0, o1;
                    o0.x = x[i * 8 + 0] * rstd * gg[i * 8 + 0]; o0.y = x[i * 8 + 1] * rstd * gg[i * 8 + 1]; o0.z = x[i * 8 + 2] * rstd * gg[i * 8 + 2]; o0.w = x[i * 8 + 3] * rstd * gg[i * 8 + 3];
                    o1.x = x[i * 8 + 4] * rstd * gg[i * 8 + 4]; o1.y = x[i * 8 + 5] * rstd * gg[i * 8 + 5]; o1.z = x[i * 8 + 6] * rstd * gg[i * 8 + 6]; o1.w = x[i * 8 + 7] * rstd * gg[i * 8 + 7];
                    *(float4*)(yr + i * 512 + lane * 8) = o0; *(float4*)(yr + i * 512 + lane * 8 + 4) = o1; }
            } }
    }
}

constexpr float QSCALE = 0.125f * 1.4426950408889634f;
__device__ __forceinline__ u32x2 pk4(const f32x4& v) { u32x2 w; w.x = pg8::cvt_pk_bf16(v[0], v[1]); w.y = pg8::cvt_pk_bf16(v[2], v[3]); return w; }
__device__ __forceinline__ u32x4 pk8(const f32x4& a, const f32x4& b) { u32x4 w; w.x = pg8::cvt_pk_bf16(a[0], a[1]); w.y = pg8::cvt_pk_bf16(a[2], a[3]); w.z = pg8::cvt_pk_bf16(b[0], b[1]); w.w = pg8::cvt_pk_bf16(b[2], b[3]); return w; }

template <bool IN16>
struct EpiRes {
    static constexpr bool PERM = true, AFTER_DRAIN = false;
    const float* xa; const float* xb; const bf16_t* x16; bf16_t* xo; const float* gate;
    __device__ __forceinline__ void operator()(const f32x4 (&acc)[2][2][4][2], const pg8::Unit& u, int wr, int wc, int fr, int fq) const {
        const int row0 = u.pm * 256 + wr * 64 + fr, col0 = u.pn * 256 + wc * 32 + 8 * fq;
        const bool ctx = u.pm < 16;
        const int mi = ctx ? 0 : 1 + ((u.pm - 16) >> 2);
        const float* xbase = (ctx ? xa + (size_t)row0 * 1024 : xb + (size_t)(row0 - NCTX) * 1024) + col0;
        const bf16_t* x16b = x16 + (size_t)row0 * 1024 + col0;
        bf16_t* obase = xo + (size_t)row0 * 1024 + col0;
        f32x4 gv[2][2];
#pragma unroll
        for (int bj = 0; bj < 2; ++bj)
#pragma unroll
            for (int n = 0; n < 2; ++n) gv[bj][n] = *(const f32x4*)(gate + mi * 3072 + col0 + bj * 128 + 4 * n);
#pragma unroll
        for (int ai = 0; ai < 2; ++ai) {
            f32x4 xv[4][2][2];
#pragma unroll
            for (int m = 0; m < 4; ++m)
#pragma unroll
                for (int bj = 0; bj < 2; ++bj) {
                    const size_t off = (size_t)(ai * 128 + m * 16) * 1024 + bj * 128;
                    if (IN16) { const u32x4 w = *(const u32x4*)(x16b + off);
                        xv[m][bj][0] = (f32x4){__uint_as_float(w.x << 16), __uint_as_float(w.x & 0xffff0000u), __uint_as_float(w.y << 16), __uint_as_float(w.y & 0xffff0000u)};
                        xv[m][bj][1] = (f32x4){__uint_as_float(w.z << 16), __uint_as_float(w.z & 0xffff0000u), __uint_as_float(w.w << 16), __uint_as_float(w.w & 0xffff0000u)}; }
                    else { xv[m][bj][0] = __builtin_nontemporal_load((const f32x4*)(xbase + off)); xv[m][bj][1] = __builtin_nontemporal_load((const f32x4*)(xbase + off + 4)); }
                }
            __builtin_amdgcn_sched_barrier(0);
#pragma unroll
            for (int m = 0; m < 4; ++m)
#pragma unroll
                for (int bj = 0; bj < 2; ++bj)
                    *(u32x4*)(obase + (size_t)(ai * 128 + m * 16) * 1024 + bj * 128) = pk8(xv[m][bj][0] + gv[bj][0] * acc[ai][bj][m][0], xv[m][bj][1] + gv[bj][1] * acc[ai][bj][m][1]);
        }
    }
};

struct Epi1 {
    static constexpr bool PERM = true, AFTER_DRAIN = false;
    unsigned char* ws; float* out;
    __device__ __forceinline__ void operator()(const f32x4 (&acc)[2][2][4][2], const pg8::Unit& u, int wr, int wc, int fr, int fq) const {
        const int reg = u.pn >> 1, cb = (u.pn & 1) * 256 + wc * 32 + 8 * fq;
        const bool ctx = u.pm < 16;
        bf16_t* P0 = (bf16_t*)(ws + WS_P);
#pragma unroll
        for (int ai = 0; ai < 2; ++ai)
#pragma unroll
            for (int m = 0; m < 4; ++m) {
                const int row = u.pm * 256 + ai * 128 + wr * 64 + m * 16 + fr;
                const int lt = row - NCTX, b = ctx ? (row >> 8) : (lt >> 10), t = ctx ? (row & 255) : (lt & 1023);
#pragma unroll
                for (int bj = 0; bj < 2; ++bj) {
                    const int c = cb + bj * 128; const f32x4 v0 = acc[ai][bj][m][0], v1 = acc[ai][bj][m][1];
                    if (reg == 0) *(u32x4*)(P0 + (size_t)row * 2048 + c) = pk8(v0 * QSCALE, v1 * QSCALE);
                    else if (reg >= 3) *(u32x4*)(P0 + (size_t)row * 2048 + (reg - 2) * 512 + c) = pk8(v0, v1);
                    else if (reg == 1) {
                        if (ctx) { float* o = out + O_NAK + (size_t)row * 512 + c; *(f32x4*)o = v0; *(f32x4*)(o + 4) = v1;
                            *(u32x4*)((bf16_t*)(ws + WS_K0C) + (size_t)row * 512 + c) = pk8(v0, v1); }
                        else *(u32x4*)((bf16_t*)(ws + WS_K0L) + ((size_t)b * 1280 + 256 + t) * 512 + c) = pk8(v0, v1);
                    } else {
                        if (ctx) { float* o = out + O_NAV + (size_t)row * 512 + c; *(f32x4*)o = v0; *(f32x4*)(o + 4) = v1;
                            *(u32x4*)((bf16_t*)(ws + WS_V0C) + (size_t)row * 512 + c) = pk8(v0, v1); }
                        else *(u32x4*)((bf16_t*)(ws + WS_V0L) + ((size_t)b * 1280 + 256 + t) * 512 + c) = pk8(v0, v1);
                    }
                }
            }
    }
};

struct Epi3 {
    static constexpr bool PERM = true, AFTER_DRAIN = false;
    unsigned char* ws; float* out;
    __device__ __forceinline__ void operator()(const f32x4 (&acc)[2][2][4][2], const pg8::Unit& u, int wr, int wc, int fr, int fq) const {
        const int reg = u.pn >> 2, cb = (u.pn & 3) * 256 + wc * 32 + 8 * fq;
        const bool ctx = u.pm < 16;
        bf16_t* P1 = (bf16_t*)(ws + WS_P);
        const float* rc = (const float*)(ws + WS_ROPE);
        const bool rope = !ctx && reg < 2;
        const float sgn = fq >= 2 ? 1.0f : -1.0f;
#pragma unroll
        for (int ai = 0; ai < 2; ++ai) {
            f32x4 csv[4][2], snv[4][2];
            if (rope) {
#pragma unroll
                for (int m = 0; m < 4; ++m) { const int t = (u.pm * 256 + ai * 128 + wr * 64 + m * 16 + fr - NCTX) & 1023; const int pos = (wc & 1) ? (t & 63) : (t >> 6);
#pragma unroll
                    for (int n = 0; n < 2; ++n) { const int idx = pos * 16 + 8 * (fq & 1) + 4 * n; csv[m][n] = *(const f32x4*)(rc + idx); snv[m][n] = *(const f32x4*)(rc + 1024 + idx); } }
            }
#pragma unroll
            for (int m = 0; m < 4; ++m) {
                const int row = u.pm * 256 + ai * 128 + wr * 64 + m * 16 + fr;
                const int lt = row - NCTX, b = ctx ? (row >> 8) : (lt >> 10), t = ctx ? (row & 255) : (lt & 1023);
#pragma unroll
                for (int bj = 0; bj < 2; ++bj) {
                    f32x4 v0 = acc[ai][bj][m][0], v1 = acc[ai][bj][m][1];
                    if (rope) {
                        f32x4 p0, p1;
#pragma unroll
                        for (int j = 0; j < 4; ++j) { p0[j] = __shfl_xor(v0[j], 32); p1[j] = __shfl_xor(v1[j], 32); }
                        v0 = v0 * csv[m][0] + (p0 * snv[m][0]) * sgn; v1 = v1 * csv[m][1] + (p1 * snv[m][1]) * sgn;
                    }
                    const int c = cb + bj * 128;
                    if (reg == 0) *(u32x4*)(P1 + (size_t)row * 2048 + c) = pk8(v0 * QSCALE, v1 * QSCALE);
                    else if (reg == 3) *(u32x4*)(P1 + (size_t)row * 2048 + 1024 + c) = pk8(v0, v1);
                    else if (reg == 1) {
                        if (ctx) { float* o = out + O_DK + (size_t)row * 1024 + c; *(f32x4*)o = v0; *(f32x4*)(o + 4) = v1;
                            *(u32x4*)((bf16_t*)(ws + WS_K1C) + (size_t)row * 1024 + c) = pk8(v0, v1); }
                        else *(u32x4*)((bf16_t*)(ws + WS_K1L) + ((size_t)b * 1280 + 256 + t) * 1024 + c) = pk8(v0, v1);
                    } else {
                        if (ctx) { float* o = out + O_DV + (size_t)row * 1024 + c; *(f32x4*)o = v0; *(f32x4*)(o + 4) = v1;
                            *(u32x4*)((bf16_t*)(ws + WS_V1C) + (size_t)row * 1024 + c) = pk8(v0, v1); }
                        else *(u32x4*)((bf16_t*)(ws + WS_V1L) + ((size_t)b * 1280 + 256 + t) * 1024 + c) = pk8(v0, v1);
                    }
                }
            }
        }
    }
};
#define MFMA16(a, b, c) __builtin_amdgcn_mfma_f32_16x16x32_bf16(a, b, c, 0, 0, 0)
constexpr float SC_LOG2 = 0.125f * 1.4426950408889634f;
constexpr float LOG2E = 1.4426950408889634f;
constexpr float RS_TAU = 8.0f;
__device__ __forceinline__ float ex2(float x) { return __builtin_amdgcn_exp2f(x); }
__device__ __forceinline__ bf16x8 pack8(const float (&v)[8]) {
    u32x4 w; w.x = pg8::cvt_pk_bf16(v[0], v[1]); w.y = pg8::cvt_pk_bf16(v[2], v[3]); w.z = pg8::cvt_pk_bf16(v[4], v[5]); w.w = pg8::cvt_pk_bf16(v[6], v[7]);
    return __builtin_bit_cast(bf16x8, w);
}
__device__ __forceinline__ bf16x8 cat2(u32x2 a, u32x2 b) { u32x4 w; w.x = a.x; w.y = a.y; w.z = b.x; w.w = b.y; return __builtin_bit_cast(bf16x8, w); }

template <int DK, int DV> struct ACfg {
    static constexpr int KP = DK * 2 + 16, VP = 136;
    static constexpr int KBYTES = 64 * KP, VBYTES = DV * VP, STAGE = KBYTES + VBYTES;
    static constexpr int NK = DK / 64, NV = DV / 64;
};
template <int DK, int DV>
__device__ __forceinline__ void stage_load(const bf16_t* Ksrc, size_t ldk, const bf16_t* Vsrc, size_t ldv, u32x4 (&kr)[DK / 64], u32x4 (&vr)[DV / 64], int tid) {
#pragma unroll
    for (int i = 0; i < DK / 64; ++i) { const int idx = tid + i * 512, row = idx / (DK / 8), pc = idx % (DK / 8); kr[i] = *(const u32x4*)(Ksrc + (size_t)row * ldk + pc * 8); }
#pragma unroll
    for (int i = 0; i < DV / 64; ++i) { const int idx = tid + i * 512, key = idx & 63, pc = idx >> 6; vr[i] = *(const u32x4*)(Vsrc + (size_t)key * ldv + pc * 8); }
}
template <int DK, int DV>
__device__ __forceinline__ void stage_store(LAS unsigned char* base, const u32x4 (&kr)[DK / 64], const u32x4 (&vr)[DV / 64], int tid) {
    typedef ACfg<DK, DV> C;
#pragma unroll
    for (int i = 0; i < DK / 64; ++i) { const int idx = tid + i * 512, row = idx / (DK / 8), pc = idx % (DK / 8); *(LAS u32x4*)(base + row * C::KP + pc * 16) = kr[i]; }
#pragma unroll
    for (int i = 0; i < DV / 64; ++i) { const int idx = tid + i * 512, key = idx & 63, pc = idx >> 6;
        LAS unsigned char* d = base + C::KBYTES + (pc * 8) * C::VP + key * 2;
        *(LAS unsigned short*)(d + 0 * C::VP) = (unsigned short)(vr[i].x & 0xffffu); *(LAS unsigned short*)(d + 1 * C::VP) = (unsigned short)(vr[i].x >> 16);
        *(LAS unsigned short*)(d + 2 * C::VP) = (unsigned short)(vr[i].y & 0xffffu); *(LAS unsigned short*)(d + 3 * C::VP) = (unsigned short)(vr[i].y >> 16);
        *(LAS unsigned short*)(d + 4 * C::VP) = (unsigned short)(vr[i].z & 0xffffu); *(LAS unsigned short*)(d + 5 * C::VP) = (unsigned short)(vr[i].z >> 16);
        *(LAS unsigned short*)(d + 6 * C::VP) = (unsigned short)(vr[i].w & 0xffffu); *(LAS unsigned short*)(d + 7 * C::VP) = (unsigned short)(vr[i].w >> 16); }
}

struct St1 { f32x4 O[4]; float m, l; };
template <bool BIAS>
__device__ __forceinline__ void chunk1(const LAS unsigned char* kt, const LAS unsigned char* vt, int fr, int fq, const bf16x8 (&qf)[2], St1& st, const float (&bias)[8]) {
    typedef ACfg<64, 64> C;
    const LAS unsigned char* kl = kt + fr * C::KP + fq * 16;
    const LAS unsigned char* vl = vt + fr * C::VP + fq * 8;
    const bf16x8 k00 = *(const LAS bf16x8*)(kl), k01 = *(const LAS bf16x8*)(kl + 64), k10 = *(const LAS bf16x8*)(kl + 16 * C::KP), k11 = *(const LAS bf16x8*)(kl + 16 * C::KP + 64);
    u32x2 va[4], vb[4];
#pragma unroll
    for (int db = 0; db < 4; ++db) { va[db] = *(const LAS u32x2*)(vl + db * 16 * C::VP); vb[db] = *(const LAS u32x2*)(vl + db * 16 * C::VP + 32); }
    f32x4 s0 = {0.f, 0.f, 0.f, 0.f}, s1 = {0.f, 0.f, 0.f, 0.f};
    s0 = MFMA16(k00, qf[0], s0); s0 = MFMA16(k01, qf[1], s0); s1 = MFMA16(k10, qf[0], s1); s1 = MFMA16(k11, qf[1], s1);
    float sv[8];
#pragma unroll
    for (int j = 0; j < 4; ++j) { sv[j] = s0[j]; sv[4 + j] = s1[j]; }
    if (BIAS) {
#pragma unroll
        for (int i = 0; i < 8; ++i) sv[i] += bias[i];
    }
    float cm = fmaxf(fmaxf(fmaxf(sv[0], sv[1]), fmaxf(sv[2], sv[3])), fmaxf(fmaxf(sv[4], sv[5]), fmaxf(sv[6], sv[7])));
    cm = fmaxf(cm, __shfl_xor(cm, 16)); cm = fmaxf(cm, __shfl_xor(cm, 32));
    float mn = st.m;
    if (__builtin_amdgcn_ballot_w64(cm > st.m + RS_TAU)) {
        mn = fmaxf(st.m, cm);
        const float al = ex2(st.m - mn);
        st.l *= al;
#pragma unroll
        for (int db = 0; db < 4; ++db) st.O[db] *= al;
        st.m = mn;
    }
    float ps = 0.f;
#pragma unroll
    for (int i = 0; i < 8; ++i) { sv[i] = ex2(sv[i] - mn); ps += sv[i]; }
    st.l += ps;
    const bf16x8 pf = pack8(sv);
#pragma unroll
    for (int db = 0; db < 4; ++db) st.O[db] = MFMA16(cat2(va[db], vb[db]), pf, st.O[db]);
}

struct St2 { f32x4 O1[8], O2[8]; float m1, l1, m2, l2; };
__device__ __forceinline__ void qk_sm2(const LAS unsigned char* kt, int fr, int fq, const bf16x8 (&qf)[4], St2& st, bf16x8 (&pf1)[2], bf16x8 (&pf2)[2]) {
    typedef ACfg<128, 128> C;
    const LAS unsigned char* kl = kt + fr * C::KP + fq * 16;
    f32x4 a[4], b[4];
#pragma unroll
    for (int kh = 0; kh < 2; ++kh) {
        bf16x8 kf[2][4];
#pragma unroll
        for (int k2 = 0; k2 < 2; ++k2)
#pragma unroll
            for (int i = 0; i < 4; ++i) kf[k2][i] = *(const LAS bf16x8*)(kl + (kh * 2 + k2) * 16 * C::KP + i * 64);
        __builtin_amdgcn_sched_barrier(0);
#pragma unroll
        for (int k2 = 0; k2 < 2; ++k2) { const int kb = kh * 2 + k2;
            a[kb] = (f32x4){0.f, 0.f, 0.f, 0.f}; b[kb] = (f32x4){0.f, 0.f, 0.f, 0.f};
            a[kb] = MFMA16(kf[k2][0], qf[0], a[kb]); a[kb] = MFMA16(kf[k2][1], qf[1], a[kb]);
            b[kb] = MFMA16(kf[k2][2], qf[2], b[kb]); b[kb] = MFMA16(kf[k2][3], qf[3], b[kb]); }
    }
    float c1 = fmaxf(fmaxf(a[0][0], a[0][1]), fmaxf(a[0][2], a[0][3])), c2 = fmaxf(fmaxf(b[0][0], b[0][1]), fmaxf(b[0][2], b[0][3]));
#pragma unroll
    for (int kb = 1; kb < 4; ++kb) { c1 = fmaxf(c1, fmaxf(fmaxf(a[kb][0], a[kb][1]), fmaxf(a[kb][2], a[kb][3]))); c2 = fmaxf(c2, fmaxf(fmaxf(b[kb][0], b[kb][1]), fmaxf(b[kb][2], b[kb][3]))); }
    c1 = fmaxf(c1, __shfl_xor(c1, 16)); c1 = fmaxf(c1, __shfl_xor(c1, 32));
    c2 = fmaxf(c2, __shfl_xor(c2, 16)); c2 = fmaxf(c2, __shfl_xor(c2, 32));
    float n1 = st.m1, n2 = st.m2;
    const bool grow = (c1 > st.m1 + RS_TAU) || (c2 > st.m2 + RS_TAU);
    if (__builtin_amdgcn_ballot_w64(grow)) {
        n1 = fmaxf(st.m1, c1); n2 = fmaxf(st.m2, c2);
        const float al1 = ex2(st.m1 - n1), al2 = ex2(st.m2 - n2);
        st.l1 *= al1; st.l2 *= al2;
#pragma unroll
        for (int db = 0; db < 8; ++db) { st.O1[db] *= al1; st.O2[db] *= al2; }
        st.m1 = n1; st.m2 = n2;
    }
    float p1 = 0.f, p2 = 0.f;
#pragma unroll
    for (int hf = 0; hf < 2; ++hf) {
        float e1[8], e2[8];
#pragma unroll
        for (int j = 0; j < 4; ++j) { e1[j] = ex2(a[2 * hf][j] - n1); e1[4 + j] = ex2(a[2 * hf + 1][j] - n1); e2[j] = ex2(b[2 * hf][j] - n2); e2[4 + j] = ex2(b[2 * hf + 1][j] - n2); }
#pragma unroll
        for (int i = 0; i < 8; ++i) { p1 += e1[i]; p2 += e2[i]; }
        pf1[hf] = pack8(e1); pf2[hf] = pack8(e2);
    }
    st.l1 += p1; st.l2 += p2;
}
__device__ __forceinline__ void pv2(const LAS unsigned char* vt, int fr, int fq, const bf16x8 (&pf1)[2], const bf16x8 (&pf2)[2], St2& st) {
    typedef ACfg<128, 128> C;
    const LAS unsigned char* vl = vt + fr * C::VP + fq * 8;
#pragma unroll
    for (int dg = 0; dg < 2; ++dg) {
        u32x2 va[4][2], vb[4][2];
#pragma unroll
        for (int d4 = 0; d4 < 4; ++d4)
#pragma unroll
            for (int hf = 0; hf < 2; ++hf) { va[d4][hf] = *(const LAS u32x2*)(vl + (dg * 4 + d4) * 16 * C::VP + hf * 64); vb[d4][hf] = *(const LAS u32x2*)(vl + (dg * 4 + d4) * 16 * C::VP + hf * 64 + 32); }
        __builtin_amdgcn_sched_barrier(0);
#pragma unroll
        for (int d4 = 0; d4 < 4; ++d4)
#pragma unroll
            for (int hf = 0; hf < 2; ++hf) { const int db = dg * 4 + d4; const bf16x8 vf = cat2(va[d4][hf], vb[d4][hf]);
                st.O1[db] = MFMA16(vf, pf1[hf], st.O1[db]);
                st.O2[db] = MFMA16(vf, pf2[hf], st.O2[db]); }
    }
}

__device__ __forceinline__ void step1(const LAS unsigned char* kt, const LAS unsigned char* vt, int fr, int fq, const bf16x8 (&qf)[2], St1& st) {
    typedef ACfg<64, 64> C;
    const LAS unsigned char* kl = kt + fr * C::KP + fq * 16;
    const LAS unsigned char* vl = vt + fr * C::VP + fq * 8;
    f32x4 a[4];
    {
        bf16x8 kf[4][2];
#pragma unroll
        for (int kb = 0; kb < 4; ++kb) { kf[kb][0] = *(const LAS bf16x8*)(kl + kb * 16 * C::KP); kf[kb][1] = *(const LAS bf16x8*)(kl + kb * 16 * C::KP + 64); }
        __builtin_amdgcn_sched_barrier(0);
#pragma unroll
        for (int kb = 0; kb < 4; ++kb) { a[kb] = (f32x4){0.f, 0.f, 0.f, 0.f}; a[kb] = MFMA16(kf[kb][0], qf[0], a[kb]); a[kb] = MFMA16(kf[kb][1], qf[1], a[kb]); }
    }
    float c1 = fmaxf(fmaxf(a[0][0], a[0][1]), fmaxf(a[0][2], a[0][3]));
#pragma unroll
    for (int kb = 1; kb < 4; ++kb) c1 = fmaxf(c1, fmaxf(fmaxf(a[kb][0], a[kb][1]), fmaxf(a[kb][2], a[kb][3])));
    c1 = fmaxf(c1, __shfl_xor(c1, 16)); c1 = fmaxf(c1, __shfl_xor(c1, 32));
    float n1 = st.m;
    if (__builtin_amdgcn_ballot_w64(c1 > st.m + RS_TAU)) {
        n1 = fmaxf(st.m, c1);
        const float al = ex2(st.m - n1);
        st.l *= al;
#pragma unroll
        for (int db = 0; db < 4; ++db) st.O[db] *= al;
        st.m = n1;
    }
    float p1 = 0.f;
    bf16x8 pf[2];
#pragma unroll
    for (int hf = 0; hf < 2; ++hf) {
        float e1[8];
#pragma unroll
        for (int j = 0; j < 4; ++j) { e1[j] = ex2(a[2 * hf][j] - n1); e1[4 + j] = ex2(a[2 * hf + 1][j] - n1); }
#pragma unroll
        for (int i = 0; i < 8; ++i) p1 += e1[i];
        pf[hf] = pack8(e1);
    }
    st.l += p1;
    {
        u32x2 va[4][2], vb[4][2];
#pragma unroll
        for (int db = 0; db < 4; ++db)
#pragma unroll
            for (int hf = 0; hf < 2; ++hf) { va[db][hf] = *(const LAS u32x2*)(vl + db * 16 * C::VP + hf * 64); vb[db][hf] = *(const LAS u32x2*)(vl + db * 16 * C::VP + hf * 64 + 32); }
        __builtin_amdgcn_sched_barrier(0);
#pragma unroll
        for (int db = 0; db < 4; ++db)
#pragma unroll
            for (int hf = 0; hf < 2; ++hf) st.O[db] = MFMA16(cat2(va[db][hf], vb[db][hf]), pf[hf], st.O[db]);
    }
}

constexpr int A0_RPB_OFF = 36864;
__device__ __forceinline__ void attn0_item(const Params& p, int item, LAS unsigned char* lds) {
    typedef ACfg<64, 64> C;
    const int tid = tidx(), lane = tid & 63, w = tid >> 6, fr = lane & 15, fq = lane >> 4;
    const bf16_t* P0 = (const bf16_t*)(p.ws + WS_P);
    bf16_t* Y = (bf16_t*)(p.ws + WS_Y);
    St1 st;
#pragma unroll
    for (int db = 0; db < 4; ++db) st.O[db] = (f32x4){0.f, 0.f, 0.f, 0.f};
    st.m = -1e30f; st.l = 0.f;
    bf16x8 qf[2]; int tok, h;
    float bias[8];
#pragma unroll
    for (int i = 0; i < 8; ++i) bias[i] = 0.f;
    const bf16_t* K; const bf16_t* V; size_t ldv; int nsteps, nwin, rs0, r = 0, rs = 0, span0 = 0, qc = 0, cs = 0;
    LAS float* rpbs = (LAS float*)(lds + A0_RPB_OFF);
    __syncthreads();
    if (item < 512) {
        const int b = item >> 6; h = (item >> 3) & 7; const int rp = item & 7;
        r = 2 * rp + (w >> 2); const int cq = w & 3, c0 = cq * 16;
        tok = NCTX + b * 1024 + r * 64 + c0 + fr;
        span0 = cq == 0 ? 0 : (cq == 1 ? 8 : (cq == 2 ? 24 : 32));
        rs = min(max(r - 4, 0), 8); qc = c0 + fr; cs = min(max(qc - 8, 0), 48);
        rs0 = min(max(2 * rp - 4, 0), 8); const int rs1 = min(max(2 * rp - 3, 0), 8); nwin = 8 + rs1 - rs0; nsteps = nwin + 4;
        K = (const bf16_t*)(p.ws + WS_K0L) + (size_t)b * 1280 * 512 + h * 64;
        V = (const bf16_t*)(p.ws + WS_V0L) + (size_t)b * 1280 * 512 + h * 64; ldv = 512;
        if (tid < 465) rpbs[tid] = p.in[13][h * 465 + tid] * LOG2E;
    } else {
        const int it = item - 512; const int b = it >> 4; h = (it >> 1) & 7; const int qb = it & 1;
        tok = b * 256 + qb * 128 + w * 16 + fr;
        nwin = 0; nsteps = 4; rs0 = 0;
        K = (const bf16_t*)(p.ws + WS_K0C) + (size_t)b * 256 * 512 + h * 64;
        V = (const bf16_t*)(p.ws + WS_V0C) + (size_t)b * 256 * 512 + h * 64; ldv = 512;
    }
    qf[0] = *(const bf16x8*)(P0 + (size_t)tok * 2048 + h * 64 + fq * 8); qf[1] = *(const bf16x8*)(P0 + (size_t)tok * 2048 + h * 64 + 32 + fq * 8);
    u32x2 gwv[4];
#pragma unroll
    for (int db = 0; db < 4; ++db) gwv[db] = *(const u32x2*)(P0 + (size_t)tok * 2048 + 512 + h * 64 + db * 16 + fq * 4);
#define A0_KEY0(s) ((s) < nwin ? 256 + (rs0 + (s)) * 64 : ((s) - nwin) * 64)
#define A0_LOAD(s, KR, VR) do { const int _k0 = A0_KEY0(s); stage_load<64, 64>(K + (size_t)_k0 * 512, 512, V + (size_t)_k0 * 512, ldv, KR, VR, tid); } while (0)
#define A0_COMPUTE(s, cur) do { \
        if ((s) < nwin) { const int krow = rs0 + (s); \
            if (krow >= rs && krow < rs + 8) { const LAS float* rb = rpbs + (krow - r + 7) * 31; \
                _Pragma("unroll") for (int i = 0; i < 8; ++i) { const int kc = span0 + (i >> 2) * 16 + fq * 4 + (i & 3); \
                    const bool ok = kc >= cs && kc < cs + 16; const int dc = min(max(kc - qc + 15, 0), 30); bias[i] = ok ? rb[dc] : -1e30f; } \
                chunk1<true>((cur) + span0 * C::KP, (cur) + C::KBYTES + span0 * 2, fr, fq, qf, st, bias); } \
        } else step1((cur), (cur) + C::KBYTES, fr, fq, qf, st); } while (0)
    u32x4 krA[1], vrA[1], krB[1], vrB[1];
    A0_LOAD(0, krA, vrA);
    A0_LOAD(1, krB, vrB);
    stage_store<64, 64>(lds, krA, vrA, tid);
    __syncthreads();
    for (int s = 0; s < nsteps; s += 2) {
        if (s + 2 < nsteps) A0_LOAD(s + 2, krA, vrA);
        A0_COMPUTE(s, lds);
        if (s + 1 < nsteps) stage_store<64, 64>(lds + C::STAGE, krB, vrB, tid);
        __syncthreads();
        if (s + 1 >= nsteps) break;
        if (s + 3 < nsteps) A0_LOAD(s + 3, krB, vrB);
        A0_COMPUTE(s + 1, lds + C::STAGE);
        if (s + 2 < nsteps) stage_store<64, 64>(lds, krA, vrA, tid);
        __syncthreads();
    }
#undef A0_KEY0
#undef A0_LOAD
#undef A0_COMPUTE
    float l = st.l; l += __shfl_xor(l, 16); l += __shfl_xor(l, 32);
    const float il = 1.0f / l;
#pragma unroll
    for (int db = 0; db < 4; ++db) {
        const int d = db * 16 + fq * 4;
        const u32x2 gw = gwv[db];
        f32x4 o;
        o[0] = st.O[db][0] * il * silu_f(__uint_as_float(gw.x << 16)); o[1] = st.O[db][1] * il * silu_f(__uint_as_float(gw.x & 0xffff0000u));
        o[2] = st.O[db][2] * il * silu_f(__uint_as_float(gw.y << 16)); o[3] = st.O[db][3] * il * silu_f(__uint_as_float(gw.y & 0xffff0000u));
        *(u32x2*)(Y + (size_t)tok * 1024 + h * 64 + d) = pk4(o);
    }
}

__device__ __forceinline__ void attn1_item(const Params& p, int item, float lam, LAS unsigned char* lds) {
    typedef ACfg<128, 128> C;
    const int tid = tidx(), lane = tid & 63, w = tid >> 6, fr = lane & 15, fq = lane >> 4;
    const bf16_t* P1 = (const bf16_t*)(p.ws + WS_P);
    bf16_t* Y = (bf16_t*)(p.ws + WS_Y);
    St2 st;
#pragma unroll
    for (int db = 0; db < 8; ++db) { st.O1[db] = (f32x4){0.f, 0.f, 0.f, 0.f}; st.O2[db] = (f32x4){0.f, 0.f, 0.f, 0.f}; }
    st.m1 = -1e30f; st.l1 = 0.f; st.m2 = -1e30f; st.l2 = 0.f;
    int tok, h, nst; const bf16_t* K; const bf16_t* V; size_t ldv;
    if (item < 512) {
        const int b = item >> 6; h = (item >> 3) & 7; const int qb = item & 7;
        tok = NCTX + b * 1024 + qb * 128 + w * 16 + fr; nst = 20;
        K = (const bf16_t*)(p.ws + WS_K1L) + (size_t)b * 1280 * 1024 + h * 128;
        V = (const bf16_t*)(p.ws + WS_V1L) + (size_t)b * 1280 * 1024 + h * 128; ldv = 1024;
    } else {
        const int it = item - 512; const int b = it >> 4; h = (it >> 1) & 7; const int qb = it & 1;
        tok = b * 256 + qb * 128 + w * 16 + fr; nst = 4;
        K = (const bf16_t*)(p.ws + WS_K1C) + (size_t)b * 256 * 1024 + h * 128;
        V = (const bf16_t*)(p.ws + WS_V1C) + (size_t)b * 256 * 1024 + h * 128; ldv = 1024;
    }
    bf16x8 qf[4];
#pragma unroll
    for (int i = 0; i < 4; ++i) qf[i] = *(const bf16x8*)(P1 + (size_t)tok * 2048 + h * 128 + i * 32 + fq * 8);
    u32x2 gwv[8];
#pragma unroll
    for (int db = 0; db < 8; ++db) gwv[db] = *(const u32x2*)(P1 + (size_t)tok * 2048 + 1024 + h * 128 + db * 16 + fq * 4);
    u32x4 kr[2], vr[2];
    bf16x8 pf1[2], pf2[2];
    const bool late = w >= 4;
    __syncthreads();
    stage_load<128, 128>(K, 1024, V, ldv, kr, vr, tid); stage_store<128, 128>(lds, kr, vr, tid);
    __syncthreads();
    int bc = 0, bp = 2;
    if (late) __builtin_amdgcn_s_setprio(1);
    for (int s = 0; s < nst; ++s) {
        LAS unsigned char* cur = lds + bc * C::STAGE;
        const int bn = bc == 2 ? 0 : bc + 1;
        if (s + 1 < nst) stage_load<128, 128>(K + (size_t)(s + 1) * 64 * 1024, 1024, V + (size_t)(s + 1) * 64 * 1024, ldv, kr, vr, tid);
        if (late) {
            if (s > 0) pv2(lds + bp * C::STAGE + C::KBYTES, fr, fq, pf1, pf2, st);
            qk_sm2(cur, fr, fq, qf, st, pf1, pf2);
        } else {
            qk_sm2(cur, fr, fq, qf, st, pf1, pf2);
            pv2(cur + C::KBYTES, fr, fq, pf1, pf2, st);
        }
        if (s + 1 < nst) stage_store<128, 128>(lds + bn * C::STAGE, kr, vr, tid);
        __syncthreads();
        bp = bc; bc = bn;
    }
    if (late) pv2(lds + bp * C::STAGE + C::KBYTES, fr, fq, pf1, pf2, st);
    __builtin_amdgcn_s_setprio(0);
    float l1 = st.l1; l1 += __shfl_xor(l1, 16); l1 += __shfl_xor(l1, 32);
    float l2 = st.l2; l2 += __shfl_xor(l2, 16); l2 += __shfl_xor(l2, 32);
    const float i1 = 1.0f / l1, i2 = lam / l2;
    float ss = 0.f;
#pragma unroll
    for (int db = 0; db < 8; ++db) { st.O1[db] = st.O1[db] * i1 - st.O2[db] * i2;
        ss += st.O1[db][0] * st.O1[db][0] + st.O1[db][1] * st.O1[db][1] + st.O1[db][2] * st.O1[db][2] + st.O1[db][3] * st.O1[db][3]; }
    ss += __shfl_xor(ss, 16); ss += __shfl_xor(ss, 32);
    const float rstd = rsqrtf(ss * (1.0f / 128.0f) + 1e-6f) * (1.0f - LAM_INIT);
    f32x4 sgv[8];
#pragma unroll
    for (int db = 0; db < 8; ++db) sgv[db] = *(const f32x4*)(p.in[30] + db * 16 + fq * 4);
    __builtin_amdgcn_sched_barrier(0);
#pragma unroll
    for (int db = 0; db < 8; ++db) {
        const int d = db * 16 + fq * 4;
        const u32x2 gw = gwv[db];
        const f32x4 sg = sgv[db];
        f32x4 o;
        o[0] = st.O1[db][0] * rstd * sg[0] * silu_f(__uint_as_float(gw.x << 16)); o[1] = st.O1[db][1] * rstd * sg[1] * silu_f(__uint_as_float(gw.x & 0xffff0000u));
        o[2] = st.O1[db][2] * rstd * sg[2] * silu_f(__uint_as_float(gw.y << 16)); o[3] = st.O1[db][3] * rstd * sg[3] * silu_f(__uint_as_float(gw.y & 0xffff0000u));
        *(u32x2*)(Y + (size_t)tok * 1024 + h * 128 + d) = pk4(o);
    }
}
__device__ __forceinline__ float sigm(float x) { return __builtin_amdgcn_rcpf(1.0f + ex2(-LOG2E * x)); }
__device__ __forceinline__ void lru_item(const Params& p, int item, float* sm) {
    const int tid = tidx(), lane = tid & 63, w = tid >> 6, fr = lane & 15, fq = lane >> 4;
    int s, n; if (item < 64) { s = 16 + (item >> 3); n = item & 7; } else { s = (item - 64) >> 3; n = (item - 64) & 7; }
    const bool lat = s >= 16;
    const int T = lat ? 1024 : 256, tok0 = lat ? NCTX + (s - 16) * 1024 : s * 256, nchunk = T >> 8;
    const bf16_t* P0 = (const bf16_t*)(p.ws + WS_P); bf16_t* Y = (bf16_t*)(p.ws + WS_Y); float* Hf = (float*)(p.ws + WS_HF);
    const bf16_t* Wg = (const bf16_t*)(p.ws + WS_WG);
    float* xcs = sm; float* seg = sm + 256 * 68;
    const int cg8 = (tid & 7) * 8, q0 = tid >> 3;
    for (int dir = 0; dir < 2; ++dir) {
        float ba[4], bx[4], nl[4], carry[4];
#pragma unroll
        for (int dt = 0; dt < 4; ++dt) { const int ch = n * 64 + dt * 16 + fr;
            ba[dt] = p.in[17][dir * 512 + ch]; bx[dt] = p.in[19][dir * 512 + ch]; nl[dt] = -8.0f * LOG2E * log1pf(__expf(-p.in[20][dir * 512 + ch]));
            carry[dt] = lat ? p.in[5][((s - 16) * 2 + dir) * 512 + ch] : 0.f;
        }
        for (int ck = 0; ck < nchunk; ++ck) {
            __syncthreads();
            {
                float cw[4][8], cbv[8];
#pragma unroll
                for (int j = 0; j < 4; ++j) { const f32x4 a = *(const f32x4*)(p.in[14] + j * 512 + n * 64 + cg8), b = *(const f32x4*)(p.in[14] + j * 512 + n * 64 + cg8 + 4);
#pragma unroll
                    for (int k = 0; k < 4; ++k) { cw[j][k] = a[k]; cw[j][4 + k] = b[k]; } }
                { const f32x4 a = *(const f32x4*)(p.in[15] + n * 64 + cg8), b = *(const f32x4*)(p.in[15] + n * 64 + cg8 + 4);
#pragma unroll
                    for (int k = 0; k < 4; ++k) { cbv[k] = a[k]; cbv[4 + k] = b[k]; } }
                u32x4 wv[4][4];
#pragma unroll
                for (int i = 0; i < 4; ++i) {
                    const int q = q0 + 64 * i, pp = ck * 256 + q, t = dir ? T - 1 - pp : pp;
#pragma unroll
                    for (int j = 0; j < 4; ++j) { const int tt = min(max(t - 2 + j, 0), T - 1);
                        wv[i][j] = *(const u32x4*)(P0 + (size_t)(tok0 + tt) * 2048 + 1024 + n * 64 + cg8); }
                }
#pragma unroll
                for (int i = 0; i < 4; ++i) {
                    const int q = q0 + 64 * i, pp = ck * 256 + q, t = dir ? T - 1 - pp : pp;
                    float xc[8];
#pragma unroll
                    for (int k = 0; k < 8; ++k) xc[k] = cbv[k];
#pragma unroll
                    for (int j = 0; j < 4; ++j) { const int tt = t - 2 + j; const float ok = (tt >= 0 && tt < T) ? 1.0f : 0.0f; const u32x4 w4 = wv[i][j];
                        xc[0] += ok * cw[j][0] * __uint_as_float(w4.x << 16); xc[1] += ok * cw[j][1] * __uint_as_float(w4.x & 0xffff0000u);
                        xc[2] += ok * cw[j][2] * __uint_as_float(w4.y << 16); xc[3] += ok * cw[j][3] * __uint_as_float(w4.y & 0xffff0000u);
                        xc[4] += ok * cw[j][4] * __uint_as_float(w4.z << 16); xc[5] += ok * cw[j][5] * __uint_as_float(w4.z & 0xffff0000u);
                        xc[6] += ok * cw[j][6] * __uint_as_float(w4.w << 16); xc[7] += ok * cw[j][7] * __uint_as_float(w4.w & 0xffff0000u); }
                    *(f32x4*)(xcs + q * 68 + cg8) = (f32x4){xc[0], xc[1], xc[2], xc[3]};
                    *(f32x4*)(xcs + q * 68 + cg8 + 4) = (f32x4){xc[4], xc[5], xc[6], xc[7]};
                }
            }
            bf16x8 wfa[2][2], wfx[2][2];
#define LRU_WF(dt_, sl_) do { _Pragma("unroll") for (int ks = 0; ks < 2; ++ks) { \
                wfa[sl_][ks] = *(const bf16x8*)(Wg + (size_t)((((dir * 2 + 0) * 8 + n) * 64) + (dt_) * 16 + fr) * 64 + ks * 32 + fq * 8); \
                wfx[sl_][ks] = *(const bf16x8*)(Wg + (size_t)((((dir * 2 + 1) * 8 + n) * 64) + (dt_) * 16 + fr) * 64 + ks * 32 + fq * 8); } } while (0)
            LRU_WF(0, 0);
            __syncthreads();
            bf16x8 af[2][2];
#pragma unroll
            for (int tt = 0; tt < 2; ++tt)
#pragma unroll
                for (int ks = 0; ks < 2; ++ks) { const float* src = xcs + (w * 32 + tt * 16 + fr) * 68 + ks * 32 + fq * 8;
                    const f32x4 x0 = *(const f32x4*)src, x1 = *(const f32x4*)(src + 4);
                    const float v[8] = {x0[0], x0[1], x0[2], x0[3], x1[0], x1[1], x1[2], x1[3]};
                    af[tt][ks] = pack8(v); }
            float hl[2][4][4], ap[2][4][4], Aex[2][4], Hex[2][4];
#pragma unroll
            for (int dt = 0; dt < 4; ++dt) {
                float At0 = 1.f, Ht0 = 0.f;
                if (dt < 3) LRU_WF(dt + 1, (dt + 1) & 1);
#pragma unroll
                for (int tt = 0; tt < 2; ++tt) {
                    f32x4 ca = {0.f, 0.f, 0.f, 0.f}, cx = {0.f, 0.f, 0.f, 0.f};
#pragma unroll
                    for (int ks = 0; ks < 2; ++ks) { ca = MFMA16(af[tt][ks], wfa[dt & 1][ks], ca); cx = MFMA16(af[tt][ks], wfx[dt & 1][ks], cx); }
                    float h = 0.f, A = 1.f;
#pragma unroll
                    for (int j = 0; j < 4; ++j) {
                        const float xcv = xcs[(w * 32 + tt * 16 + fq * 4 + j) * 68 + dt * 16 + fr];
                        const float rr = sigm(ca[j] + ba[dt]), ii = sigm(cx[j] + bx[dt]);
                        const float a = ex2(rr * nl[dt]), uu = __builtin_amdgcn_sqrtf(fmaxf(1.0f - a * a, 0.f)) * (ii * xcv);
                        h = a * h + uu; A *= a; hl[tt][dt][j] = h; ap[tt][dt][j] = A;
                    }
                    { const float A1 = __shfl_up(A, 16), H1 = __shfl_up(h, 16); if (fq >= 1) { h = A * H1 + h; A = A * A1; } }
                    { const float A2 = __shfl_up(A, 32), H2 = __shfl_up(h, 32); if (fq >= 2) { h = A * H2 + h; A = A * A2; } }
                    float Ae = __shfl_up(A, 16), He = __shfl_up(h, 16); if (fq == 0) { Ae = 1.f; He = 0.f; }
                    const float At = __shfl(A, 48 + fr), Ht = __shfl(h, 48 + fr);
                    if (tt == 0) { Aex[0][dt] = Ae; Hex[0][dt] = He; At0 = At; Ht0 = Ht; }
                    else { Aex[1][dt] = At0 * Ae; Hex[1][dt] = Ae * Ht0 + He;
                        if (fq == 0) { seg[(w * 64 + dt * 16 + fr) * 2] = At0 * At; seg[(w * 64 + dt * 16 + fr) * 2 + 1] = At * Ht0 + Ht; } }
                }
            }
            __syncthreads();
#pragma unroll
            for (int dt = 0; dt < 4; ++dt) {
                float hc = carry[dt], hin = hc;
#pragma unroll
                for (int w2 = 0; w2 < 8; ++w2) { const float A = seg[(w2 * 64 + dt * 16 + fr) * 2], H = seg[(w2 * 64 + dt * 16 + fr) * 2 + 1];
                    hc = A * hc + H; if (w2 + 1 == w) hin = hc; }
                carry[dt] = hc;
#pragma unroll
                for (int tt = 0; tt < 2; ++tt) {
                    const float hs = Aex[tt][dt] * hin + Hex[tt][dt];
#pragma unroll
                    for (int j = 0; j < 4; ++j) xcs[(w * 32 + tt * 16 + fq * 4 + j) * 68 + dt * 16 + fr] = ap[tt][dt][j] * hs + hl[tt][dt][j];
                }
            }
            const int tid2 = tidx();
            f32x4 hfa[4][2]; u32x4 gba[4];
            if (dir == 1) {
#pragma unroll
                for (int i = 0; i < 4; ++i) { const int piece = tid2 + i * 512, q = piece >> 3, c8 = (piece & 7) * 8; const size_t tk = (size_t)(tok0 + T - 1 - (ck * 256 + q));
                    hfa[i][0] = *(const f32x4*)(Hf + tk * 512 + n * 64 + c8); hfa[i][1] = *(const f32x4*)(Hf + tk * 512 + n * 64 + c8 + 4);
                    gba[i] = *(const u32x4*)(P0 + tk * 2048 + 1536 + n * 64 + c8); }
            }
            __syncthreads();
#pragma unroll
            for (int i = 0; i < 4; ++i) {
                const int piece = tid2 + i * 512, q = piece >> 3, c8 = (piece & 7) * 8, pp = ck * 256 + q;
                const f32x4 h0 = *(const f32x4*)(xcs + q * 68 + c8), h1 = *(const f32x4*)(xcs + q * 68 + c8 + 4);
                if (dir == 0) { float* o = Hf + (size_t)(tok0 + pp) * 512 + n * 64 + c8; *(f32x4*)o = h0; *(f32x4*)(o + 4) = h1; }
                else {
                    const u32x4 gw = gba[i];
                    f32x4 g0 = {__uint_as_float(gw.x << 16), __uint_as_float(gw.x & 0xffff0000u), __uint_as_float(gw.y << 16), __uint_as_float(gw.y & 0xffff0000u)};
                    f32x4 g1 = {__uint_as_float(gw.z << 16), __uint_as_float(gw.z & 0xffff0000u), __uint_as_float(gw.w << 16), __uint_as_float(gw.w & 0xffff0000u)};
                    f32x4 y0, y1;
#pragma unroll
                    for (int e = 0; e < 4; ++e) { y0[e] = (hfa[i][0][e] + h0[e]) * g0[e] * sigm(g0[e]); y1[e] = (hfa[i][1][e] + h1[e]) * g1[e] * sigm(g1[e]); }
                    *(u32x4*)(Y + (size_t)(tok0 + T - 1 - pp) * 1024 + 512 + n * 64 + c8) = pk8(y0, y1);
                }
            }
        }
#undef LRU_WF
        if (!lat && w == 0 && fq == 0) {
#pragma unroll
            for (int dt = 0; dt < 4; ++dt) p.out[O_LRU + (s * 2 + dir) * 512 + n * 64 + dt * 16 + fr] = carry[dt];
        }
    }
}
__device__ __forceinline__ void gsync(const Params& p) {
    extern __shared__ __attribute__((aligned(16))) unsigned char smem_[];
    XcdBarrier b; b.bar = (unsigned*)(p.ws + WS_BAR); b.x = xb_xcc_id(); b.st = (volatile LAS unsigned*)((LAS unsigned char*)smem_ + 131072);
    xcd_barrier(b);
}
__global__ void __launch_bounds__(512) mega(Params p) {
    extern __shared__ __attribute__((aligned(16))) unsigned char smem[];
    cg::grid_group grid = cg::this_grid();
    PG8_LAS unsigned char* lds = (PG8_LAS unsigned char*)smem;
    const float* mod = (const float*)(p.ws + WS_MOD);
    pg8::StaticOrder S;
    volatile LAS unsigned* xst = (volatile LAS unsigned*)(lds + 131072);
    if (threadIdx.x == 0) { xst[0] = 0u; xst[1] = 0u; }
    __syncthreads();
    if (blockIdx.x == 0) {
        unsigned* bw = (unsigned*)(p.ws + WS_BAR);
        for (int i = (int)threadIdx.x; i < XCD_BAR_WORDS; i += 512) bw[i] = 0u;
    }
    phaseA(p, (float*)smem);
    grid.sync();
    (void)xcd_barrier_post((unsigned*)(p.ws + WS_BAR), xst);
    phaseA1b(p, (float*)smem);
    phase_norm(p, 0, p.in[0], p.in[1]);
    gsync(p);
    { pg8::Gemm g{(const bf16_t*)(p.ws + WS_H), (const bf16_t*)(p.ws + WS_W1T), NTOK, 3072, 1024}; S.init(NTOK, 3072, (int)gridDim.x, (int)blockIdx.x);
      Epi1 E{p.ws, p.out};
      pg8::gemm_phase<Epi1, pg8::StaticOrder, false>(lds, g, S, E, nullptr); }
    if (blockIdx.x >= 64) phaseA2(p, (float*)smem, (int)blockIdx.x - 64, (int)gridDim.x - 64);
    gsync(p);
    {
        unsigned* qctr = (unsigned*)(p.ws + WS_BAR);
        volatile LAS int* slot = (volatile LAS int*)(lds + 131072 + 16);
        for (;;) {
            __syncthreads();
            if (threadIdx.x == 0) *slot = (int)__hip_atomic_fetch_add(qctr, 1u, __ATOMIC_RELAXED, __HIP_MEMORY_SCOPE_AGENT);
            __syncthreads();
            const int q = *slot;
            if (q >= 960) break;
            int kind, idx;
            if (q < 64) { kind = 0; idx = q; } else if (q < 576) { kind = 1; idx = q - 64; } else if (q < 704) { kind = 0; idx = 64 + q - 576; } else { kind = 1; idx = 512 + q - 704; }
            if (kind == 0) lru_item(p, idx, (float*)smem); else attn0_item(p, idx, lds);
        }
    }
    gsync(p);
    { pg8::Gemm g{(const bf16_t*)(p.ws + WS_Y), (const bf16_t*)(p.ws + WS_W2T), NTOK, 1024, 1024}; S.init(NTOK, 1024, (int)gridDim.x, (int)blockIdx.x);
      EpiRes<false> E{p.in[0], p.in[1], nullptr, (bf16_t*)(p.ws + WS_X1B), mod + 2048};
      pg8::gemm_phase<EpiRes<false>, pg8::StaticOrder, false>(lds, g, S, E, nullptr); }
    gsync(p);
    phase_norm16(p, (const bf16_t*)(p.ws + WS_X1B));
    gsync(p);
    { pg8::Gemm g{(const bf16_t*)(p.ws + WS_H), (const bf16_t*)(p.ws + WS_W3T), NTOK, 4096, 1024}; S.init(NTOK, 4096, (int)gridDim.x, (int)blockIdx.x);
      Epi3 E{p.ws, p.out};
      pg8::gemm_phase<Epi3, pg8::StaticOrder, false>(lds, g, S, E, nullptr); }
    gsync(p);
    { const int lane = threadIdx.x & 63;
      const float lam = __expf(wave_sum(p.in[26][lane] * p.in[27][lane])) - __expf(wave_sum(p.in[28][lane] * p.in[29][lane])) + LAM_INIT;
      for (int it = blockIdx.x; it < 768; it += gridDim.x) attn1_item(p, it, lam, lds); }
    gsync(p);
    { pg8::Gemm g{(const bf16_t*)(p.ws + WS_Y), (const bf16_t*)(p.ws + WS_W4T), NTOK, 1024, 1024}; S.init(NTOK, 1024, (int)gridDim.x, (int)blockIdx.x);
      EpiRes<true> E{nullptr, nullptr, (const bf16_t*)(p.ws + WS_X1B), (bf16_t*)(p.ws + WS_X2B), mod + 9 * 3072 + 2048};
      pg8::gemm_phase<EpiRes<true>, pg8::StaticOrder, false>(lds, g, S, E, nullptr); }
    gsync(p);
    phase_final16(p, (const bf16_t*)(p.ws + WS_X2B));
}

extern "C" void kernel_launch(void* const* d_in, const int* in_sizes, int n_in, void* d_out, int out_size, void* d_ws, size_t ws_size, hipStream_t stream) {
    static int grid_blocks = 0;
    if (!grid_blocks) {
        int dev = 0, cus = 0, per_cu = 0;
        (void)hipGetDevice(&dev);
        (void)hipDeviceGetAttribute(&cus, hipDeviceAttributeMultiprocessorCount, dev);
        (void)hipFuncSetAttribute((const void*)mega, hipFuncAttributeMaxDynamicSharedMemorySize, LDS_BYTES);
        (void)hipOccupancyMaxActiveBlocksPerMultiprocessor(&per_cu, (const void*)mega, 512, LDS_BYTES);
        if (per_cu < 1) { fprintf(stderr, "occupancy query says %d\n", per_cu); per_cu = 1; }
        grid_blocks = cus;
        if (ws_size < WS_END) fprintf(stderr, "workspace too small: %zu < %zu\n", ws_size, (size_t)WS_END);
    }
    Params p{};
    for (int i = 0; i < 33; ++i) p.in[i] = (const float*)d_in[i];
    p.out = (float*)d_out; p.ws = (unsigned char*)d_ws;
    void* args[] = {&p};
    hipError_t e = hipLaunchCooperativeKernel((void*)mega, dim3(grid_blocks), dim3(512), args, LDS_BYTES, stream);
    if (e != hipSuccess) fprintf(stderr, "cooperative launch failed: %s (grid %d)\n", hipGetErrorString(e), grid_blocks);
}
```
